# Optimizing an MI355X kernel written in HIP

```python
import jax, jax.numpy as jnp
from jax import lax
import numpy as np

D_MODEL = 4096
BATCH = 2
SEQ = 8192
DEPTH = 2

N_MIXERS = 2
N_CONV_LAYERS = (DEPTH + N_MIXERS - 1) // N_MIXERS
N_ATTN_LAYERS = DEPTH // N_MIXERS
N_META = 16
GRID_W = 64
D_FF = 11008
N_HEADS = 32
N_KV_HEADS = 8
HEAD_DIM = D_MODEL // N_HEADS
GROUP = N_HEADS // N_KV_HEADS
ROPE_AXIS_DIM = HEAD_DIM // 2
ROPE_THETA = 10000.0
Q_BLOCK = 128
CONV_WIDTH = 3
NORM_EPS = 1e-6
MACARON_WEIGHT = 0.5

kernel_name = "hybrid_conv_axial_gqa_macaron_encoder"


def _rmsnorm(x, g):
    xf = x.astype(jnp.float32)
    y = xf * lax.rsqrt(jnp.mean(xf * xf, axis=-1, keepdims=True) + NORM_EPS)
    return (y * g.astype(jnp.float32)).astype(x.dtype)


def _swiglu(x, w_gate, w_up, w_down):
    return (jax.nn.silu(x @ w_gate) * (x @ w_up)) @ w_down


def _short_conv_mixer(x, w_in, conv_w, conv_b, w_out):
    b_gate, c_gate, h = jnp.split(x @ w_in, 3, axis=-1)
    u = c_gate * h
    n = u.shape[1]
    up = jnp.pad(u, ((0, 0), (1, 1), (0, 0)))
    conv = (up[:, 0:n] * conv_w[0] + up[:, 1:n + 1] * conv_w[1]
            + up[:, 2:n + 2] * conv_w[2] + conv_b)
    return (b_gate * conv) @ w_out


def _axial_angles(n_real):
    rows = n_real // GRID_W
    real_row = jnp.repeat(jnp.arange(rows, dtype=jnp.float32), GRID_W)
    real_col = jnp.tile(jnp.arange(GRID_W, dtype=jnp.float32), rows)
    row = jnp.concatenate([jnp.full((N_META,), -1.0, jnp.float32), real_row])
    col = jnp.concatenate([jnp.arange(N_META, dtype=jnp.float32), real_col])
    inv_freq = ROPE_THETA ** (-jnp.arange(0, ROPE_AXIS_DIM, 2, dtype=jnp.float32) / ROPE_AXIS_DIM)
    return row[:, None] * inv_freq, col[:, None] * inv_freq


def _rope_axis(t, ang):
    half = t.shape[-1] // 2
    t1, t2 = t[..., :half], t[..., half:]
    cos = jnp.cos(ang)[None, :, None, :]
    sin = jnp.sin(ang)[None, :, None, :]
    return jnp.concatenate([t1 * cos - t2 * sin, t2 * cos + t1 * sin], axis=-1)


def _qk_prep(t, gain, row_ang, col_ang):
    tf = t.astype(jnp.float32)
    tf = tf * lax.rsqrt(jnp.mean(tf * tf, axis=-1, keepdims=True) + NORM_EPS) * gain.astype(jnp.float32)
    tf = jnp.concatenate([_rope_axis(tf[..., :ROPE_AXIS_DIM], row_ang),
                          _rope_axis(tf[..., ROPE_AXIS_DIM:], col_ang)], axis=-1)
    return tf.astype(t.dtype)


def _attend_block(qb, k, v):
    s = jnp.einsum('bqkgd,bskd->bkgqs', qb, k).astype(jnp.float32) * (HEAD_DIM ** -0.5)
    p = jax.nn.softmax(s, axis=-1).astype(v.dtype)
    return jnp.einsum('bkgqs,bskd->bqkgd', p, v)


def _axial_gqa_attention(x, w_qkv, q_gain, k_gain, w_o, row_ang, col_ang):
    bsz, n, _ = x.shape
    n_real = n - N_META
    q, k, v = jnp.split(x @ w_qkv, [N_HEADS * HEAD_DIM, (N_HEADS + N_KV_HEADS) * HEAD_DIM], axis=-1)
    q = _qk_prep(q.reshape(bsz, n, N_HEADS, HEAD_DIM), q_gain, row_ang, col_ang)
    k = _qk_prep(k.reshape(bsz, n, N_KV_HEADS, HEAD_DIM), k_gain, row_ang, col_ang)
    v = v.reshape(bsz, n, N_KV_HEADS, HEAD_DIM)
    q = q.reshape(bsz, n, N_KV_HEADS, GROUP, HEAD_DIM)
    attend = lambda qb: _attend_block(qb, k, v)
    out_meta = attend(q[:, :N_META])
    q_real = q[:, N_META:].reshape(bsz, n_real // Q_BLOCK, Q_BLOCK, N_KV_HEADS, GROUP, HEAD_DIM)
    out_real = lax.map(attend, jnp.swapaxes(q_real, 0, 1))
    out_real = jnp.swapaxes(out_real, 0, 1).reshape(bsz, n_real, N_KV_HEADS, GROUP, HEAD_DIM)
    out = jnp.concatenate([out_meta, out_real], axis=1).reshape(bsz, n, N_HEADS * HEAD_DIM)
    return out @ w_o


def setup_inputs(seed: int = 0) -> dict:
    key = jax.random.key(seed)
    ks = iter(jax.random.split(key, 32))
    f32 = jnp.float32

    def w(shape, fan_in):
        return jax.random.normal(next(ks), shape, f32) * (fan_in ** -0.5)

    def gain(shape):
        return 1.0 + 0.05 * jax.random.normal(next(ks), shape, f32)

    qkv_width = (N_HEADS + 2 * N_KV_HEADS) * HEAD_DIM
    return {
        "x": jax.random.normal(next(ks), (BATCH, SEQ, D_MODEL), f32),
        "meta_tokens": jax.random.normal(next(ks), (N_META, D_MODEL), f32),
        "ffn_a_norm": gain((DEPTH, D_MODEL)),
        "ffn_a_w_gate": w((DEPTH, D_MODEL, D_FF), D_MODEL),
        "ffn_a_w_up": w((DEPTH, D_MODEL, D_FF), D_MODEL),
        "ffn_a_w_down": w((DEPTH, D_FF, D_MODEL), D_FF),
        "ffn_b_norm": gain((DEPTH, D_MODEL)),
        "ffn_b_w_gate": w((DEPTH, D_MODEL, D_FF), D_MODEL),
        "ffn_b_w_up": w((DEPTH, D_MODEL, D_FF), D_MODEL),
        "ffn_b_w_down": w((DEPTH, D_FF, D_MODEL), D_FF),
        "conv_norm": gain((N_CONV_LAYERS, D_MODEL)),
        "conv_w_in": w((N_CONV_LAYERS, D_MODEL, 3 * D_MODEL), D_MODEL),
        "conv_w": w((N_CONV_LAYERS, CONV_WIDTH, D_MODEL), CONV_WIDTH),
        "conv_b": 0.02 * jax.random.normal(next(ks), (N_CONV_LAYERS, D_MODEL), f32),
        "conv_w_out": w((N_CONV_LAYERS, D_MODEL, D_MODEL), D_MODEL),
        "attn_norm": gain((N_ATTN_LAYERS, D_MODEL)),
        "attn_w_qkv": w((N_ATTN_LAYERS, D_MODEL, qkv_width), D_MODEL),
        "attn_q_norm": gain((N_ATTN_LAYERS, HEAD_DIM)),
        "attn_k_norm": gain((N_ATTN_LAYERS, HEAD_DIM)),
        "attn_w_o": w((N_ATTN_LAYERS, N_HEADS * HEAD_DIM, D_MODEL), N_HEADS * HEAD_DIM),
        "final_norm": gain((D_MODEL,)),
    }


def reference(x, meta_tokens, ffn_a_norm, ffn_a_w_gate, ffn_a_w_up, ffn_a_w_down,
              ffn_b_norm, ffn_b_w_gate, ffn_b_w_up, ffn_b_w_down,
              conv_norm, conv_w_in, conv_w, conv_b, conv_w_out,
              attn_norm, attn_w_qkv, attn_q_norm, attn_k_norm, attn_w_o,
              final_norm):
    bsz, n_real, d = x.shape
    meta = jnp.broadcast_to(meta_tokens.astype(x.dtype)[None], (bsz, N_META, d))
    h = jnp.concatenate([meta, x], axis=1)
    row_ang, col_ang = _axial_angles(n_real)

    for i in range(DEPTH):
        h = h + MACARON_WEIGHT * _swiglu(_rmsnorm(h, ffn_a_norm[i]),
                                         ffn_a_w_gate[i], ffn_a_w_up[i], ffn_a_w_down[i])
        j = i // N_MIXERS
        if i % N_MIXERS == 0:
            h = h + _short_conv_mixer(_rmsnorm(h, conv_norm[j]),
                                      conv_w_in[j], conv_w[j], conv_b[j], conv_w_out[j])
        else:
            h = h + _axial_gqa_attention(_rmsnorm(h, attn_norm[j]), attn_w_qkv[j],
                                         attn_q_norm[j], attn_k_norm[j], attn_w_o[j],
                                         row_ang, col_ang)
        h = h + MACARON_WEIGHT * _swiglu(_rmsnorm(h, ffn_b_norm[i]),
                                         ffn_b_w_gate[i], ffn_b_w_up[i], ffn_b_w_down[i])

    h = _rmsnorm(h, final_norm)
    return h[:, N_META:]
```

```cpp
#include <hip/hip_runtime.h>
#include <hip/hip_bf16.h>
#include <cstdio>
#include <cstdint>

constexpr int DM = 4096, DFF = 11008, SEQ = 8192, NB = 2, NMETA = 16, NHEAD = 32, NKV = 8, HD = 128;
constexpr int MREAL = NB * SEQ;
constexpr int MVALID = MREAL + NB * NMETA;
constexpr int MPAD = 16640;
constexpr int KVROWS = 64 + SEQ;
constexpr int NQKV = (NHEAD + 2 * NKV) * HD;
constexpr float RMS_EPS = 1e-6f;

__device__ __forceinline__ float rstd_from_ss(float ss) { return __builtin_amdgcn_rsqf(ss * (1.0f / (float)DM) + RMS_EPS); }
__device__ __forceinline__ float silu_f(float x) { return x * __builtin_amdgcn_rcpf(1.0f + __builtin_amdgcn_exp2f(-1.4426950408889634f * x)); }
__device__ __forceinline__ int kv_row_of_real(int row) { return (row >> 13) * KVROWS + 64 + (row & (SEQ - 1)); }

namespace pg8 {
#define PG8_LAS __attribute__((address_space(3)))
typedef unsigned short bf16_t;
typedef short bf16x8 __attribute__((ext_vector_type(8)));
typedef float f32x4 __attribute__((ext_vector_type(4)));
typedef unsigned u32x4 __attribute__((ext_vector_type(4)));
constexpr int BM = 256, BK = 64, HALF = 128, HTB = HALF * BK * 2  , STAGE_BYTES = 8 * HTB, NXCD = 8, WGM = 8;

__host__ __device__ __forceinline__ int lds_byte(int r, int c) { const int st = (r >> 4) * 2 + (c >> 5), rr = r & 15, cc = c & 31, ob = rr * 64 + cc * 2; return st * 1024 + (ob ^ (((ob >> 9) & 1) << 5)); }
__host__ __device__ __forceinline__ void stage_rc(int b, int& R, int& C) { const int st = b / 1024, sb = b % 1024, swz = sb ^ (((sb >> 9) & 1) << 5); R = (st >> 1) * 16 + swz / 64; C = (st & 1) * 32 + (swz % 64) / 2; }
__host__ __device__ __forceinline__ int perm32(int rho) { const int n = rho >> 4, i = rho & 15; return 8 * (i >> 2) + 4 * n + (i & 3); }

struct Unit { int pm, pn; };
struct Gemm { const bf16_t* A; const bf16_t* Bt; int M, N, K; };

struct StaticOrder {
    int nM, nN, nwg, G, c;
    __host__ __device__ void init(int M, int N, int G_, int c_) { nM = M / BM; nN = N / BM; nwg = nM * nN; G = G_; c = c_; }
    __host__ __device__ bool next(int i, Unit& u) const {
        const long L = (long)i * G + c; if (L >= nwg) return false;
        int wgid = (int)L; { const int q = nwg / NXCD, r = nwg % NXCD, xcd = wgid % NXCD, off = wgid / NXCD; wgid = (xcd < r ? xcd * (q + 1) : r * (q + 1) + (xcd - r) * q) + off; }
        const int nig = WGM * nN, gid = wgid / nig, fm = gid * WGM, gsz = (nM - fm) < WGM ? (nM - fm) : WGM;
        u.pm = fm + ((wgid % nig) % gsz); u.pn = (wgid % nig) / gsz; return true;
    }
    __device__ __forceinline__ void a_ready(const Unit&) const {}
    __device__ __forceinline__ void done(const Unit&) const {}
};

__device__ __forceinline__ unsigned cvt_pk_bf16(float lo, float hi) { unsigned r; asm volatile("v_cvt_pk_bf16_f32 %0, %1, %2" : "=v"(r) : "v"(lo), "v"(hi)); return r; }

__device__ __forceinline__ u32x4 pack8(const f32x4 a, const f32x4 b) { u32x4 w; w.x = cvt_pk_bf16(a[0], a[1]); w.y = cvt_pk_bf16(a[2], a[3]); w.z = cvt_pk_bf16(b[0], b[1]); w.w = cvt_pk_bf16(b[2], b[3]); return w; }

struct EpiSwiGLU {
    static constexpr bool PERM = true, AFTER_DRAIN = false;
    bf16_t* act; const float* rss;
    __device__ __forceinline__ void operator()(const f32x4 (&acc)[2][2][4][2], const Unit& u, int wr, int wc, int fr, int fq) const {
        const int row0 = u.pm * BM + wr * 64 + fr, col0 = u.pn * 128 + wc * 32 + 8 * fq;
#pragma unroll
        for (int ai = 0; ai < 2; ++ai)
#pragma unroll
            for (int m = 0; m < 4; ++m) {
                const int row = row0 + ai * HALF + m * 16;
                const float rs = rstd_from_ss(rss[row]);
                f32x4 o[2];
#pragma unroll
                for (int n = 0; n < 2; ++n)
#pragma unroll
                    for (int j = 0; j < 4; ++j) o[n][j] = silu_f(acc[ai][0][m][n][j] * rs) * (acc[ai][1][m][n][j] * rs);
                *(u32x4*)(act + (size_t)row * DFF + col0) = pack8(o[0], o[1]);
            }
    }
};

struct EpiResid {
    static constexpr bool PERM = true, AFTER_DRAIN = false;
    const float* base; float* out; bf16_t* hb; float* rss_out; float scale;
    __device__ __forceinline__ void operator()(const f32x4 (&acc)[2][2][4][2], const Unit& u, int wr, int wc, int fr, int fq) const {
        const int lane = fq * 16 + fr;
        const int row0 = u.pm * BM + wr * 64 + fr, colb = u.pn * BM + wc * 32 + 8 * fq;
#pragma unroll
        for (int ai = 0; ai < 2; ++ai) {
            float sel = 0.f;
#pragma unroll
            for (int m = 0; m < 4; ++m) {
                const size_t ro = (size_t)(row0 + ai * HALF + m * 16) * DM + colb;
                float ss = 0.f;
#pragma unroll
                for (int bj = 0; bj < 2; ++bj) {
                    const size_t o = ro + bj * HALF;
                    const f32x4 b0 = *(const f32x4*)(base + o), b1 = *(const f32x4*)(base + o + 4);
                    const f32x4 v0 = b0 + acc[ai][bj][m][0] * scale, v1 = b1 + acc[ai][bj][m][1] * scale;
                    *(f32x4*)(out + o) = v0; *(f32x4*)(out + o + 4) = v1;
                    if (hb) *(u32x4*)(hb + o) = pack8(v0, v1);
                    ss += (v0[0] * v0[0] + v0[1] * v0[1]) + (v0[2] * v0[2] + v0[3] * v0[3]) + (v1[0] * v1[0] + v1[1] * v1[1]) + (v1[2] * v1[2] + v1[3] * v1[3]);
                }
                ss += __shfl_xor(ss, 16); ss += __shfl_xor(ss, 32);
                sel = (fq == m) ? ss : sel;
                asm volatile("" ::: "memory");
            }
            unsafeAtomicAdd(rss_out + u.pm * BM + ai * HALF + wr * 64 + lane, sel);
        }
    }
};

struct EpiConvIn {
    static constexpr bool PERM = true, AFTER_DRAIN = false;
    bf16_t* bbuf; bf16_t* ubuf; const float* rss;
    __device__ __forceinline__ void operator()(const f32x4 (&acc)[2][2][4][2], const Unit& u, int wr, int wc, int fr, int fq) const {
        const int row0 = u.pm * BM + wr * 64 + fr;
        if (u.pn < 32) {
            const int col0 = u.pn * 128 + wc * 32 + 8 * fq;
#pragma unroll
            for (int ai = 0; ai < 2; ++ai)
#pragma unroll
                for (int m = 0; m < 4; ++m) {
                    const int row = row0 + ai * HALF + m * 16;
                    const float rs = rstd_from_ss(rss[row]);
                    f32x4 o[2];
#pragma unroll
                    for (int n = 0; n < 2; ++n) o[n] = (acc[ai][0][m][n] * rs) * (acc[ai][1][m][n] * rs);
                    *(u32x4*)(ubuf + (size_t)row * DM + col0) = pack8(o[0], o[1]);
                }
        } else {
            const int colb = (u.pn - 32) * BM + wc * 32 + 8 * fq;
#pragma unroll
            for (int ai = 0; ai < 2; ++ai)
#pragma unroll
                for (int m = 0; m < 4; ++m) {
                    const int row = row0 + ai * HALF + m * 16;
                    const float rs = rstd_from_ss(rss[row]);
#pragma unroll
                    for (int bj = 0; bj < 2; ++bj) *(u32x4*)(bbuf + (size_t)row * DM + colb + bj * HALF) = pack8(acc[ai][bj][m][0] * rs, acc[ai][bj][m][1] * rs);
                }
        }
    }
};

struct EpiQKV {
    static constexpr bool PERM = true, AFTER_DRAIN = false;
    bf16_t* q; bf16_t* k; bf16_t* v; const float* rss;
    __device__ __forceinline__ void operator()(const f32x4 (&acc)[2][2][4][2], const Unit& u, int wr, int wc, int fr, int fq) const {
        const int row0 = u.pm * BM + wr * 64 + fr;
        bf16_t* dst; int ld, colb; const bool isq = u.pn < 16;
        if (isq) { dst = q; ld = DM; colb = u.pn * BM; } else if (u.pn < 20) { dst = k; ld = NKV * HD; colb = (u.pn - 16) * BM; } else { dst = v; ld = NKV * HD; colb = (u.pn - 20) * BM; }
        colb += wc * 32 + 8 * fq;
#pragma unroll
        for (int ai = 0; ai < 2; ++ai)
#pragma unroll
            for (int m = 0; m < 4; ++m) {
                const int row = row0 + ai * HALF + m * 16;
                const float rs = rstd_from_ss(rss[row]);
                const int drow = isq ? row : kv_row_of_real(row);
#pragma unroll
                for (int bj = 0; bj < 2; ++bj) *(u32x4*)(dst + (size_t)drow * ld + colb + bj * HALF) = pack8(acc[ai][bj][m][0] * rs, acc[ai][bj][m][1] * rs);
            }
    }
};

template <class Epi, class Sched, bool ALIGN_EPI = false, bool SP2 = false>
__device__ __forceinline__ void gemm_phase(PG8_LAS unsigned char* lds, const Gemm g, const Sched& S, const Epi& E) {
    const int tid = threadIdx.x, wid = __builtin_amdgcn_readfirstlane(tid >> 6), lane = tid & 63, wr = wid >> 2, wc = wid & 3, fr = lane & 15, fq = lane >> 4;
    const int K = g.K, nt = K / BK;
    unsigned voffA[2], voffB[2];
#pragma unroll
    for (int i = 0; i < 2; ++i) { int R, C; stage_rc(tid * 16 + i * 8192, R, C); const int Rb = Epi::PERM ? ((R & ~31) + perm32(R & 31)) : R;
        voffA[i] = (unsigned)(R * K + C) * 2u; voffB[i] = (unsigned)(Rb * K + C) * 2u; }
    const size_t kstep = (size_t)(BK * 2);
    const size_t hstep = (size_t)HALF * K * 2;
    const size_t tstep = 2 * hstep;
    const unsigned ldsw = (unsigned)wid * 1024u;
    const int aoff = lds_byte(wr * 64 + fr, fq * 8), boff = lds_byte(wc * 32 + fr, fq * 8);
#define PG8_SA(b, h) (((b) * 2 + (h)) * HTB)
#define PG8_SB(b, h) ((4 + (b) * 2 + (h)) * HTB)
#define PG8_STAGE(bufoff, gbase, voff) do { _Pragma("unroll") for (int _i = 0; _i < 2; ++_i) \
        __builtin_amdgcn_global_load_lds((const unsigned*)((const char*)(gbase) + (voff)[_i]), (PG8_LAS unsigned*)(lds + (bufoff) + ldsw + _i * 8192), 16, 0, 0); } while (0)
#define PG8_LDA(dst, b, h) do { _Pragma("unroll") for (int m = 0; m < 4; ++m) _Pragma("unroll") for (int k = 0; k < 2; ++k) dst[m][k] = *(const PG8_LAS bf16x8*)(lds + PG8_SA(b, h) + aoff + m * 2048 + k * 1024); } while (0)
#define PG8_LDB(dst, b, h) do { _Pragma("unroll") for (int n = 0; n < 2; ++n) _Pragma("unroll") for (int k = 0; k < 2; ++k) dst[n][k] = *(const PG8_LAS bf16x8*)(lds + PG8_SB(b, h) + boff + n * 2048 + k * 1024); } while (0)
#define PG8_MMA(ai, bj, At, Bt) do { __builtin_amdgcn_s_setprio(1); _Pragma("unroll") for (int m = 0; m < 4; ++m) _Pragma("unroll") for (int n = 0; n < 2; ++n) _Pragma("unroll") for (int k = 0; k < 2; ++k) \
        acc[ai][bj][m][n] = __builtin_amdgcn_mfma_f32_16x16x32_bf16(Bt[n][k], At[m][k], acc[ai][bj][m][n], 0, 0, 0); __builtin_amdgcn_s_setprio(0); } while (0)
#define PG8_WAIT_V(n) asm volatile("s_waitcnt vmcnt(" #n ")" ::: "memory")
#define PG8_WAIT_L(n) asm volatile("s_waitcnt lgkmcnt(" #n ")" ::: "memory")
#define PG8_BAR __builtin_amdgcn_s_barrier()
#define PG8_SCHED __builtin_amdgcn_sched_barrier(0)
    Unit cur, nxt; int ui = 0;
    if (!S.next(0, cur)) return;
    f32x4 acc[2][2][4][2];
#pragma unroll
    for (int a = 0; a < 2; ++a)
#pragma unroll
        for (int b = 0; b < 2; ++b)
#pragma unroll
            for (int m = 0; m < 4; ++m)
#pragma unroll
                for (int n = 0; n < 2; ++n) acc[a][b][m][n] = (f32x4){0.f, 0.f, 0.f, 0.f};
    bf16x8 At[4][2], B0[2][2], B1[2][2];
    const char* cA = (const char*)g.A + (size_t)cur.pm * tstep; const char* cB = (const char*)g.Bt + (size_t)cur.pn * tstep;
    S.a_ready(cur);
    if constexpr (SP2) {
        PG8_STAGE(PG8_SB(0, 0), cB, voffB); PG8_STAGE(PG8_SB(0, 1), cB + hstep, voffB); PG8_STAGE(PG8_SA(0, 0), cA, voffA); PG8_STAGE(PG8_SA(0, 1), cA + hstep, voffA);
        if (wr == 1) PG8_BAR;
        PG8_WAIT_V(2); PG8_BAR;
        PG8_STAGE(PG8_SB(1, 0), cB + kstep, voffB); PG8_STAGE(PG8_SA(1, 0), cA + kstep, voffA); PG8_STAGE(PG8_SB(1, 1), cB + hstep + kstep, voffB);
        PG8_WAIT_V(6); PG8_BAR;
    } else {
        PG8_STAGE(PG8_SB(0, 0), cB, voffB); PG8_STAGE(PG8_SA(0, 0), cA, voffA); PG8_STAGE(PG8_SB(0, 1), cB + hstep, voffB); PG8_STAGE(PG8_SA(0, 1), cA + hstep, voffA);
        if (wr == 1) PG8_BAR;
        PG8_WAIT_V(4); PG8_BAR;
        PG8_STAGE(PG8_SB(1, 0), cB + kstep, voffB); PG8_STAGE(PG8_SA(1, 0), cA + kstep, voffA); PG8_STAGE(PG8_SB(1, 1), cB + hstep + kstep, voffB);
        PG8_WAIT_V(6); PG8_BAR;
    }
    for (;;) {
        const bool has_next = S.next(ui + 1, nxt);
        const char* nA = has_next ? (const char*)g.A + (size_t)nxt.pm * tstep : cA; const char* nB = has_next ? (const char*)g.Bt + (size_t)nxt.pn * tstep : cB;
        for (int t = 0; t < nt; t += 2) {
            const bool last = (t == nt - 2);
            const char* a1 = cA + (size_t)(t + 1) * kstep;
            const char* a2 = last ? nA : cA + (size_t)(t + 2) * kstep; const char* b2 = last ? nB : cB + (size_t)(t + 2) * kstep;
            const char* a3 = a2 + kstep; const char* b3 = b2 + kstep;
            if (last && has_next) S.a_ready(nxt);
            if constexpr (SP2) {
            PG8_LDB(B0, 0, 0); PG8_LDB(B1, 0, 1); PG8_SCHED; PG8_LDA(At, 0, 0); PG8_STAGE(PG8_SA(1, 1), a1 + hstep, voffA);
            PG8_WAIT_V(8); PG8_WAIT_L(0); PG8_BAR; PG8_MMA(0, 0, At, B0); PG8_MMA(0, 1, At, B1); PG8_BAR; PG8_SCHED;
            PG8_LDA(At, 0, 1); PG8_STAGE(PG8_SB(0, 0), b2, voffB); PG8_STAGE(PG8_SB(0, 1), b2 + hstep, voffB); PG8_STAGE(PG8_SA(0, 0), a2, voffA);
            PG8_WAIT_V(8); PG8_WAIT_L(0); PG8_BAR; PG8_MMA(1, 0, At, B0); PG8_MMA(1, 1, At, B1); PG8_BAR; PG8_SCHED;
            PG8_LDB(B0, 1, 0); PG8_LDB(B1, 1, 1); PG8_SCHED; PG8_LDA(At, 1, 0); PG8_STAGE(PG8_SA(0, 1), a2 + hstep, voffA);
            PG8_WAIT_V(8); PG8_WAIT_L(0); PG8_BAR; PG8_MMA(0, 0, At, B0); PG8_MMA(0, 1, At, B1); PG8_BAR; PG8_SCHED;
            PG8_LDA(At, 1, 1); PG8_STAGE(PG8_SB(1, 0), b3, voffB); PG8_STAGE(PG8_SB(1, 1), b3 + hstep, voffB); PG8_STAGE(PG8_SA(1, 0), a3, voffA);
            PG8_WAIT_V(8); PG8_WAIT_L(0); PG8_BAR; PG8_MMA(1, 0, At, B0); PG8_MMA(1, 1, At, B1); PG8_BAR; PG8_SCHED;
            } else {
            PG8_LDB(B0, 0, 0); PG8_SCHED; PG8_LDA(At, 0, 0); PG8_STAGE(PG8_SA(1, 1), a1 + hstep, voffA);
            PG8_WAIT_L(8); PG8_BAR; PG8_WAIT_L(0); PG8_MMA(0, 0, At, B0); PG8_BAR; PG8_SCHED;
            PG8_LDB(B1, 0, 1); PG8_STAGE(PG8_SB(0, 0), b2, voffB);
            PG8_BAR; PG8_WAIT_L(0); PG8_MMA(0, 1, At, B1); PG8_BAR;
            PG8_LDA(At, 0, 1); PG8_STAGE(PG8_SA(0, 0), a2, voffA);
            PG8_BAR; PG8_WAIT_L(0); PG8_MMA(1, 0, At, B0); PG8_BAR; PG8_SCHED;
            PG8_STAGE(PG8_SB(0, 1), b2 + hstep, voffB);
            PG8_WAIT_V(6); PG8_BAR; PG8_MMA(1, 1, At, B1); PG8_BAR;
            PG8_LDB(B0, 1, 0); PG8_SCHED; PG8_LDA(At, 1, 0); PG8_STAGE(PG8_SA(0, 1), a2 + hstep, voffA);
            PG8_WAIT_L(8); PG8_BAR; PG8_WAIT_L(0); PG8_MMA(0, 0, At, B0); PG8_BAR; PG8_SCHED;
            PG8_LDB(B1, 1, 1); PG8_STAGE(PG8_SB(1, 0), b3, voffB);
            PG8_BAR; PG8_WAIT_L(0); PG8_MMA(0, 1, At, B1); PG8_BAR;
            PG8_LDA(At, 1, 1); PG8_STAGE(PG8_SA(1, 0), a3, voffA);
            PG8_BAR; PG8_WAIT_L(0); PG8_MMA(1, 0, At, B0); PG8_BAR; PG8_SCHED;
            PG8_STAGE(PG8_SB(1, 1), b3 + hstep, voffB);
            PG8_WAIT_V(6); PG8_BAR; PG8_MMA(1, 1, At, B1); PG8_BAR;
            }
        }
        if constexpr (ALIGN_EPI) { if (wr == 0) PG8_BAR; }
        if constexpr (!Epi::AFTER_DRAIN) { E(acc, cur, wr, wc, fr, fq); S.done(cur); }
        if (!has_next) break;
#pragma unroll
        for (int a = 0; a < 2; ++a)
#pragma unroll
            for (int b = 0; b < 2; ++b)
#pragma unroll
                for (int m = 0; m < 4; ++m)
#pragma unroll
                    for (int n = 0; n < 2; ++n) acc[a][b][m][n] = (f32x4){0.f, 0.f, 0.f, 0.f};
        cur = nxt; cA = nA; cB = nB; ++ui;
        if constexpr (ALIGN_EPI) { if (wr == 1) PG8_BAR; }
    }
    PG8_WAIT_V(0);
    if constexpr (!ALIGN_EPI) { if (wr == 0) PG8_BAR; }
    PG8_BAR;
    if constexpr (Epi::AFTER_DRAIN) { E.fused(acc, cur, wr, wc, fr, fq, lds, wid, lane); S.done(cur); }
#undef PG8_SA
#undef PG8_SB
#undef PG8_STAGE
#undef PG8_LDA
#undef PG8_LDB
#undef PG8_MMA
#undef PG8_WAIT_V
#undef PG8_WAIT_L
#undef PG8_BAR
#undef PG8_SCHED
}
}

namespace att {
typedef unsigned short bf16_t;
using bf16x8 = __attribute__((ext_vector_type(8))) short;
using s16x4  = __attribute__((ext_vector_type(4))) short;
using f32x16 = __attribute__((ext_vector_type(16))) float;
using u32x4  = __attribute__((ext_vector_type(4))) unsigned;
constexpr int D = 128, NW = 8, QBLK = 32, KVBLK = 64;
constexpr float SCALE = 0.088388347648318440f;
constexpr float THR = 8.f;
constexpr int LDQ = NHEAD * HD, LDK = NKV * HD, LDO = NHEAD * HD;
constexpr int SHM_V = KVBLK * D * 2, SHM_K = KVBLK * D * 2, SHM_ATTN = 2 * SHM_V + 2 * SHM_K + NW * 64 * 4;
constexpr int NT = KVROWS / KVBLK;
static_assert(NT % 2 == 1 && NT >= 3, "the loop below is written for an odd tile count");
#define KSWZ(row, colB) ((row) * 256 + ((colB) ^ (((row) & 7) << 4)))
#define SBAR() __builtin_amdgcn_sched_barrier(0)
__device__ __forceinline__ int crow(int r, int hi) { return (r & 3) + 8 * (r >> 2) + 4 * hi; }
__device__ __forceinline__ unsigned cvtpk(float lo, float hi) { unsigned r; asm volatile("v_cvt_pk_bf16_f32 %0, %1, %2" : "=v"(r) : "v"(lo), "v"(hi)); return r; }

__device__ __forceinline__ void partialSM(f32x16& p0, f32x16& p1, float& m_reg, float& mn, float& alpha) {
  constexpr float C = SCALE * 1.4426950408889634f;
  float pmax = p0[0];
#pragma unroll
  for (int r = 1; r < 16; ++r) pmax = fmaxf(pmax, p0[r]);
#pragma unroll
  for (int r = 0; r < 16; ++r) pmax = fmaxf(pmax, p1[r]);
  { auto rr = __builtin_amdgcn_permlane32_swap(__float_as_uint(pmax), __float_as_uint(pmax), false, false);
    pmax = fmaxf(__uint_as_float(rr[0]), __uint_as_float(rr[1])); }
  if (__builtin_expect(__all(pmax - m_reg <= THR / SCALE), 1)) { mn = m_reg; alpha = 1.f; }
  else { mn = fmaxf(m_reg, pmax); alpha = __builtin_amdgcn_exp2f((m_reg - mn) * C); m_reg = mn; }
  float mnC = -mn * C;
#pragma unroll
  for (int r = 0; r < 16; ++r) p0[r] = fmaf(p0[r], C, mnC);
#pragma unroll
  for (int r = 0; r < 16; ++r) p1[r] = fmaf(p1[r], C, mnC);
#pragma unroll
  for (int r = 0; r < 16; ++r) p0[r] = __builtin_amdgcn_exp2f(p0[r]);
}
__device__ __forceinline__ void finishSM(f32x16& p0, f32x16& p1, float alpha, float& l_reg, bf16x8& pa0, bf16x8& pa1, bf16x8& pa2, bf16x8& pa3) {
#pragma unroll
  for (int r = 0; r < 16; ++r) p1[r] = __builtin_amdgcn_exp2f(p1[r]);
  float ps = 0;
#pragma unroll
  for (int r = 0; r < 16; ++r) ps += p0[r];
#pragma unroll
  for (int r = 0; r < 16; ++r) ps += p1[r];
  { auto rr = __builtin_amdgcn_permlane32_swap(__float_as_uint(ps), __float_as_uint(ps), false, false);
    ps = __uint_as_float(rr[0]) + __uint_as_float(rr[1]); }
  l_reg = l_reg * alpha + ps;
#define PK4(P, BASE, OUT) do { unsigned a0 = cvtpk(P[BASE + 0], P[BASE + 1]), a1 = cvtpk(P[BASE + 2], P[BASE + 3]);   \
    unsigned b0 = cvtpk(P[BASE + 4], P[BASE + 5]), b1 = cvtpk(P[BASE + 6], P[BASE + 7]);                              \
    auto r0 = __builtin_amdgcn_permlane32_swap(a0, b0, false, false); auto r1 = __builtin_amdgcn_permlane32_swap(a1, b1, false, false); \
    u32x4 w = {r0[0], r1[0], r0[1], r1[1]}; OUT = *reinterpret_cast<bf16x8*>(&w); } while (0)
  PK4(p0, 0, pa0); PK4(p0, 8, pa1); PK4(p1, 0, pa2); PK4(p1, 8, pa3);
#undef PK4
}
__device__ __forceinline__ void qkt(f32x16& p0, f32x16& p1, const bf16_t* Ks, const bf16x8* qr, int r32, int hi) {
  p0 = f32x16{}; p1 = f32x16{};
#pragma unroll
  for (int d0 = 0; d0 < 8; ++d0) { int cb = (d0 * 16 + hi * 8) * 2;
    bf16x8 b0 = *reinterpret_cast<const bf16x8*>((const char*)Ks + KSWZ(r32, cb));
    bf16x8 b1 = *reinterpret_cast<const bf16x8*>((const char*)Ks + KSWZ(32 + r32, cb));
    p0 = __builtin_amdgcn_mfma_f32_32x32x16_bf16(b0, qr[d0], p0, 0, 0, 0);
    p1 = __builtin_amdgcn_mfma_f32_32x32x16_bf16(b1, qr[d0], p1, 0, 0, 0); }
}
__device__ __forceinline__ int v_st(int k, int c) { const int kk = (k & ~0xC) | ((k & 4) << 1) | ((k & 8) >> 1); return ((kk >> 3) * 4 + (c >> 5)) * 512 + ((kk & 7) * 32 + (c & 31)) * 2; }
__device__ __forceinline__ int v_rd_base(int lane) { return ((lane & 3) << 3) | (((lane >> 2) & 3) << 6) | (((lane >> 4) & 1) << 5) | (((lane >> 5) & 1) << 8); }
constexpr int v_rd_off(int d0, int ks, int half) { return d0 * 512 + ks * 4096 + half * 2048; }
template <int OFF> __device__ __forceinline__ s16x4 tr_read(int vb) {
  s16x4 r; asm volatile("ds_read_b64_tr_b16 %0, %1 offset:%2" : "=&v"(r) : "v"(vb), "i"(OFF) : "memory"); return r;
}
template <int D0> __device__ __forceinline__ void pv_one(f32x16& od, int vb, bf16x8 pa0, bf16x8 pa1, bf16x8 pa2, bf16x8 pa3) {
  const s16x4 l0 = tr_read<v_rd_off(D0, 0, 0)>(vb), h0 = tr_read<v_rd_off(D0, 0, 1)>(vb), l1 = tr_read<v_rd_off(D0, 1, 0)>(vb), h1 = tr_read<v_rd_off(D0, 1, 1)>(vb);
  const s16x4 l2 = tr_read<v_rd_off(D0, 2, 0)>(vb), h2 = tr_read<v_rd_off(D0, 2, 1)>(vb), l3 = tr_read<v_rd_off(D0, 3, 0)>(vb), h3 = tr_read<v_rd_off(D0, 3, 1)>(vb);
  asm volatile("s_waitcnt lgkmcnt(0)" ::: "memory"); SBAR();
#define PK(L, H) (bf16x8){L[0], L[1], L[2], L[3], H[0], H[1], H[2], H[3]}
  od = __builtin_amdgcn_mfma_f32_32x32x16_bf16(pa0, PK(l0, h0), od, 0, 0, 0);
  od = __builtin_amdgcn_mfma_f32_32x32x16_bf16(pa1, PK(l1, h1), od, 0, 0, 0);
  od = __builtin_amdgcn_mfma_f32_32x32x16_bf16(pa2, PK(l2, h2), od, 0, 0, 0);
  od = __builtin_amdgcn_mfma_f32_32x32x16_bf16(pa3, PK(l3, h3), od, 0, 0, 0);
#undef PK
}
__device__ __forceinline__ void pv_d0(f32x16* o, int vb, bf16x8 pa0, bf16x8 pa1, bf16x8 pa2, bf16x8 pa3) {
  pv_one<0>(o[0], vb, pa0, pa1, pa2, pa3); pv_one<1>(o[1], vb, pa0, pa1, pa2, pa3); pv_one<2>(o[2], vb, pa0, pa1, pa2, pa3); pv_one<3>(o[3], vb, pa0, pa1, pa2, pa3);
}

__device__ __forceinline__ int lane_id_asm() { int l; asm volatile("v_mbcnt_lo_u32_b32 %0, -1, 0\n\tv_mbcnt_hi_u32_b32 %0, -1, %0" : "=v"(l)); return l; }
__device__ __forceinline__ void attn_unit(const bf16_t* __restrict__ Qb, const bf16_t* __restrict__ Kh, const bf16_t* __restrict__ Vh, bf16_t* __restrict__ Ob, char* lds, const int wid) {
  const int lane = lane_id_asm(), tid = wid * 64 + lane, r32 = lane & 31, hi = lane >> 5;
  bf16_t* V_lds = (bf16_t*)lds; bf16_t* K_lds = (bf16_t*)(lds + 2 * SHM_V);
  float* ws = (float*)(lds + 2 * SHM_V + 2 * SHM_K) + wid * 64; float* li_l = ws; float* al_l = ws + 32;
  float m_reg = -1e30f, l_reg = 0; f32x16 o[4] = {}; bf16x8 qr[8];
  __syncthreads();
  { const unsigned qoff = (unsigned)((wid * QBLK + r32) * LDQ + hi * 8) * 2u;
#pragma unroll
    for (int d0 = 0; d0 < 8; ++d0) qr[d0] = *reinterpret_cast<const bf16x8*>((const char*)Qb + qoff + d0 * 32); }
  const int sr = tid >> 4, sc = (tid & 15) * 8, vst0 = v_st(sr, sc), vst1 = v_st(32 + sr, sc);
  const int vb0 = (int)(uintptr_t)V_lds + v_rd_base(lane);
  struct { bf16x8 vs0, vs1, ks0, ks1; } sr_[2];
#define LD8(p) (*reinterpret_cast<const bf16x8*>(p))
  const unsigned goff0 = (unsigned)(sr * LDK + sc) * 2u, goff1 = goff0 + 32u * LDK * 2u;
#define SLOAD(i, k0) do { const char* vt_ = (const char*)Vh + (size_t)(k0) * (LDK * 2); const char* kt_ = (const char*)Kh + (size_t)(k0) * (LDK * 2); \
    sr_[i].vs0 = LD8(vt_ + goff0); sr_[i].vs1 = LD8(vt_ + goff1); sr_[i].ks0 = LD8(kt_ + goff0); sr_[i].ks1 = LD8(kt_ + goff1); } while (0)
#define SWRITE(b, i) do { *(bf16x8*)((char*)V_lds + (b) * SHM_V + vst0) = sr_[i].vs0;          \
    *(bf16x8*)((char*)V_lds + (b) * SHM_V + vst1) = sr_[i].vs1; int kc = sc * 2;               \
    *(bf16x8*)((char*)K_lds + (b) * SHM_K + KSWZ(sr, kc)) = sr_[i].ks0;                       \
    *(bf16x8*)((char*)K_lds + (b) * SHM_K + KSWZ(32 + sr, kc)) = sr_[i].ks1; } while (0)
#define SWAIT() asm volatile("s_waitcnt vmcnt(4)" ::: "memory")
#define RESC(a) do { if (__any((a) < 1.f)) { if (hi == 0) al_l[r32] = (a); asm volatile("s_waitcnt lgkmcnt(0)" ::: "memory"); \
    _Pragma("unroll") for (int d = 0; d < 4; ++d) _Pragma("unroll") for (int r = 0; r < 16; ++r) o[d][r] *= al_l[crow(r, hi)]; } } while (0)
  f32x16 pA0, pA1, pB0, pB1; float mnA, mnB, alA, alB; bf16x8 pa0, pa1, pa2, pa3;
  constexpr int SE = 0, SO = 1;
  SLOAD(SE, 0); asm volatile("s_waitcnt vmcnt(0)" ::: "memory"); SWRITE(0, SE); __syncthreads();
  qkt(pA0, pA1, K_lds, qr, r32, hi);
#pragma unroll
  for (int r = 8; r < 16; ++r) pA0[r] = -INFINITY;
#pragma unroll
  for (int r = 0; r < 16; ++r) pA1[r] = -INFINITY;
  partialSM(pA0, pA1, m_reg, mnA, alA);
  SLOAD(SO, KVBLK); SLOAD(SE, 2 * KVBLK);
  SWAIT(); SWRITE(1, SO); __syncthreads();
  for (int j = 1; j + 1 < NT; j += 2) {
    SBAR(); qkt(pB0, pB1, (bf16_t*)((char*)K_lds + SHM_K), qr, r32, hi);
    finishSM(pA0, pA1, alA, l_reg, pa0, pa1, pa2, pa3); SBAR();
    if (j + 2 < NT) SLOAD(SO, (j + 2) * KVBLK); SBAR();
    pv_d0(o, vb0, pa0, pa1, pa2, pa3); partialSM(pB0, pB1, m_reg, mnB, alB);
    __syncthreads(); SWAIT(); SWRITE(0, SE);
    RESC(alB); __syncthreads();
    SBAR(); qkt(pA0, pA1, K_lds, qr, r32, hi);
    finishSM(pB0, pB1, alB, l_reg, pa0, pa1, pa2, pa3); SBAR();
    if (j + 3 < NT) SLOAD(SE, (j + 3) * KVBLK); SBAR();
    pv_d0(o, vb0 + (int)SHM_V, pa0, pa1, pa2, pa3); partialSM(pA0, pA1, m_reg, mnA, alA);
    __syncthreads(); SWAIT(); if (j + 2 < NT) SWRITE(1, SO);
    RESC(alA); __syncthreads();
  }
  finishSM(pA0, pA1, alA, l_reg, pa0, pa1, pa2, pa3); SBAR();
  pv_d0(o, vb0, pa0, pa1, pa2, pa3);
  if (hi == 0) li_l[r32] = l_reg; asm volatile("s_waitcnt lgkmcnt(0)" ::: "memory");
  float rli[16];
#pragma unroll
  for (int r = 0; r < 16; ++r) rli[r] = __builtin_amdgcn_rcpf(li_l[crow(r, hi)]);
  { const int l2 = lane_id_asm(), c32 = l2 & 31, h2 = l2 >> 5; char* Ow = (char*)Ob + (size_t)(wid * QBLK) * (LDO * 2);
#pragma unroll
    for (int r = 0; r < 16; ++r) { const unsigned ooff = (unsigned)(crow(r, h2) * LDO + c32) * 2u;
#pragma unroll
      for (int d0 = 0; d0 < 4; ++d0) *(bf16_t*)(Ow + ooff + d0 * 64) = (bf16_t)(cvtpk(o[d0][r] * rli[r], 0.f) & 0xffffu); } }
#undef LD8
#undef SLOAD
#undef SWRITE
#undef SWAIT
#undef RESC
}
#undef KSWZ
}

#define GAS __attribute__((address_space(1)))
#define LAS __attribute__((address_space(3)))
typedef unsigned short bf16;
typedef unsigned v4u __attribute__((ext_vector_type(4)));
typedef float f32x4 __attribute__((ext_vector_type(4)));
typedef short bf16x8 __attribute__((ext_vector_type(8)));
typedef GAS unsigned gu32;
typedef GAS unsigned long long gu64;
#define RLX_AGENT __ATOMIC_RELAXED, __HIP_MEMORY_SCOPE_AGENT
#define LDS_WAIT() asm volatile("s_waitcnt lgkmcnt(0)" ::: "memory")
#define VM_WAIT() asm volatile("s_waitcnt vmcnt(0)" ::: "memory")
__device__ __forceinline__ unsigned long long rt() { return __builtin_amdgcn_s_memrealtime(); }
__device__ __forceinline__ unsigned f2bf(float f) { unsigned u = __builtin_bit_cast(unsigned, f); return (u + 0x7fffu + ((u >> 16) & 1u)) >> 16; }
__device__ __forceinline__ unsigned pk2(float lo, float hi) { return f2bf(lo) | (f2bf(hi) << 16); }

#define XB_TMO      128
#define XB_XCNT(j)  (256  + 64 * (j))
#define XB_XSUB(j)  (1280 + 64 * (j))
#define XB_XGEN(j)  (2304 + 64 * (j))
#define XB_TOP      3328
#define XB_TOPGEN   3392
#define XCD_BAR_WORDS 3456
#define XB_SPIN_CAP (1u << 18)

__device__ __forceinline__ unsigned xb_ld(unsigned* p)              { return __hip_atomic_load(p, __ATOMIC_RELAXED, __HIP_MEMORY_SCOPE_AGENT); }
__device__ __forceinline__ unsigned xb_add(unsigned* p, unsigned v) { return __hip_atomic_fetch_add(p, v, __ATOMIC_RELAXED, __HIP_MEMORY_SCOPE_AGENT); }
__device__ __forceinline__ unsigned xb_xcc_id() { return (unsigned)__builtin_amdgcn_s_getreg((3 << 11) | 20) & 0xFu; }
#define XB_SPIN(cond, bar) do { unsigned _sp = 0; while (cond) { __builtin_amdgcn_s_sleep(1); \
    if ((++_sp & 255u) == 0u) { if (xb_ld(&(bar)[XB_TMO])) break; if (_sp > XB_SPIN_CAP) { atomicAdd(&(bar)[XB_TMO], 1u); break; } } } } while (0)

struct XcdBarrier {
    unsigned* bar; unsigned x;
    volatile LAS unsigned* st;
};

__device__ __forceinline__ XcdBarrier xcd_barrier_post(unsigned* bar, volatile LAS unsigned* st) {
    XcdBarrier b; b.bar = bar; b.x = xb_xcc_id(); b.st = st;
    if (threadIdx.x == 0) (void)xb_add(&bar[XB_XCNT(b.x)], 1u);
    return b;
}
__device__ __forceinline__ void xcd_barrier_complete(unsigned* bar, unsigned x, unsigned& nloc, unsigned& nx) {
    const unsigned G = gridDim.x * gridDim.y * gridDim.z;
    unsigned sum, cnt, mine, sp = 0u;
    for (;;) {
        sum = 0u; cnt = 0u; mine = 0u;
#pragma unroll
        for (unsigned j = 0; j < 16; ++j) { const unsigned c = xb_ld(&bar[XB_XCNT(j)]); sum += c; cnt += (c > 0u) ? 1u : 0u; mine = (j == x) ? c : mine; }
        if (sum == G) break;
        __builtin_amdgcn_s_sleep(1);
        if ((++sp & 255u) == 0u) { if (xb_ld(&bar[XB_TMO])) break; if (sp > XB_SPIN_CAP) { atomicAdd(&bar[XB_TMO], 1u); break; } }
    }
    nloc = mine > 0u ? mine : 1u; nx = cnt > 0u ? cnt : 1u;
}

__device__ __forceinline__ void xcd_barrier(const XcdBarrier& b) {
    asm volatile("s_waitcnt vmcnt(0)" ::: "memory");
    __syncthreads();
    if (threadIdx.x == 0) {
        unsigned* bar = b.bar;
        __builtin_amdgcn_s_waitcnt(0);
        unsigned nloc = b.st[0], nx = b.st[1];
        if (nloc == 0u) { xcd_barrier_complete(bar, b.x, nloc, nx); b.st[0] = nloc; b.st[1] = nx; }
        const unsigned old = xb_add(&bar[XB_XSUB(b.x)], 1u);
        const unsigned gen = old / nloc;
        if (old + 1u == (gen + 1u) * nloc) {
            __builtin_amdgcn_fence(__ATOMIC_RELEASE, "agent");
            asm volatile("s_waitcnt vmcnt(0)" ::: "memory");
            const unsigned og = xb_add(&bar[XB_TOP], 1u);
            const unsigned tg = og / nx;
            if (og + 1u == (tg + 1u) * nx) xb_add(&bar[XB_TOPGEN], 1u);
            else XB_SPIN(xb_ld(&bar[XB_TOPGEN]) == tg, bar);
            __builtin_amdgcn_fence(__ATOMIC_ACQUIRE, "agent");
            xb_add(&bar[XB_XGEN(b.x)], 1u);
            asm volatile("s_waitcnt vmcnt(0)" ::: "memory");
        } else {
            XB_SPIN(xb_ld(&bar[XB_XGEN(b.x)]) == gen, bar);
            __builtin_amdgcn_fence(__ATOMIC_ACQUIRE, "agent");
            asm volatile("s_waitcnt vmcnt(0)" ::: "memory");
        }
    }
    __syncthreads();
}

constexpr size_t MiB = 1u << 20;
constexpr size_t CTL_ZERO_BYTES = 1 * MiB;
constexpr int CW_BAR = 4096;
constexpr size_t RSS_OFF = 256 * 1024;
constexpr int NRSS = 7;
static_assert((CW_BAR + XCD_BAR_WORDS) * 4 <= (int)RSS_OFF && RSS_OFF + (size_t)NRSS * MPAD * 4 <= CTL_ZERO_BYTES, "control region");
constexpr size_t SZ_WGU = (size_t)2 * DFF * DM * 2, SZ_WD = (size_t)DM * DFF * 2, SZ_WCI = (size_t)3 * DM * DM * 2, SZ_WSQ = (size_t)DM * DM * 2, SZ_WQKV = (size_t)NQKV * DM * 2;
constexpr size_t WS_WGU = 1 * MiB;
constexpr size_t WS_WD = WS_WGU + 4 * SZ_WGU;
constexpr size_t WS_WCI = WS_WD + 4 * SZ_WD;
constexpr size_t WS_WCO = WS_WCI + SZ_WCI;
constexpr size_t WS_WQKV = WS_WCO + SZ_WSQ;
constexpr size_t WS_WO = WS_WQKV + SZ_WQKV;
constexpr size_t WS_H = WS_WO + SZ_WSQ;
constexpr size_t WS_HB = WS_H + (size_t)MPAD * DM * 4;
constexpr size_t WS_ACT = WS_HB + (size_t)MPAD * DM * 2;
constexpr size_t SZ_ACT = (size_t)MPAD * DFF * 2;
constexpr size_t WS_BB = WS_ACT, WS_UB = WS_ACT + (size_t)MPAD * DM * 2;
constexpr size_t WS_Q = WS_ACT, WS_K = WS_Q + (size_t)MREAL * DM * 2, WS_V = WS_K + (size_t)NB * KVROWS * NKV * HD * 2;
static_assert(WS_UB + (size_t)MPAD * DM * 2 <= WS_ACT + SZ_ACT && WS_V + (size_t)NB * KVROWS * NKV * HD * 2 <= WS_ACT + SZ_ACT, "overlays fit the FFN hidden buffer");
constexpr size_t WS_AUX = WS_ACT + SZ_ACT;
constexpr size_t WS_END = WS_AUX + (size_t)MPAD * DM * 2;
static_assert(WS_WGU % 256 == 0 && WS_WD % 256 == 0 && WS_H % 256 == 0 && WS_HB % 256 == 0 && WS_ACT % 256 == 0 && WS_K % 256 == 0 && WS_V % 256 == 0 && WS_AUX % 256 == 0, "alignment");

constexpr int NWAVES = 8;
constexpr int RING_BYTES = 131072;
constexpr int MISC_OFF = RING_BYTES + 320;
constexpr int LDS_BYTES = 147456;

struct Frame {
    LAS unsigned char* lds;
    int tid, lane, wave, G, bid;
};
#define REFRAME(F) do { (F).lane = att::lane_id_asm(); (F).tid = (F).wave * 64 + (F).lane; } while (0)

__device__ __forceinline__ float wave_sum(float v) {
#pragma unroll
    for (int o = 1; o < 64; o <<= 1) v += __shfl_xor(v, o);
    return v;
}
__device__ __forceinline__ float bf2f(unsigned short b) { return __uint_as_float((unsigned)b << 16); }

__device__ __forceinline__ void cvt_item(const float* W, int ldw, int scol, const float* g, bf16* WT, int K, int drow, int k0, LAS float* scr, int lane) {
#pragma unroll 8
    for (int i = 0; i < 32; ++i) { const int kk = 2 * i + (lane >> 5); const float gv = g ? g[k0 + kk] : 1.f; scr[kk * 33 + (lane & 31)] = W[(size_t)(k0 + kk) * ldw + scol + (lane & 31)] * gv; }
    LDS_WAIT(); asm volatile("" ::: "memory");
    const int c = lane & 7;
#pragma unroll
    for (int j = 0; j < 4; ++j) { const int n = (lane >> 3) + 8 * j; const LAS float* s = scr + (8 * c) * 33 + n;
        v4u o; o.x = pg8::cvt_pk_bf16(s[0 * 33], s[1 * 33]); o.y = pg8::cvt_pk_bf16(s[2 * 33], s[3 * 33]); o.z = pg8::cvt_pk_bf16(s[4 * 33], s[5 * 33]); o.w = pg8::cvt_pk_bf16(s[6 * 33], s[7 * 33]);
        *(GAS v4u*)(WT + (size_t)(drow + n) * K + k0 + 8 * c) = o; }
    LDS_WAIT(); asm volatile("" ::: "memory");
}
template <int MODE>
__device__ __forceinline__ void cvt_matrix(Frame& F, const float* W, const float* W2, int ldw, const float* g, bf16* WT, int K, int ndst) {
    LAS float* scr = (LAS float*)(F.lds + F.wave * 16384);
    const int gw = F.bid * NWAVES + F.wave, NGW = F.G * NWAVES;
    const int nblk = ndst / 32, nitems = nblk * (K / 64);
    for (int it = gw; it < nitems; it += NGW) {
        const int kb = it / nblk, nb = it - kb * nblk, drow = nb * 32;
        const float* src = W; int scol = drow;
        if (MODE == 1) { src = ((drow >> 7) & 1) ? W2 : W; scol = (drow >> 8) * 128 + (drow & 127); }
        if (MODE == 2) { if (drow < 2 * DM) scol = (((drow >> 7) & 1) ? 2 * DM : DM) + (drow >> 8) * 128 + (drow & 127); else scol = drow - 2 * DM; }
        cvt_item(src, ldw, scol, g, WT, K, drow, kb * 64, scr, F.lane);
    }
}

typedef float f32x16 __attribute__((ext_vector_type(16)));
template <int NT, class Epi>
__device__ __forceinline__ void skinny_phase(Frame& F, const bf16* A, const bf16* Bt, int K, int n_items, const Epi& E) {
    const int r32 = F.lane & 31, hi = F.lane >> 5, kc = K / 8, k0 = F.wave * kc;
    LAS float* P = (LAS float*)F.lds;
    for (int item = F.bid; item < n_items; item += F.G) {
        f32x16 acc[NT];
        const bf16* bp[NT];
        const bf16* ap = A + (size_t)r32 * K + k0 + hi * 16;
#pragma unroll
        for (int t = 0; t < NT; ++t) { acc[t] = f32x16{}; bp[t] = Bt + (size_t)(E.tile_row(item, t) + r32) * K + k0 + hi * 16; }
        for (int kk = 0; kk < kc; kk += 32) {
            const bf16x8 a0 = *(const bf16x8*)(ap + kk), a1 = *(const bf16x8*)(ap + kk + 8);
#pragma unroll
            for (int t = 0; t < NT; ++t) {
                const bf16x8 b0 = *(const bf16x8*)(bp[t] + kk), b1 = *(const bf16x8*)(bp[t] + kk + 8);
                acc[t] = __builtin_amdgcn_mfma_f32_32x32x16_bf16(a0, b0, acc[t], 0, 0, 0);
                acc[t] = __builtin_amdgcn_mfma_f32_32x32x16_bf16(a1, b1, acc[t], 0, 0, 0);
            }
        }
#pragma unroll
        for (int t = 0; t < NT; ++t)
#pragma unroll
            for (int r = 0; r < 16; ++r) P[((F.wave * NT + t) * 32 + att::crow(r, hi)) * 32 + r32] = acc[t][r];
        __syncthreads();
#pragma unroll
        for (int h = 0; h < 2; ++h) {
            const int e = F.tid + h * 512; float v[NT];
#pragma unroll
            for (int t = 0; t < NT; ++t) { float s = 0.f;
#pragma unroll
                for (int w = 0; w < NWAVES; ++w) s += P[(w * NT + t) * 1024 + e];
                v[t] = s; }
            E.apply(item, e >> 5, e & 31, v);
        }
        __syncthreads();
    }
}
struct SkResid {
    float* h; bf16* hb; float* rss_out; float scale;
    __device__ __forceinline__ int tile_row(int item, int) const { return item * 32; }
    __device__ __forceinline__ void apply(int item, int row, int col, const float (&v)[1]) const {
        const size_t o = (size_t)(MREAL + row) * DM + item * 32 + col;
        const float x = h[o] + scale * v[0];
        h[o] = x; hb[o] = (bf16)f2bf(x);
        float ss = x * x;
#pragma unroll
        for (int d = 1; d < 32; d <<= 1) ss += __shfl_xor(ss, d);
        if (col == 0) unsafeAtomicAdd(rss_out + MREAL + row, ss);
    }
};
struct SkConvIn {
    bf16* bbuf; bf16* ubuf; const float* rss;
    __device__ __forceinline__ int tile_row(int item, int t) const { const int ch = item * 32; return t == 0 ? 2 * DM + ch : (ch >> 7) * 256 + (t == 2 ? 128 : 0) + (ch & 127); }
    __device__ __forceinline__ void apply(int item, int row, int col, const float (&v)[3]) const {
        const float rs = rstd_from_ss(rss[MREAL + row]); const size_t o = (size_t)(MREAL + row) * DM + item * 32 + col;
        bbuf[o] = (bf16)f2bf(v[0] * rs); ubuf[o] = (bf16)f2bf((v[1] * rs) * (v[2] * rs));
    }
};
struct SkKV {
    bf16* k; bf16* v; const float* rss;
    __device__ __forceinline__ int tile_row(int item, int) const { return NHEAD * HD + item * 32; }
    __device__ __forceinline__ void apply(int item, int row, int col, const float (&x)[1]) const {
        const float rs = rstd_from_ss(rss[MREAL + row]); const int kvr = (row >> 4) * KVROWS + (row & 15);
        bf16* dst = item < 32 ? k : v; const int c = (item & 31) * 32 + col;
        dst[(size_t)kvr * (NKV * HD) + c] = (bf16)f2bf(x[0] * rs);
    }
};

__device__ __forceinline__ void rows_init(Frame& F, const float* x, const float* meta, float* h, bf16* hb, float* rss0) {
    const int gw = F.bid * NWAVES + F.wave, NGW = F.G * NWAVES;
    for (int r = gw; r < MVALID; r += NGW) {
        const float* src = r < MREAL ? x + (size_t)r * DM : meta + (size_t)((r - MREAL) & (NMETA - 1)) * DM;
        float ss = 0.f;
#pragma unroll 4
        for (int j = 0; j < 16; ++j) {
            const f32x4 v = *(const GAS f32x4*)(src + (size_t)(64 * j + F.lane) * 4);
            ss += (v.x * v.x + v.y * v.y) + (v.z * v.z + v.w * v.w);
            const unsigned long long pk = (unsigned long long)pg8::cvt_pk_bf16(v.x, v.y) | ((unsigned long long)pg8::cvt_pk_bf16(v.z, v.w) << 32);
            *(GAS unsigned long long*)(hb + (size_t)r * DM + (size_t)(64 * j + F.lane) * 4) = pk;
            if (r >= MREAL) *(GAS f32x4*)(h + (size_t)r * DM + (size_t)(64 * j + F.lane) * 4) = v;
        }
        ss = wave_sum(ss);
        if (F.lane == 0) rss0[r] = ss;
    }
}
__device__ __forceinline__ void seq_neighbours(int r, int& prev, int& next) {
    if (r < MREAL) { const int b = r >> 13, t = r & (SEQ - 1); prev = t > 0 ? r - 1 : MREAL + b * NMETA + (NMETA - 1); next = t < SEQ - 1 ? r + 1 : -1; }
    else { const int b = (r - MREAL) >> 4, j = (r - MREAL) & 15; prev = j > 0 ? r - 1 : -1; next = j < NMETA - 1 ? r + 1 : b * SEQ; }
}
__device__ __forceinline__ void conv_pass(Frame& F, const bf16* bbuf, const bf16* ubuf, const float* cw, const float* cb, bf16* cv) {
    const int gt = F.bid * (NWAVES * 64) + F.tid, NGT = F.G * NWAVES * 64;
    for (int it = gt; it < MVALID * (DM / 8); it += NGT) {
        const int r = it >> 9, c = (it & 511) * 8; int prev, next; seq_neighbours(r, prev, next);
        const bf16x8 zero = {0, 0, 0, 0, 0, 0, 0, 0};
        const bf16x8 bv = *(const GAS bf16x8*)(bbuf + (size_t)r * DM + c), u1 = *(const GAS bf16x8*)(ubuf + (size_t)r * DM + c);
        const bf16x8 u0 = prev >= 0 ? *(const GAS bf16x8*)(ubuf + (size_t)prev * DM + c) : zero, u2 = next >= 0 ? *(const GAS bf16x8*)(ubuf + (size_t)next * DM + c) : zero;
        float o[8];
#pragma unroll
        for (int q = 0; q < 2; ++q) {
            const f32x4 w0 = *(const GAS f32x4*)(cw + c + 4 * q), w1 = *(const GAS f32x4*)(cw + DM + c + 4 * q), w2 = *(const GAS f32x4*)(cw + 2 * DM + c + 4 * q), bb = *(const GAS f32x4*)(cb + c + 4 * q);
#pragma unroll
            for (int j = 0; j < 4; ++j) { const int e = 4 * q + j;
                o[e] = bf2f((unsigned short)bv[e]) * (w0[j] * bf2f((unsigned short)u0[e]) + w1[j] * bf2f((unsigned short)u1[e]) + w2[j] * bf2f((unsigned short)u2[e]) + bb[j]); }
        }
        v4u w; w.x = pg8::cvt_pk_bf16(o[0], o[1]); w.y = pg8::cvt_pk_bf16(o[2], o[3]); w.z = pg8::cvt_pk_bf16(o[4], o[5]); w.w = pg8::cvt_pk_bf16(o[6], o[7]);
        *(GAS v4u*)(cv + (size_t)r * DM + c) = w;
    }
}
__device__ __forceinline__ void rope_head(bf16* p, const float* gain, float rowpos, float colpos, int i) {
    const float x0 = bf2f(p[i]), x1 = bf2f(p[32 + i]), x2 = bf2f(p[64 + i]), x3 = bf2f(p[96 + i]);
    float ss = (x0 * x0 + x1 * x1) + (x2 * x2 + x3 * x3);
#pragma unroll
    for (int d = 1; d < 32; d <<= 1) ss += __shfl_xor(ss, d);
    const float rs = __builtin_amdgcn_rsqf(ss * (1.0f / (float)HD) + RMS_EPS);
    const float y0 = x0 * rs * gain[i], y1 = x1 * rs * gain[32 + i], y2 = x2 * rs * gain[64 + i], y3 = x3 * rs * gain[96 + i];
    const float inv_freq = __builtin_amdgcn_exp2f(-(float)i * 0.41524101186092029f);
    const float ar = rowpos * inv_freq * 0.15915494309189535f, ac = colpos * inv_freq * 0.15915494309189535f;
    const float cr = __builtin_amdgcn_cosf(ar), sr = __builtin_amdgcn_sinf(ar), cc = __builtin_amdgcn_cosf(ac), sc = __builtin_amdgcn_sinf(ac);
    p[i] = (bf16)f2bf(y0 * cr - y1 * sr); p[32 + i] = (bf16)f2bf(y1 * cr + y0 * sr);
    p[64 + i] = (bf16)f2bf(y2 * cc - y3 * sc); p[96 + i] = (bf16)f2bf(y3 * cc + y2 * sc);
}
__device__ __forceinline__ void qk_prep_pass(Frame& F, bf16* Q, bf16* K, const float* qg, const float* kg) {
    const int ghw = (F.bid * NWAVES + F.wave) * 2 + (F.lane >> 5), NGHW = F.G * NWAVES * 2, i = F.lane & 31;
    constexpr int NQ = MREAL * NHEAD, NK = NB * (NMETA + SEQ) * NKV;
    for (int it = ghw; it < NQ + NK; it += NGHW) {
        if (it < NQ) { const int row = it >> 5, hd = it & 31, t = row & (SEQ - 1);
            rope_head(Q + (size_t)row * DM + hd * HD, qg, (float)(t >> 6), (float)(t & 63), i); }
        else { const int j = it - NQ, key = j >> 3, g = j & 7, b = key / (NMETA + SEQ), p = key - b * (NMETA + SEQ);
            const int kvr = b * KVROWS + (p < NMETA ? p : 64 + (p - NMETA));
            const float rowpos = p < NMETA ? -1.f : (float)((p - NMETA) >> 6), colpos = p < NMETA ? (float)p : (float)((p - NMETA) & 63);
            rope_head(K + (size_t)kvr * (NKV * HD) + g * HD, kg, rowpos, colpos, i); }
    }
}
__device__ __forceinline__ void final_norm_pass(Frame& F, const float* h, const float* rss, const float* g, float* out) {
    const int gw = F.bid * NWAVES + F.wave, NGW = F.G * NWAVES;
    for (int r = gw; r < MREAL; r += NGW) {
        const float rs = rstd_from_ss(rss[r]);
#pragma unroll 4
        for (int j = 0; j < 16; ++j) { const size_t o = (size_t)(64 * j + F.lane) * 4;
            const f32x4 v = *(const GAS f32x4*)(h + (size_t)r * DM + o), gv = *(const GAS f32x4*)(g + o);
            *(GAS f32x4*)(out + (size_t)r * DM + o) = v * rs * gv; }
    }
}

#ifndef MK_ONE_LAUNCH
#define MK_ONE_LAUNCH 1
#endif
constexpr int N_PHASES = 17;
struct Args { const float* in[21]; float* out; unsigned char* ws; int ph_lo, ph_hi; };
static_assert(sizeof(Args) == 192, "Args has no padding bytes");

__global__ void __launch_bounds__(NWAVES * 64, 2) fwd_kernel(Args args) {
    extern __shared__ __attribute__((aligned(16))) unsigned char lds_raw[];
    Frame F;
    F.lds = (LAS unsigned char*)lds_raw;
    F.tid = threadIdx.x; F.lane = F.tid & 63; F.wave = __builtin_amdgcn_readfirstlane(F.tid >> 6);
    F.G = gridDim.x; F.bid = blockIdx.x;
    volatile LAS unsigned* MISC = (volatile LAS unsigned*)(F.lds + MISC_OFF);
    unsigned char* ws = args.ws;
    gu32* ctl = (gu32*)ws;
    for (int u = F.tid; u < (LDS_BYTES - RING_BYTES) / 4; u += NWAVES * 64) ((LAS unsigned*)(F.lds + RING_BYTES))[u] = 0u;
    __syncthreads();
    XcdBarrier bar; bar.bar = (unsigned*)(ctl + CW_BAR); bar.x = 0; bar.st = nullptr;
    if (MK_ONE_LAUNCH) bar = xcd_barrier_post((unsigned*)(ctl + CW_BAR), MISC + 8);
    const int lo = args.ph_lo, hi = args.ph_hi;
#define REFRAME_(F) ((F).lane = att::lane_id_asm(), (F).tid = (F).wave * 64 + (F).lane)
#define IN(k) (lo <= (k) && (k) < hi && (REFRAME_(F), true))
#define SEAM(k) do { if (MK_ONE_LAUNCH && (lo <= (k) + 1 && (k) + 1 < hi)) xcd_barrier(bar); } while (0)

    const float* x = args.in[0]; const float* meta = args.in[1];
    const float* conv_norm = args.in[10]; const float* conv_w_in = args.in[11]; const float* conv_w = args.in[12]; const float* conv_b = args.in[13]; const float* conv_w_out = args.in[14];
    const float* attn_norm = args.in[15]; const float* attn_w_qkv = args.in[16]; const float* q_gain = args.in[17]; const float* k_gain = args.in[18]; const float* attn_w_o = args.in[19];
    const float* final_g = args.in[20];
    bf16* WGU = (bf16*)(ws + WS_WGU); bf16* WD = (bf16*)(ws + WS_WD); bf16* WCI = (bf16*)(ws + WS_WCI); bf16* WCO = (bf16*)(ws + WS_WCO); bf16* WQKV = (bf16*)(ws + WS_WQKV); bf16* WO = (bf16*)(ws + WS_WO);
    float* H = (float*)(ws + WS_H); bf16* HB = (bf16*)(ws + WS_HB); bf16* ACT = (bf16*)(ws + WS_ACT); bf16* BB = (bf16*)(ws + WS_BB); bf16* UB = (bf16*)(ws + WS_UB);
    bf16* QB = (bf16*)(ws + WS_Q); bf16* KB = (bf16*)(ws + WS_K); bf16* VB = (bf16*)(ws + WS_V); bf16* AUX = (bf16*)(ws + WS_AUX);
    float* RSS = (float*)(ws + RSS_OFF);
#define RSSK(k) (RSS + (size_t)(k) * MPAD)
    constexpr size_t NWGU = (size_t)2 * DFF * DM, NWD = (size_t)DM * DFF;

    if (IN(0)) {
        cvt_matrix<1>(F, args.in[3] + (size_t)0 * DM * DFF, args.in[4] + (size_t)0 * DM * DFF, DFF, args.in[2] + 0 * DM, WGU + 0 * NWGU, DM, 2 * DFF);
        cvt_matrix<0>(F, args.in[5] + (size_t)0 * DFF * DM, nullptr, DM, nullptr, WD + 0 * NWD, DFF, DM);
        cvt_matrix<1>(F, args.in[7] + (size_t)0 * DM * DFF, args.in[8] + (size_t)0 * DM * DFF, DFF, args.in[6] + 0 * DM, WGU + 1 * NWGU, DM, 2 * DFF);
        cvt_matrix<0>(F, args.in[9] + (size_t)0 * DFF * DM, nullptr, DM, nullptr, WD + 1 * NWD, DFF, DM);
        cvt_matrix<1>(F, args.in[3] + (size_t)1 * DM * DFF, args.in[4] + (size_t)1 * DM * DFF, DFF, args.in[2] + 1 * DM, WGU + 2 * NWGU, DM, 2 * DFF);
        cvt_matrix<0>(F, args.in[5] + (size_t)1 * DFF * DM, nullptr, DM, nullptr, WD + 2 * NWD, DFF, DM);
        cvt_matrix<1>(F, args.in[7] + (size_t)1 * DM * DFF, args.in[8] + (size_t)1 * DM * DFF, DFF, args.in[6] + 1 * DM, WGU + 3 * NWGU, DM, 2 * DFF);
        cvt_matrix<0>(F, args.in[9] + (size_t)1 * DFF * DM, nullptr, DM, nullptr, WD + 3 * NWD, DFF, DM);
        cvt_matrix<2>(F, conv_w_in, nullptr, 3 * DM, conv_norm, WCI, DM, 3 * DM);
        cvt_matrix<0>(F, conv_w_out, nullptr, DM, nullptr, WCO, DM, DM);
        cvt_matrix<0>(F, attn_w_qkv, nullptr, NQKV, attn_norm, WQKV, DM, NQKV);
        cvt_matrix<0>(F, attn_w_o, nullptr, DM, nullptr, WO, DM, DM);
        rows_init(F, x, meta, H, HB, RSSK(0));
        SEAM(0);
    }

#define FFN_UP(ph, f, rows, rin) if (IN(ph)) { \
        pg8::Gemm g{HB, WGU + (size_t)(f) * NWGU, (rows), 2 * DFF, DM}; pg8::StaticOrder S; S.init((rows), 2 * DFF, F.G, F.bid); \
        pg8::EpiSwiGLU E{ACT, RSSK(rin)}; \
        pg8::gemm_phase<pg8::EpiSwiGLU, pg8::StaticOrder, true, true>(F.lds, g, S, E); \
        SEAM(ph); }
#define FFN_DOWN(ph, f, basep, hbp, rout, with_meta) if (IN(ph)) { \
        pg8::Gemm g{ACT, WD + (size_t)(f) * NWD, MREAL, DM, DFF}; pg8::StaticOrder S; S.init(MREAL, DM, F.G, F.bid); \
        pg8::EpiResid E{(basep), H, (hbp), RSSK(rout), 0.5f}; \
        pg8::gemm_phase<pg8::EpiResid, pg8::StaticOrder, true, true>(F.lds, g, S, E); \
        if (with_meta) { SkResid SE{H, HB, RSSK(rout), 0.5f}; skinny_phase<1, SkResid>(F, ACT + (size_t)MREAL * DFF, WD + (size_t)(f) * NWD, DFF, DM / 32, SE); } \
        SEAM(ph); }

    FFN_UP(1, 0, MPAD, 0)
    FFN_DOWN(2, 0, x, HB, 1, true)
    if (IN(3)) {
        pg8::Gemm g{HB, WCI, MREAL, 3 * DM, DM}; pg8::StaticOrder S; S.init(MREAL, 3 * DM, F.G, F.bid);
        pg8::EpiConvIn E{BB, UB, RSSK(1)};
        pg8::gemm_phase<pg8::EpiConvIn, pg8::StaticOrder, true, true>(F.lds, g, S, E);
        SkConvIn SE{BB, UB, RSSK(1)}; skinny_phase<3, SkConvIn>(F, HB + (size_t)MREAL * DM, WCI, DM, DM / 32, SE);
        SEAM(3);
    }
    if (IN(4)) { conv_pass(F, BB, UB, conv_w, conv_b, AUX); SEAM(4); }
    if (IN(5)) {
        pg8::Gemm g{AUX, WCO, MREAL, DM, DM}; pg8::StaticOrder S; S.init(MREAL, DM, F.G, F.bid);
        pg8::EpiResid E{H, H, HB, RSSK(2), 1.0f};
        pg8::gemm_phase<pg8::EpiResid, pg8::StaticOrder, true, true>(F.lds, g, S, E);
        SkResid SE{H, HB, RSSK(2), 1.0f}; skinny_phase<1, SkResid>(F, AUX + (size_t)MREAL * DM, WCO, DM, DM / 32, SE);
        SEAM(5);
    }
    FFN_UP(6, 1, MPAD, 2)
    FFN_DOWN(7, 1, H, HB, 3, true)
    FFN_UP(8, 2, MPAD, 3)
    FFN_DOWN(9, 2, H, HB, 4, true)
    if (IN(10)) {
        pg8::Gemm g{HB, WQKV, MREAL, NQKV, DM}; pg8::StaticOrder S; S.init(MREAL, NQKV, F.G, F.bid);
        pg8::EpiQKV E{QB, KB, VB, RSSK(4)};
        pg8::gemm_phase<pg8::EpiQKV, pg8::StaticOrder, true, true>(F.lds, g, S, E);
        SkKV SE{KB, VB, RSSK(4)}; skinny_phase<1, SkKV>(F, HB + (size_t)MREAL * DM, WQKV, DM, 2 * NKV * HD / 32, SE);
        for (int i = F.bid * (NWAVES * 64) + F.tid; i < NB * 48 * (NKV * HD / 8); i += F.G * NWAVES * 64) {
            const int b = i / (48 * 128), r = (i / 128) % 48, c = (i & 127) * 8; const size_t o = (size_t)(b * KVROWS + NMETA + r) * (NKV * HD) + c;
            *(GAS v4u*)(KB + o) = (v4u){0u, 0u, 0u, 0u}; *(GAS v4u*)(VB + o) = (v4u){0u, 0u, 0u, 0u};
        }
        SEAM(10);
    }
    if (IN(11)) { qk_prep_pass(F, QB, KB, q_gain, k_gain); SEAM(11); }
    if (IN(12)) {
        constexpr int NUNITS = NB * NHEAD * (SEQ / 256);
        const bool xcd_deal = (F.G == 256);
        for (int i = 0;; ++i) {
            int un;
            if (xcd_deal) { if (i >= 8) break; un = (F.bid & 7) * 256 + i * 32 + (F.bid >> 3); } else { un = i * F.G + F.bid; if (un >= NUNITS) break; }
            const int grp = un >> 7, rem = un & 127, b = grp >> 3, kvh = grp & 7, hq = kvh * 4 + (rem >> 5), qb = rem & 31;
            const size_t qoff = (size_t)(b * SEQ + qb * 256) * DM + hq * HD, koff = (size_t)(b * KVROWS) * (NKV * HD) + kvh * HD;
            att::attn_unit(QB + qoff, KB + koff, VB + koff, AUX + qoff, (char*)lds_raw, F.wave);
        }
        SEAM(12);
    }
    if (IN(13)) {
        pg8::Gemm g{AUX, WO, MREAL, DM, DM}; pg8::StaticOrder S; S.init(MREAL, DM, F.G, F.bid);
        pg8::EpiResid E{H, H, HB, RSSK(5), 1.0f};
        pg8::gemm_phase<pg8::EpiResid, pg8::StaticOrder, true, true>(F.lds, g, S, E);
        SEAM(13);
    }
    FFN_UP(14, 3, MREAL, 5)
    FFN_DOWN(15, 3, H, (bf16*)nullptr, 6, false)
    if (IN(16)) final_norm_pass(F, H, RSSK(6), final_g, args.out);
#undef IN
#undef SEAM
}

extern "C" void kernel_launch(void* const* d_in, const int* in_sizes, int n_in, void* d_out, int out_size, void* d_ws, size_t ws_size, hipStream_t stream) {
    static int grid = 0;
    if (grid == 0) {
        if (n_in != 21 || in_sizes[0] != MREAL * DM || out_size != MREAL * DM || ws_size < WS_END) {
            fprintf(stderr, "kernel_launch: built for 21 inputs, x/out of %d floats, >= %zu bytes of workspace; got n_in %d, in0 %d, out %d, ws %zu; nothing launched\n", MREAL * DM, (size_t)WS_END, n_in, n_in > 0 ? in_sizes[0] : -1, out_size, ws_size);
            grid = -1; return; }
        int dev = 0, cus = 0, per_cu = 0;
        if (hipGetDevice(&dev) != hipSuccess || hipDeviceGetAttribute(&cus, hipDeviceAttributeMultiprocessorCount, dev) != hipSuccess) { fprintf(stderr, "kernel_launch: device query failed\n"); grid = -1; return; }
        if (hipFuncSetAttribute((const void*)fwd_kernel, hipFuncAttributeMaxDynamicSharedMemorySize, LDS_BYTES) != hipSuccess) { fprintf(stderr, "kernel_launch: hipFuncSetAttribute failed\n"); grid = -1; return; }
        if (hipOccupancyMaxActiveBlocksPerMultiprocessor(&per_cu, (const void*)fwd_kernel, NWAVES * 64, LDS_BYTES) != hipSuccess || per_cu < 1)
            fprintf(stderr, "kernel_launch: note: occupancy query reports %d workgroups per CU\n", per_cu);
        (void)hipGetLastError();
        grid = cus;
    }
    if (grid < 0) return;
    if (hipMemsetAsync(d_ws, 0, CTL_ZERO_BYTES, stream) != hipSuccess) { fprintf(stderr, "kernel_launch: hipMemsetAsync failed\n"); return; }
    Args a{};
    for (int i = 0; i < 21; ++i) a.in[i] = (const float*)d_in[i];
    a.out = (float*)d_out; a.ws = (unsigned char*)d_ws;
#if MK_ONE_LAUNCH
    a.ph_lo = 0; a.ph_hi = N_PHASES;
    hipLaunchKernelGGL(fwd_kernel, dim3(grid), dim3(NWAVES * 64), LDS_BYTES, stream, a);
#else
    for (int p = 0; p < N_PHASES; ++p) { a.ph_lo = p; a.ph_hi = p + 1; hipLaunchKernelGGL(fwd_kernel, dim3(grid), dim3(NWAVES * 64), LDS_BYTES, stream, a); }
#endif
    const hipError_t le = hipPeekAtLastError();
    if (le != hipSuccess) fprintf(stderr, "kernel_launch: launch failed: %s\n", hipGetErrorName(le));
}
```

```cpp
#include <hip/hip_runtime.h>
#include <hip/hip_bf16.h>
#include <cstdio>
#include <cstdint>

constexpr int DM = 4096, DFF = 11008, SEQ = 8192, NB = 2, NMETA = 16, NHEAD = 32, NKV = 8, HD = 128;
constexpr int MREAL = NB * SEQ;
constexpr int MVALID = MREAL + NB * NMETA;
constexpr int MPAD = 16640;
constexpr int KVROWS = 64 + SEQ;
constexpr int NQKV = (NHEAD + 2 * NKV) * HD;
constexpr float RMS_EPS = 1e-6f;

typedef unsigned long long rss_t;
constexpr float RSS_FX = 16777216.0f;
__device__ __forceinline__ rss_t rss_fix(float ss) { return (rss_t)(ss * RSS_FX + 0.5f); }
__device__ __forceinline__ void rss_add(rss_t* p, float ss) { (void)__hip_atomic_fetch_add(p, rss_fix(ss), __ATOMIC_RELAXED, __HIP_MEMORY_SCOPE_AGENT); }
__device__ __forceinline__ float rstd_from_ss(rss_t v) { return __builtin_amdgcn_rsqf((float)v * (1.0f / (RSS_FX * (float)DM)) + RMS_EPS); }
__device__ __forceinline__ float silu_f(float x) { return x * __builtin_amdgcn_rcpf(1.0f + __builtin_amdgcn_exp2f(-1.4426950408889634f * x)); }
__device__ __forceinline__ int kv_row_of_real(int row) { return (row >> 13) * KVROWS + 64 + (row & (SEQ - 1)); }

namespace pg8 {
#define PG8_LAS __attribute__((address_space(3)))
typedef unsigned short bf16_t;
typedef short bf16x8 __attribute__((ext_vector_type(8)));
typedef float f32x4 __attribute__((ext_vector_type(4)));
typedef unsigned u32x4 __attribute__((ext_vector_type(4)));
constexpr int BM = 256, BK = 64, HALF = 128, HTB = HALF * BK * 2  , STAGE_BYTES = 8 * HTB, NXCD = 8, WGM = 8;

__host__ __device__ __forceinline__ int lds_byte(int r, int c) { const int st = (r >> 4) * 2 + (c >> 5), rr = r & 15, cc = c & 31, ob = rr * 64 + cc * 2; return st * 1024 + (ob ^ (((ob >> 9) & 1) << 5)); }
__host__ __device__ __forceinline__ void stage_rc(int b, int& R, int& C) { const int st = b / 1024, sb = b % 1024, swz = sb ^ (((sb >> 9) & 1) << 5); R = (st >> 1) * 16 + swz / 64; C = (st & 1) * 32 + (swz % 64) / 2; }
__host__ __device__ __forceinline__ int perm32(int rho) { const int n = rho >> 4, i = rho & 15; return 8 * (i >> 2) + 4 * n + (i & 3); }

struct Unit { int pm, pn; };
struct Gemm { const bf16_t* A; const bf16_t* Bt; int M, N, K; };

struct StaticOrder {
    int nM, nN, nwg, G, c;
    __host__ __device__ void init(int M, int N, int G_, int c_) { nM = M / BM; nN = N / BM; nwg = nM * nN; G = G_; c = c_; }
    __host__ __device__ bool next(int i, Unit& u) const {
        const long L = (long)i * G + c; if (L >= nwg) return false;
        int wgid = (int)L; { const int q = nwg / NXCD, r = nwg % NXCD, xcd = wgid % NXCD, off = wgid / NXCD; wgid = (xcd < r ? xcd * (q + 1) : r * (q + 1) + (xcd - r) * q) + off; }
        const int nig = WGM * nN, gid = wgid / nig, fm = gid * WGM, gsz = (nM - fm) < WGM ? (nM - fm) : WGM;
        u.pm = fm + ((wgid % nig) % gsz); u.pn = (wgid % nig) / gsz; return true;
    }
    __device__ __forceinline__ void a_ready(const Unit&) const {}
    __device__ __forceinline__ void done(const Unit&) const {}
};

__device__ __forceinline__ unsigned cvt_pk_bf16(float lo, float hi) { unsigned r; asm volatile("v_cvt_pk_bf16_f32 %0, %1, %2" : "=v"(r) : "v"(lo), "v"(hi)); return r; }

__device__ __forceinline__ u32x4 pack8(const f32x4 a, const f32x4 b) { u32x4 w; w.x = cvt_pk_bf16(a[0], a[1]); w.y = cvt_pk_bf16(a[2], a[3]); w.z = cvt_pk_bf16(b[0], b[1]); w.w = cvt_pk_bf16(b[2], b[3]); return w; }

typedef int i32x8 __attribute__((ext_vector_type(8)));
__device__ __forceinline__ i32x8 cat8(const bf16x8 a, const bf16x8 b) { typedef int i32x4 __attribute__((ext_vector_type(4))); const i32x4 x = __builtin_bit_cast(i32x4, a), y = __builtin_bit_cast(i32x4, b); return (i32x8){x[0], x[1], x[2], x[3], y[0], y[1], y[2], y[3]}; }
__device__ __forceinline__ unsigned pack_fp8x4(const f32x4 v) {
    int w = 0;
    w = __builtin_amdgcn_cvt_pk_fp8_f32(__builtin_amdgcn_fmed3f(v[0], -448.f, 448.f), __builtin_amdgcn_fmed3f(v[1], -448.f, 448.f), w, false);
    w = __builtin_amdgcn_cvt_pk_fp8_f32(__builtin_amdgcn_fmed3f(v[2], -448.f, 448.f), __builtin_amdgcn_fmed3f(v[3], -448.f, 448.f), w, true);
    return (unsigned)w;
}
constexpr float FP8_ACT_SCALE = 4.f, FP8_W_SCALE = 64.f, FP8_H_SCALE = 8.f, FP8_O_SCALE = 16.f;

template <bool OUT8> struct EpiSwiGLU {
    static constexpr bool PERM = true, AFTER_DRAIN = false;
    bf16_t* act; const rss_t* rss;
    __device__ __forceinline__ void operator()(const f32x4 (&acc)[2][2][4][2], const Unit& u, int wr, int wc, int fr, int fq) const {
        const int row0 = u.pm * BM + wr * 64 + fr, col0 = u.pn * 128 + wc * 32 + 8 * fq;
#pragma unroll
        for (int ai = 0; ai < 2; ++ai)
#pragma unroll
            for (int m = 0; m < 4; ++m) {
                const int row = row0 + ai * HALF + m * 16;
                const float rs = rstd_from_ss(rss[row]);
                f32x4 o[2];
#pragma unroll
                for (int n = 0; n < 2; ++n)
#pragma unroll
                    for (int j = 0; j < 4; ++j) o[n][j] = silu_f(acc[ai][0][m][n][j] * rs) * (acc[ai][1][m][n][j] * rs);
                if constexpr (OUT8) { typedef unsigned u32x2 __attribute__((ext_vector_type(2))); *(u32x2*)((unsigned char*)act + (size_t)row * DFF + col0) = (u32x2){pack_fp8x4(o[0] * FP8_ACT_SCALE), pack_fp8x4(o[1] * FP8_ACT_SCALE)}; }
                else *(u32x4*)(act + (size_t)row * DFF + col0) = pack8(o[0], o[1]);
            }
    }
};

struct EpiResid {
    static constexpr bool PERM = true, AFTER_DRAIN = false;
    const float* base; float* out; bf16_t* hb; unsigned char* hb8; rss_t* rss_out; float scale;
    __device__ __forceinline__ void operator()(const f32x4 (&acc)[2][2][4][2], const Unit& u, int wr, int wc, int fr, int fq) const {
        const int lane = fq * 16 + fr;
        const int row0 = u.pm * BM + wr * 64 + fr, colb = u.pn * BM + wc * 32 + 8 * fq;
#pragma unroll
        for (int ai = 0; ai < 2; ++ai) {
            float sel = 0.f;
            f32x4 bv[4][2][2];
#pragma unroll
            for (int m = 0; m < 4; ++m)
#pragma unroll
                for (int bj = 0; bj < 2; ++bj) { const size_t o = (size_t)(row0 + ai * HALF + m * 16) * DM + colb + bj * HALF;
                    bv[m][bj][0] = *(const f32x4*)(base + o); bv[m][bj][1] = *(const f32x4*)(base + o + 4); }
#pragma unroll
            for (int m = 0; m < 4; ++m) {
                const size_t ro = (size_t)(row0 + ai * HALF + m * 16) * DM + colb;
                float ss = 0.f;
#pragma unroll
                for (int bj = 0; bj < 2; ++bj) {
                    const size_t o = ro + bj * HALF;
                    const f32x4 v0 = bv[m][bj][0] + acc[ai][bj][m][0] * scale, v1 = bv[m][bj][1] + acc[ai][bj][m][1] * scale;
                    *(f32x4*)(out + o) = v0; *(f32x4*)(out + o + 4) = v1;
                    if (hb) *(u32x4*)(hb + o) = pack8(v0, v1);
                    if (hb8) { typedef unsigned u32x2 __attribute__((ext_vector_type(2))); *(u32x2*)(hb8 + o) = (u32x2){pack_fp8x4(v0 * FP8_H_SCALE), pack_fp8x4(v1 * FP8_H_SCALE)}; }
                    ss += (v0[0] * v0[0] + v0[1] * v0[1]) + (v0[2] * v0[2] + v0[3] * v0[3]) + (v1[0] * v1[0] + v1[1] * v1[1]) + (v1[2] * v1[2] + v1[3] * v1[3]);
                }
                ss += __shfl_xor(ss, 16); ss += __shfl_xor(ss, 32);
                sel = (fq == m) ? ss : sel;
            }
            rss_add(rss_out + u.pm * BM + ai * HALF + wr * 64 + lane, sel);
            asm volatile("" ::: "memory");
        }
    }
};

struct EpiConvIn {
    static constexpr bool PERM = true, AFTER_DRAIN = false;
    bf16_t* bbuf; bf16_t* ubuf; const rss_t* rss;
    __device__ __forceinline__ void operator()(const f32x4 (&acc)[2][2][4][2], const Unit& u, int wr, int wc, int fr, int fq) const {
        const int row0 = u.pm * BM + wr * 64 + fr;
        if (u.pn < 32) {
            const int col0 = u.pn * 128 + wc * 32 + 8 * fq;
#pragma unroll
            for (int ai = 0; ai < 2; ++ai)
#pragma unroll
                for (int m = 0; m < 4; ++m) {
                    const int row = row0 + ai * HALF + m * 16;
                    const float rs = rstd_from_ss(rss[row]);
                    f32x4 o[2];
#pragma unroll
                    for (int n = 0; n < 2; ++n) o[n] = (acc[ai][0][m][n] * rs) * (acc[ai][1][m][n] * rs);
                    *(u32x4*)(ubuf + (size_t)row * DM + col0) = pack8(o[0], o[1]);
                }
        } else {
            const int colb = (u.pn - 32) * BM + wc * 32 + 8 * fq;
#pragma unroll
            for (int ai = 0; ai < 2; ++ai)
#pragma unroll
                for (int m = 0; m < 4; ++m) {
                    const int row = row0 + ai * HALF + m * 16;
                    const float rs = rstd_from_ss(rss[row]);
#pragma unroll
                    for (int bj = 0; bj < 2; ++bj) *(u32x4*)(bbuf + (size_t)row * DM + colb + bj * HALF) = pack8(acc[ai][bj][m][0] * rs, acc[ai][bj][m][1] * rs);
                }
        }
    }
};

struct EpiQKV {
    static constexpr bool PERM = true, AFTER_DRAIN = false;
    bf16_t* q; bf16_t* k; bf16_t* v; const rss_t* rss; float cs;
    __device__ __forceinline__ void operator()(const f32x4 (&acc)[2][2][4][2], const Unit& u, int wr, int wc, int fr, int fq) const {
        const int row0 = u.pm * BM + wr * 64 + fr;
        bf16_t* dst; int ld, colb; const bool isq = u.pn < 16;
        if (isq) { dst = q; ld = DM; colb = u.pn * BM; } else if (u.pn < 20) { dst = k; ld = NKV * HD; colb = (u.pn - 16) * BM; } else { dst = v; ld = NKV * HD; colb = (u.pn - 20) * BM; }
        colb += wc * 32 + 8 * fq;
#pragma unroll
        for (int ai = 0; ai < 2; ++ai)
#pragma unroll
            for (int m = 0; m < 4; ++m) {
                const int row = row0 + ai * HALF + m * 16;
                const float rs = rstd_from_ss(rss[row]) * cs;
                const int drow = isq ? row : kv_row_of_real(row);
#pragma unroll
                for (int bj = 0; bj < 2; ++bj) *(u32x4*)(dst + (size_t)drow * ld + colb + bj * HALF) = pack8(acc[ai][bj][m][0] * rs, acc[ai][bj][m][1] * rs);
            }
    }
};

template <class Epi, class Sched, bool ALIGN_EPI = false, bool SP2 = false, bool FP8 = false>
__device__ __forceinline__ void gemm_phase(PG8_LAS unsigned char* lds, const Gemm g, const Sched& S, const Epi& E, const int wid) {
    int lane; asm volatile("v_mbcnt_lo_u32_b32 %0, -1, 0\n\tv_mbcnt_hi_u32_b32 %0, -1, %0" : "=v"(lane));
    const int tid = wid * 64 + lane, wr = wid >> 2, wc = wid & 3, fr = lane & 15, fq = lane >> 4;
    const int KB = FP8 ? g.K : 2 * g.K, nt = KB / (BK * 2);
    unsigned voffA[2], voffB[2];
#pragma unroll
    for (int i = 0; i < 2; ++i) { int R, C; stage_rc(tid * 16 + i * 8192, R, C); const int Rb = Epi::PERM ? ((R & ~31) + perm32(R & 31)) : R;
        voffA[i] = (unsigned)(R * KB + C * 2); voffB[i] = (unsigned)(Rb * KB + C * 2); }
    const size_t kstep = (size_t)(BK * 2);
    const size_t hstep = (size_t)HALF * KB;
    const size_t tstep = 2 * hstep;
    const unsigned ldsw = (unsigned)wid * 1024u;
    const int aoff = lds_byte(wr * 64 + fr, fq * 8), boff = lds_byte(wc * 32 + fr, fq * 8);
#define PG8_SA(b, h) (((b) * 2 + (h)) * HTB)
#define PG8_SB(b, h) ((4 + (b) * 2 + (h)) * HTB)
#define PG8_STAGE(bufoff, gbase, voff) do { _Pragma("unroll") for (int _i = 0; _i < 2; ++_i) \
        __builtin_amdgcn_global_load_lds((const unsigned*)((const char*)(gbase) + (voff)[_i]), (PG8_LAS unsigned*)(lds + (bufoff) + ldsw + _i * 8192), 16, 0, 0); } while (0)
#define PG8_LDA(dst, b, h) do { _Pragma("unroll") for (int m = 0; m < 4; ++m) _Pragma("unroll") for (int k = 0; k < 2; ++k) dst[m][k] = *(const PG8_LAS bf16x8*)(lds + PG8_SA(b, h) + aoff + m * 2048 + k * 1024); } while (0)
#define PG8_LDB(dst, b, h) do { _Pragma("unroll") for (int n = 0; n < 2; ++n) _Pragma("unroll") for (int k = 0; k < 2; ++k) dst[n][k] = *(const PG8_LAS bf16x8*)(lds + PG8_SB(b, h) + boff + n * 2048 + k * 1024); } while (0)
#define PG8_MMA(ai, bj, At, Bt) do { __builtin_amdgcn_s_setprio(1); if constexpr (FP8) { _Pragma("unroll") for (int m = 0; m < 4; ++m) _Pragma("unroll") for (int n = 0; n < 2; ++n) \
        asm volatile("v_mfma_f32_16x16x128_f8f6f4 %0, %1, %2, %0" : "+v"(acc[ai][bj][m][n]) : "v"(cat8(Bt[n][0], Bt[n][1])), "v"(cat8(At[m][0], At[m][1]))); } \
        else { _Pragma("unroll") for (int m = 0; m < 4; ++m) _Pragma("unroll") for (int n = 0; n < 2; ++n) _Pragma("unroll") for (int k = 0; k < 2; ++k) \
        acc[ai][bj][m][n] = __builtin_amdgcn_mfma_f32_16x16x32_bf16(Bt[n][k], At[m][k], acc[ai][bj][m][n], 0, 0, 0); } __builtin_amdgcn_s_setprio(0); } while (0)
#define PG8_WAIT_V(n) asm volatile("s_waitcnt vmcnt(" #n ")" ::: "memory")
#define PG8_WAIT_L(n) asm volatile("s_waitcnt lgkmcnt(" #n ")" ::: "memory")
#define PG8_BAR __builtin_amdgcn_s_barrier()
#define PG8_SCHED __builtin_amdgcn_sched_barrier(0)
    Unit cur, nxt; int ui = 0;
    if (!S.next(0, cur)) return;
    f32x4 acc[2][2][4][2];
#pragma unroll
    for (int a = 0; a < 2; ++a)
#pragma unroll
        for (int b = 0; b < 2; ++b)
#pragma unroll
            for (int m = 0; m < 4; ++m)
#pragma unroll
                for (int n = 0; n < 2; ++n) acc[a][b][m][n] = (f32x4){0.f, 0.f, 0.f, 0.f};
    bf16x8 At[4][2], B0[2][2], B1[2][2];
    const char* cA = (const char*)g.A + (size_t)cur.pm * tstep; const char* cB = (const char*)g.Bt + (size_t)cur.pn * tstep;
    S.a_ready(cur);
    if constexpr (SP2) {
        PG8_STAGE(PG8_SB(0, 0), cB, voffB); PG8_STAGE(PG8_SB(0, 1), cB + hstep, voffB); PG8_STAGE(PG8_SA(0, 0), cA, voffA); PG8_STAGE(PG8_SA(0, 1), cA + hstep, voffA);
        if (wr == 1) PG8_BAR;
        PG8_WAIT_V(2); PG8_BAR;
        PG8_STAGE(PG8_SB(1, 0), cB + kstep, voffB); PG8_STAGE(PG8_SA(1, 0), cA + kstep, voffA); PG8_STAGE(PG8_SB(1, 1), cB + hstep + kstep, voffB);
        PG8_WAIT_V(6); PG8_BAR;
    } else {
        PG8_STAGE(PG8_SB(0, 0), cB, voffB); PG8_STAGE(PG8_SA(0, 0), cA, voffA); PG8_STAGE(PG8_SB(0, 1), cB + hstep, voffB); PG8_STAGE(PG8_SA(0, 1), cA + hstep, voffA);
        if (wr == 1) PG8_BAR;
        PG8_WAIT_V(4); PG8_BAR;
        PG8_STAGE(PG8_SB(1, 0), cB + kstep, voffB); PG8_STAGE(PG8_SA(1, 0), cA + kstep, voffA); PG8_STAGE(PG8_SB(1, 1), cB + hstep + kstep, voffB);
        PG8_WAIT_V(6); PG8_BAR;
    }
    for (;;) {
        const bool has_next = S.next(ui + 1, nxt);
        const char* nA = has_next ? (const char*)g.A + (size_t)nxt.pm * tstep : cA; const char* nB = has_next ? (const char*)g.Bt + (size_t)nxt.pn * tstep : cB;
        for (int t = 0; t < nt; t += 2) {
            const bool last = (t == nt - 2);
            const char* a1 = cA + (size_t)(t + 1) * kstep;
            const char* a2 = last ? nA : cA + (size_t)(t + 2) * kstep; const char* b2 = last ? nB : cB + (size_t)(t + 2) * kstep;
            const char* a3 = a2 + kstep; const char* b3 = b2 + kstep;
            if (last && has_next) S.a_ready(nxt);
            if constexpr (SP2) {
            PG8_LDB(B0, 0, 0); PG8_LDB(B1, 0, 1); PG8_SCHED; PG8_LDA(At, 0, 0); PG8_STAGE(PG8_SA(1, 1), a1 + hstep, voffA);
            PG8_WAIT_V(8); PG8_WAIT_L(0); PG8_BAR; PG8_MMA(0, 0, At, B0); PG8_MMA(0, 1, At, B1); PG8_BAR; PG8_SCHED;
            PG8_LDA(At, 0, 1); PG8_STAGE(PG8_SB(0, 0), b2, voffB); PG8_STAGE(PG8_SB(0, 1), b2 + hstep, voffB); PG8_STAGE(PG8_SA(0, 0), a2, voffA);
            PG8_WAIT_V(8); PG8_WAIT_L(0); PG8_BAR; PG8_MMA(1, 0, At, B0); PG8_MMA(1, 1, At, B1); PG8_BAR; PG8_SCHED;
            PG8_LDB(B0, 1, 0); PG8_LDB(B1, 1, 1); PG8_SCHED; PG8_LDA(At, 1, 0); PG8_STAGE(PG8_SA(0, 1), a2 + hstep, voffA);
            PG8_WAIT_V(8); PG8_WAIT_L(0); PG8_BAR; PG8_MMA(0, 0, At, B0); PG8_MMA(0, 1, At, B1); PG8_BAR; PG8_SCHED;
            PG8_LDA(At, 1, 1); PG8_STAGE(PG8_SB(1, 0), b3, voffB); PG8_STAGE(PG8_SB(1, 1), b3 + hstep, voffB); PG8_STAGE(PG8_SA(1, 0), a3, voffA);
            PG8_WAIT_V(8); PG8_WAIT_L(0); PG8_BAR; PG8_MMA(1, 0, At, B0); PG8_MMA(1, 1, At, B1); PG8_BAR; PG8_SCHED;
            } else {
            PG8_LDB(B0, 0, 0); PG8_SCHED; PG8_LDA(At, 0, 0); PG8_STAGE(PG8_SA(1, 1), a1 + hstep, voffA);
            PG8_WAIT_L(8); PG8_BAR; PG8_WAIT_L(0); PG8_MMA(0, 0, At, B0); PG8_BAR; PG8_SCHED;
            PG8_LDB(B1, 0, 1); PG8_STAGE(PG8_SB(0, 0), b2, voffB);
            PG8_BAR; PG8_WAIT_L(0); PG8_MMA(0, 1, At, B1); PG8_BAR;
            PG8_LDA(At, 0, 1); PG8_STAGE(PG8_SA(0, 0), a2, voffA);
            PG8_BAR; PG8_WAIT_L(0); PG8_MMA(1, 0, At, B0); PG8_BAR; PG8_SCHED;
            PG8_STAGE(PG8_SB(0, 1), b2 + hstep, voffB);
            PG8_WAIT_V(6); PG8_BAR; PG8_MMA(1, 1, At, B1); PG8_BAR;
            PG8_LDB(B0, 1, 0); PG8_SCHED; PG8_LDA(At, 1, 0); PG8_STAGE(PG8_SA(0, 1), a2 + hstep, voffA);
            PG8_WAIT_L(8); PG8_BAR; PG8_WAIT_L(0); PG8_MMA(0, 0, At, B0); PG8_BAR; PG8_SCHED;
            PG8_LDB(B1, 1, 1); PG8_STAGE(PG8_SB(1, 0), b3, voffB);
            PG8_BAR; PG8_WAIT_L(0); PG8_MMA(0, 1, At, B1); PG8_BAR;
            PG8_LDA(At, 1, 1); PG8_STAGE(PG8_SA(1, 0), a3, voffA);
            PG8_BAR; PG8_WAIT_L(0); PG8_MMA(1, 0, At, B0); PG8_BAR; PG8_SCHED;
            PG8_STAGE(PG8_SB(1, 1), b3 + hstep, voffB);
            PG8_WAIT_V(6); PG8_BAR; PG8_MMA(1, 1, At, B1); PG8_BAR;
            }
        }
        if constexpr (FP8) {
            asm volatile("s_nop 15\n\ts_nop 15" : "+v"(At[0][0]), "+v"(At[0][1]), "+v"(At[1][0]), "+v"(At[1][1]), "+v"(At[2][0]), "+v"(At[2][1]), "+v"(At[3][0]), "+v"(At[3][1]),
                         "+v"(B0[0][0]), "+v"(B0[0][1]), "+v"(B0[1][0]), "+v"(B0[1][1]), "+v"(B1[0][0]), "+v"(B1[0][1]), "+v"(B1[1][0]), "+v"(B1[1][1]) :: "memory");
        }
        if constexpr (ALIGN_EPI) { if (wr == 0) PG8_BAR; }
        if constexpr (FP8) {
            asm volatile("s_nop 15\n\ts_nop 15\n\ts_nop 7" : "+v"(acc[1][1][0][0]), "+v"(acc[1][1][0][1]), "+v"(acc[1][1][1][0]), "+v"(acc[1][1][1][1]), "+v"(acc[1][1][2][0]), "+v"(acc[1][1][2][1]), "+v"(acc[1][1][3][0]), "+v"(acc[1][1][3][1]) :: "memory");
            asm volatile("" : "+v"(acc[1][0][0][0]), "+v"(acc[1][0][0][1]), "+v"(acc[1][0][1][0]), "+v"(acc[1][0][1][1]), "+v"(acc[1][0][2][0]), "+v"(acc[1][0][2][1]), "+v"(acc[1][0][3][0]), "+v"(acc[1][0][3][1]));
        }
        if constexpr (!Epi::AFTER_DRAIN) { E(acc, cur, wr, wc, fr, fq); S.done(cur); }
        if (!has_next) break;
#pragma unroll
        for (int a = 0; a < 2; ++a)
#pragma unroll
            for (int b = 0; b < 2; ++b)
#pragma unroll
                for (int m = 0; m < 4; ++m)
#pragma unroll
                    for (int n = 0; n < 2; ++n) acc[a][b][m][n] = (f32x4){0.f, 0.f, 0.f, 0.f};
        cur = nxt; cA = nA; cB = nB; ++ui;
        if constexpr (ALIGN_EPI) { if (wr == 1) PG8_BAR; }
    }
    PG8_WAIT_V(0);
    if constexpr (!ALIGN_EPI) { if (wr == 0) PG8_BAR; }
    PG8_BAR;
    if constexpr (Epi::AFTER_DRAIN) { E.fused(acc, cur, wr, wc, fr, fq, lds, wid, lane); S.done(cur); }
#undef PG8_SA
#undef PG8_SB
#undef PG8_STAGE
#undef PG8_LDA
#undef PG8_LDB
#undef PG8_MMA
#undef PG8_WAIT_V
#undef PG8_WAIT_L
#undef PG8_BAR
#undef PG8_SCHED
}
}

namespace att {
typedef unsigned short bf16_t;
using bf16x8 = __attribute__((ext_vector_type(8))) short;
using s16x4  = __attribute__((ext_vector_type(4))) short;
using f32x16 = __attribute__((ext_vector_type(16))) float;
using u32x4  = __attribute__((ext_vector_type(4))) unsigned;
using f32x4  = __attribute__((ext_vector_type(4))) float;
constexpr int D = 128, NW = 8, QBLK = 32, KVBLK = 64;
constexpr float SCALE = 0.088388347648318440f;
constexpr float THR = 8.f;
constexpr int LDQ = NHEAD * HD, LDK = NKV * HD, LDO = NHEAD * HD;
constexpr int SHM_V = KVBLK * D * 2, SHM_K = KVBLK * D * 2, SHM_ATTN = 2 * SHM_V + 2 * SHM_K + NW * 64 * 4;
constexpr int NT = KVROWS / KVBLK;
static_assert(NT % 2 == 1 && NT >= 3, "the loop below is written for an odd tile count");
#define KSWZ(row, colB) ((row) * 256 + ((colB) ^ (((row) & 7) << 4)))
#define SBAR() __builtin_amdgcn_sched_barrier(0)
__device__ __forceinline__ int crow(int r, int hi) { return (r & 3) + 8 * (r >> 2) + 4 * hi; }
__device__ __forceinline__ unsigned cvtpk(float lo, float hi) { unsigned r; asm volatile("v_cvt_pk_bf16_f32 %0, %1, %2" : "=v"(r) : "v"(lo), "v"(hi)); return r; }

__device__ __forceinline__ void partialSM(f32x16& p0, f32x16& p1, float& m_reg, float& mn, float& alpha) {
  constexpr float C = SCALE * 1.4426950408889634f;
  float pmax = p0[0];
#pragma unroll
  for (int r = 1; r < 16; ++r) pmax = fmaxf(pmax, p0[r]);
#pragma unroll
  for (int r = 0; r < 16; ++r) pmax = fmaxf(pmax, p1[r]);
  { auto rr = __builtin_amdgcn_permlane32_swap(__float_as_uint(pmax), __float_as_uint(pmax), false, false);
    pmax = fmaxf(__uint_as_float(rr[0]), __uint_as_float(rr[1])); }
  if (__builtin_expect(__all(pmax - m_reg <= THR / SCALE), 1)) { mn = m_reg; alpha = 1.f; }
  else { mn = fmaxf(m_reg, pmax); alpha = __builtin_amdgcn_exp2f((m_reg - mn) * C); m_reg = mn; }
  float mnC = -mn * C;
#pragma unroll
  for (int r = 0; r < 16; ++r) p0[r] = fmaf(p0[r], C, mnC);
#pragma unroll
  for (int r = 0; r < 16; ++r) p1[r] = fmaf(p1[r], C, mnC);
#pragma unroll
  for (int r = 0; r < 16; ++r) p0[r] = __builtin_amdgcn_exp2f(p0[r]);
}
__device__ __forceinline__ void finishSM(f32x16& p0, f32x16& p1, float alpha, float& l_reg, bf16x8& pa0, bf16x8& pa1, bf16x8& pa2, bf16x8& pa3) {
#pragma unroll
  for (int r = 0; r < 16; ++r) p1[r] = __builtin_amdgcn_exp2f(p1[r]);
  float ps = 0;
#pragma unroll
  for (int r = 0; r < 16; ++r) ps += p0[r];
#pragma unroll
  for (int r = 0; r < 16; ++r) ps += p1[r];
  { auto rr = __builtin_amdgcn_permlane32_swap(__float_as_uint(ps), __float_as_uint(ps), false, false);
    ps = __uint_as_float(rr[0]) + __uint_as_float(rr[1]); }
  l_reg = l_reg * alpha + ps;
#define PK4(P, BASE, OUT) do { unsigned a0 = cvtpk(P[BASE + 0], P[BASE + 1]), a1 = cvtpk(P[BASE + 2], P[BASE + 3]);   \
    unsigned b0 = cvtpk(P[BASE + 4], P[BASE + 5]), b1 = cvtpk(P[BASE + 6], P[BASE + 7]);                              \
    auto r0 = __builtin_amdgcn_permlane32_swap(a0, b0, false, false); auto r1 = __builtin_amdgcn_permlane32_swap(a1, b1, false, false); \
    u32x4 w = {r0[0], r1[0], r0[1], r1[1]}; OUT = *reinterpret_cast<bf16x8*>(&w); } while (0)
  PK4(p0, 0, pa0); PK4(p0, 8, pa1); PK4(p1, 0, pa2); PK4(p1, 8, pa3);
#undef PK4
}
__device__ __forceinline__ void qkt(f32x16& p0, f32x16& p1, const bf16_t* Ks, const bf16x8* qr, int r32, int hi) {
  p0 = f32x16{}; p1 = f32x16{};
#pragma unroll
  for (int d0 = 0; d0 < 8; ++d0) { int cb = (d0 * 16 + hi * 8) * 2;
    bf16x8 b0 = *reinterpret_cast<const bf16x8*>((const char*)Ks + KSWZ(r32, cb));
    bf16x8 b1 = *reinterpret_cast<const bf16x8*>((const char*)Ks + KSWZ(32 + r32, cb));
    p0 = __builtin_amdgcn_mfma_f32_32x32x16_bf16(b0, qr[d0], p0, 0, 0, 0);
    p1 = __builtin_amdgcn_mfma_f32_32x32x16_bf16(b1, qr[d0], p1, 0, 0, 0); }
}
__device__ __forceinline__ int v_st(int k, int c) { const int kk = (k & ~0xC) | ((k & 4) << 1) | ((k & 8) >> 1); return ((kk >> 3) * 4 + (c >> 5)) * 512 + ((kk & 7) * 32 + (c & 31)) * 2; }
__device__ __forceinline__ int v_rd_base(int lane) { return ((lane & 3) << 3) | (((lane >> 2) & 3) << 6) | (((lane >> 4) & 1) << 5) | (((lane >> 5) & 1) << 8); }
constexpr int v_rd_off(int d0, int ks, int half) { return d0 * 512 + ks * 4096 + half * 2048; }
template <int OFF> __device__ __forceinline__ s16x4 tr_read(int vb) {
  s16x4 r; asm volatile("ds_read_b64_tr_b16 %0, %1 offset:%2" : "=&v"(r) : "v"(vb), "i"(OFF) : "memory"); return r;
}
template <int D0> __device__ __forceinline__ void pv_one(f32x16& od, int vb, bf16x8 pa0, bf16x8 pa1, bf16x8 pa2, bf16x8 pa3) {
  const s16x4 l0 = tr_read<v_rd_off(D0, 0, 0)>(vb), h0 = tr_read<v_rd_off(D0, 0, 1)>(vb), l1 = tr_read<v_rd_off(D0, 1, 0)>(vb), h1 = tr_read<v_rd_off(D0, 1, 1)>(vb);
  const s16x4 l2 = tr_read<v_rd_off(D0, 2, 0)>(vb), h2 = tr_read<v_rd_off(D0, 2, 1)>(vb), l3 = tr_read<v_rd_off(D0, 3, 0)>(vb), h3 = tr_read<v_rd_off(D0, 3, 1)>(vb);
  asm volatile("s_waitcnt lgkmcnt(0)" ::: "memory"); SBAR();
#define PK(L, H) (bf16x8){L[0], L[1], L[2], L[3], H[0], H[1], H[2], H[3]}
  od = __builtin_amdgcn_mfma_f32_32x32x16_bf16(pa0, PK(l0, h0), od, 0, 0, 0);
  od = __builtin_amdgcn_mfma_f32_32x32x16_bf16(pa1, PK(l1, h1), od, 0, 0, 0);
  od = __builtin_amdgcn_mfma_f32_32x32x16_bf16(pa2, PK(l2, h2), od, 0, 0, 0);
  od = __builtin_amdgcn_mfma_f32_32x32x16_bf16(pa3, PK(l3, h3), od, 0, 0, 0);
#undef PK
}
__device__ __forceinline__ void pv_d0(f32x16* o, int vb, bf16x8 pa0, bf16x8 pa1, bf16x8 pa2, bf16x8 pa3) {
  pv_one<0>(o[0], vb, pa0, pa1, pa2, pa3); pv_one<1>(o[1], vb, pa0, pa1, pa2, pa3); pv_one<2>(o[2], vb, pa0, pa1, pa2, pa3); pv_one<3>(o[3], vb, pa0, pa1, pa2, pa3);
}

__device__ __forceinline__ int lane_id_asm() { int l; asm volatile("v_mbcnt_lo_u32_b32 %0, -1, 0\n\tv_mbcnt_hi_u32_b32 %0, -1, %0" : "=v"(l)); return l; }
template <bool O8> __device__ __forceinline__ void attn_unit(const bf16_t* __restrict__ Qb, const bf16_t* __restrict__ Kh, const bf16_t* __restrict__ Vh, void* __restrict__ Ob, char* lds, const int wid, const float* __restrict__ qg, const int t0) {
  const int lane = lane_id_asm(), tid = wid * 64 + lane, r32 = lane & 31, hi = lane >> 5;
  bf16_t* V_lds = (bf16_t*)lds; bf16_t* K_lds = (bf16_t*)(lds + 2 * SHM_V);
  float* ws = (float*)(lds + 2 * SHM_V + 2 * SHM_K) + wid * 64; float* li_l = ws; float* al_l = ws + 32;
  float m_reg = -1e30f, l_reg = 0; f32x16 o[4] = {}; bf16x8 qr[8];
  __syncthreads();
  { const unsigned qoff = (unsigned)((wid * QBLK + r32) * LDQ + hi * 8) * 2u;
#pragma unroll
    for (int d0 = 0; d0 < 8; ++d0) qr[d0] = *reinterpret_cast<const bf16x8*>((const char*)Qb + qoff + d0 * 32); }
  { float xf[8][8]; float ss = 0.f;
#pragma unroll
    for (int d0 = 0; d0 < 8; ++d0)
#pragma unroll
      for (int k = 0; k < 8; ++k) { xf[d0][k] = __uint_as_float((unsigned)(unsigned short)qr[d0][k] << 16); ss += xf[d0][k] * xf[d0][k]; }
    { auto rr = __builtin_amdgcn_permlane32_swap(__float_as_uint(ss), __float_as_uint(ss), false, false); ss = __uint_as_float(rr[0]) + __uint_as_float(rr[1]); }
    const float rs = __builtin_amdgcn_rsqf(ss * (1.0f / (float)D) + RMS_EPS);
#pragma unroll
    for (int d0 = 0; d0 < 8; ++d0) { const f32x4 g0 = *(const f32x4*)(qg + 16 * d0 + 8 * hi), g1 = *(const f32x4*)(qg + 16 * d0 + 8 * hi + 4);
#pragma unroll
      for (int k = 0; k < 4; ++k) { xf[d0][k] *= rs * g0[k]; xf[d0][4 + k] *= rs * g1[k]; } }
    const int t = t0 + wid * QBLK + r32; const float pos[2] = {(float)(t >> 6), (float)(t & 63)};
#pragma unroll
    for (int ax = 0; ax < 2; ++ax)
#pragma unroll
      for (int dd = 0; dd < 2; ++dd)
#pragma unroll
        for (int k = 0; k < 8; ++k) {
          const float inv_freq = __builtin_amdgcn_exp2f(-(float)(16 * dd + 8 * hi + k) * 0.41524101186092029f);
          const float rev = pos[ax] * inv_freq * 0.15915494309189535f, c = __builtin_amdgcn_cosf(rev), s = __builtin_amdgcn_sinf(rev);
          const float y1 = xf[4 * ax + dd][k], y2 = xf[4 * ax + dd + 2][k];
          xf[4 * ax + dd][k] = y1 * c - y2 * s; xf[4 * ax + dd + 2][k] = y2 * c + y1 * s; }
#pragma unroll
    for (int d0 = 0; d0 < 8; ++d0) { u32x4 w = {cvtpk(xf[d0][0], xf[d0][1]), cvtpk(xf[d0][2], xf[d0][3]), cvtpk(xf[d0][4], xf[d0][5]), cvtpk(xf[d0][6], xf[d0][7])}; qr[d0] = *reinterpret_cast<bf16x8*>(&w); }
  }
  const int sr = tid >> 4, sc = (tid & 15) * 8, vst0 = v_st(sr, sc), vst1 = v_st(32 + sr, sc);
  const int vb0 = (int)(uintptr_t)V_lds + v_rd_base(lane);
  struct { bf16x8 vs0, vs1, ks0, ks1; } sr_[2];
#define LD8(p) (*reinterpret_cast<const bf16x8*>(p))
  const unsigned goff0 = (unsigned)(sr * LDK + sc) * 2u, goff1 = goff0 + 32u * LDK * 2u;
#define SLOAD(i, k0) do { const char* vt_ = (const char*)Vh + (size_t)(k0) * (LDK * 2); const char* kt_ = (const char*)Kh + (size_t)(k0) * (LDK * 2); \
    sr_[i].vs0 = LD8(vt_ + goff0); sr_[i].vs1 = LD8(vt_ + goff1); sr_[i].ks0 = LD8(kt_ + goff0); sr_[i].ks1 = LD8(kt_ + goff1); } while (0)
#define SWRITE(b, i) do { *(bf16x8*)((char*)V_lds + (b) * SHM_V + vst0) = sr_[i].vs0;          \
    *(bf16x8*)((char*)V_lds + (b) * SHM_V + vst1) = sr_[i].vs1; int kc = sc * 2;               \
    *(bf16x8*)((char*)K_lds + (b) * SHM_K + KSWZ(sr, kc)) = sr_[i].ks0;                       \
    *(bf16x8*)((char*)K_lds + (b) * SHM_K + KSWZ(32 + sr, kc)) = sr_[i].ks1; } while (0)
#define SWAIT() asm volatile("s_waitcnt vmcnt(4)" ::: "memory")
#define RESC(a) do { if (__any((a) < 1.f)) { if (hi == 0) al_l[r32] = (a); asm volatile("s_waitcnt lgkmcnt(0)" ::: "memory"); \
    _Pragma("unroll") for (int d = 0; d < 4; ++d) _Pragma("unroll") for (int r = 0; r < 16; ++r) o[d][r] *= al_l[crow(r, hi)]; } } while (0)
  f32x16 pA0, pA1, pB0, pB1; float mnA, mnB, alA, alB; bf16x8 pa0, pa1, pa2, pa3;
  constexpr int SE = 0, SO = 1;
  SLOAD(SE, 0); asm volatile("s_waitcnt vmcnt(0)" ::: "memory"); SWRITE(0, SE); __syncthreads();
  qkt(pA0, pA1, K_lds, qr, r32, hi);
#pragma unroll
  for (int r = 8; r < 16; ++r) pA0[r] = -INFINITY;
#pragma unroll
  for (int r = 0; r < 16; ++r) pA1[r] = -INFINITY;
  partialSM(pA0, pA1, m_reg, mnA, alA);
  SLOAD(SO, KVBLK); SLOAD(SE, 2 * KVBLK);
  SWAIT(); SWRITE(1, SO); __syncthreads();
  for (int j = 1; j + 1 < NT; j += 2) {
    SBAR(); qkt(pB0, pB1, (bf16_t*)((char*)K_lds + SHM_K), qr, r32, hi);
    finishSM(pA0, pA1, alA, l_reg, pa0, pa1, pa2, pa3); SBAR();
    if (j + 2 < NT) SLOAD(SO, (j + 2) * KVBLK); SBAR();
    pv_d0(o, vb0, pa0, pa1, pa2, pa3); partialSM(pB0, pB1, m_reg, mnB, alB);
    __syncthreads(); SWAIT(); SWRITE(0, SE);
    RESC(alB); __syncthreads();
    SBAR(); qkt(pA0, pA1, K_lds, qr, r32, hi);
    finishSM(pB0, pB1, alB, l_reg, pa0, pa1, pa2, pa3); SBAR();
    if (j + 3 < NT) SLOAD(SE, (j + 3) * KVBLK); SBAR();
    pv_d0(o, vb0 + (int)SHM_V, pa0, pa1, pa2, pa3); partialSM(pA0, pA1, m_reg, mnA, alA);
    __syncthreads(); SWAIT(); if (j + 2 < NT) SWRITE(1, SO);
    RESC(alA); __syncthreads();
  }
  finishSM(pA0, pA1, alA, l_reg, pa0, pa1, pa2, pa3); SBAR();
  pv_d0(o, vb0, pa0, pa1, pa2, pa3);
  if (hi == 0) li_l[r32] = l_reg; asm volatile("s_waitcnt lgkmcnt(0)" ::: "memory");
  float rli[16];
#pragma unroll
  for (int r = 0; r < 16; ++r) rli[r] = __builtin_amdgcn_rcpf(li_l[crow(r, hi)]);
  { const int l2 = lane_id_asm(), c32 = l2 & 31, h2 = l2 >> 5;
    if constexpr (O8) { unsigned char* Ow = (unsigned char*)Ob + (size_t)(wid * QBLK) * LDO;
#pragma unroll
      for (int r = 0; r < 16; ++r) { const unsigned ooff = (unsigned)(crow(r, h2) * LDO + c32);
#pragma unroll
        for (int d0 = 0; d0 < 4; ++d0) { const float v = __builtin_amdgcn_fmed3f(o[d0][r] * rli[r] * pg8::FP8_O_SCALE, -448.f, 448.f); Ow[ooff + d0 * 32] = (unsigned char)(__builtin_amdgcn_cvt_pk_fp8_f32(v, 0.f, 0, false) & 0xff); } } }
    else { char* Ow = (char*)Ob + (size_t)(wid * QBLK) * (LDO * 2);
#pragma unroll
      for (int r = 0; r < 16; ++r) { const unsigned ooff = (unsigned)(crow(r, h2) * LDO + c32) * 2u;
#pragma unroll
        for (int d0 = 0; d0 < 4; ++d0) *(bf16_t*)(Ow + ooff + d0 * 64) = (bf16_t)(cvtpk(o[d0][r] * rli[r], 0.f) & 0xffffu); } } }
#undef LD8
#undef SLOAD
#undef SWRITE
#undef SWAIT
#undef RESC
}
#undef KSWZ
}


namespace att8 {
using att::f32x16; using att::f32x4; using att::u32x4; using att::crow; using att::lane_id_asm;
typedef int i32x8 __attribute__((ext_vector_type(8)));
typedef int i32x4 __attribute__((ext_vector_type(4)));
constexpr int D = 128, NW = 8, QBLK = 32, KVBLK = 64, NT = att::NT;
constexpr float FP8_K_SCALE = 0.5f, FP8_Q_SCALE = att::SCALE * 1.4426950408889634f * 2.0f;
constexpr float FP8_KQ_SCALE = FP8_K_SCALE;
constexpr float FP8_V_SCALE = 16.f, FP8_P_LOG2 = 4.f, THR_LOG2 = 4.f;
constexpr int LDQ = NHEAD * HD, LDK8 = NKV * HD, LDO = NHEAD * HD;
constexpr int SHM_K = KVBLK * D, SHM_V = KVBLK * D, NSLOT = 4, SHM_ATTN8 = NSLOT * SHM_K + NSLOT * SHM_V + NW * 64 * 4;
#define SBAR8() __builtin_amdgcn_sched_barrier(0)
#define MFMA8(acc, a, b) asm volatile("v_mfma_f32_32x32x64_f8f6f4 %0, %1, %2, %0" : "+v"(acc) : "v"(a), "v"(b))
#define MFMA8N(dst, a, b, c) asm volatile("v_mfma_f32_32x32x64_f8f6f4 %0, %1, %2, %3" : "=&v"(dst) : "v"(a), "v"(b), "v"(c))
__device__ __forceinline__ i32x8 cat(const i32x4 x, const i32x4 y) { return (i32x8){x[0], x[1], x[2], x[3], y[0], y[1], y[2], y[3]}; }
__device__ __forceinline__ int k8_pos(int e) { const int d0 = e >> 4, hi = (e >> 3) & 1, k = e & 7; return (d0 >> 2) * 64 + hi * 32 + (d0 & 3) * 8 + k; }
__device__ __forceinline__ int v8_key(int j) { const int h = j >> 5, i = j & 31; return i < 16 ? crow(i, h) : 32 + crow(i - 16, h); }
__device__ __forceinline__ unsigned pk4(float a, float b, float c, float d) { int w = 0; w = __builtin_amdgcn_cvt_pk_fp8_f32(a, b, w, false); w = __builtin_amdgcn_cvt_pk_fp8_f32(c, d, w, true); return (unsigned)w; }
__device__ __forceinline__ unsigned pk4u(float a, float b, float c, float d) { int w; asm volatile("" : "=v"(w)); w = __builtin_amdgcn_cvt_pk_fp8_f32(a, b, w, false); w = __builtin_amdgcn_cvt_pk_fp8_f32(c, d, w, true); return (unsigned)w; }
__device__ __forceinline__ float sat8(float v) { return __builtin_amdgcn_fmed3f(v, -448.f, 448.f); }
__device__ __forceinline__ float max3f(float a, float b, float c) { float r; asm("v_max3_f32 %0, %1, %2, %3" : "=v"(r) : "v"(a), "v"(b), "v"(c)); return r; }

__device__ __forceinline__ void qkt8(f32x16& p0, f32x16& p1, const char* Ks, const i32x8 (&qf)[2], int r32, int hi) {
  p0 = f32x16{}; p1 = f32x16{};
#pragma unroll
  for (int s = 0; s < 2; ++s) {
    const int c0 = s * 4 + hi * 2;
#pragma unroll
    for (int hp = 0; hp < 2; ++hp) { const int key = hp * 32 + r32, swz = (key >> 1) & 7; const char* kr = Ks + key * 128;
      const i32x4 a0 = *reinterpret_cast<const i32x4*>(kr + ((c0 ^ swz) << 4)), a1 = *reinterpret_cast<const i32x4*>(kr + (((c0 + 1) ^ swz) << 4));
      if (hp == 0) MFMA8(p0, cat(a0, a1), qf[s]); else MFMA8(p1, cat(a0, a1), qf[s]); }
  }
}
__device__ __forceinline__ void pv8(f32x16* o, const char* Vs, const i32x8 pf, int r32, int hi) {
#pragma unroll
  for (int d0 = 0; d0 < 4; ++d0) { const int d = d0 * 32 + r32, swz = (d >> 2) & 3; const char* vr = Vs + d * 64;
    const i32x4 b0 = *reinterpret_cast<const i32x4*>(vr + (((hi * 2) ^ swz) << 4)), b1 = *reinterpret_cast<const i32x4*>(vr + (((hi * 2 + 1) ^ swz) << 4));
    MFMA8(o[d0], pf, cat(b0, b1)); }
}
__device__ __forceinline__ i32x8 kfrag8(const char* Ks, int hp, int s, int r32, int hi) { const int key = hp * 32 + r32, swz = (key >> 1) & 7, c0 = s * 4 + hi * 2; const char* kr = Ks + key * 128;
  return cat(*reinterpret_cast<const i32x4*>(kr + ((c0 ^ swz) << 4)), *reinterpret_cast<const i32x4*>(kr + (((c0 + 1) ^ swz) << 4))); }
__device__ __forceinline__ i32x8 vfrag8(const char* Vs, int d0, int r32, int hi) { const int d = d0 * 32 + r32, swz = (d >> 2) & 3; const char* vr = Vs + d * 64;
  return cat(*reinterpret_cast<const i32x4*>(vr + (((hi * 2) ^ swz) << 4)), *reinterpret_cast<const i32x4*>(vr + (((hi * 2 + 1) ^ swz) << 4))); }
#define MAXCH8(m_, p_) do { float b_; asm("v_max3_f32 %0, %2, %3, %4\n\tv_max3_f32 %1, %5, %6, %7\n\tv_max3_f32 %0, %0, %8, %9\n\tv_max3_f32 %1, %1, %10, %11\n\tv_max3_f32 %0, %0, %12, %13\n\tv_max3_f32 %1, %1, %14, %15\n\tv_max3_f32 %0, %0, %16, %17\n\tv_max_f32 %0, %0, %1" \
    : "=&v"(m_), "=&v"(b_) : "v"(p_[0]), "v"(p_[1]), "v"(p_[2]), "v"(p_[3]), "v"(p_[4]), "v"(p_[5]), "v"(p_[6]), "v"(p_[7]), "v"(p_[8]), "v"(p_[9]), "v"(p_[10]), "v"(p_[11]), "v"(p_[12]), "v"(p_[13]), "v"(p_[14]), "v"(p_[15])); } while (0)
#define STEP8(pC0, pC1, pP0, pP1, alC, KS, VS, JT) do { \
    const char* Kb_ = K_lds + (KS) * SHM_K; const char* Vb_ = V_lds + (VS) * SHM_V; \
    DMAK8((JT) + 2, ((KS) + 2) & 3); DMAV8((JT) + 1, ((VS) + 2) & 3); \
    i32x8 ka_ = kfrag8(Kb_, 0, 0, r32, hi), kb_ = kfrag8(Kb_, 1, 0, r32, hi), kc_ = kfrag8(Kb_, 0, 1, r32, hi); SBAR8();     \
    MFMA8N(pC0, ka_, qf[0], negm); \
    i32x8 kd_ = kfrag8(Kb_, 1, 1, r32, hi); _Pragma("unroll") for (int r_ = 0; r_ < 8; ++r_) pP1[r_] = __builtin_amdgcn_exp2f(pP1[r_]); SBAR8(); \
    MFMA8N(pC1, kb_, qf[0], negm); \
    i32x8 va_ = vfrag8(Vb_, 0, r32, hi); _Pragma("unroll") for (int r_ = 8; r_ < 16; ++r_) pP1[r_] = __builtin_amdgcn_exp2f(pP1[r_]); SBAR8(); \
    MFMA8(pC0, kc_, qf[1]); \
    i32x8 vb_ = vfrag8(Vb_, 1, r32, hi); _Pragma("unroll") for (int q_ = 0; q_ < 4; ++q_) { \
        pf[q_] = (int)pk4u(pP0[4 * q_], pP0[4 * q_ + 1], pP0[4 * q_ + 2], pP0[4 * q_ + 3]); pf[4 + q_] = (int)pk4u(pP1[4 * q_], pP1[4 * q_ + 1], pP1[4 * q_ + 2], pP1[4 * q_ + 3]); } SBAR8(); \
    MFMA8(pC1, kd_, qf[1]); \
    i32x8 vc_ = vfrag8(Vb_, 2, r32, hi); SBAR8(); \
    MFMA8(o[0], pf, va_); \
    i32x8 vd_ = vfrag8(Vb_, 3, r32, hi); float m0_; MAXCH8(m0_, pC0); SBAR8(); \
    MFMA8(o[1], pf, vb_); \
    float m1_; MAXCH8(m1_, pC1); float pmax_; asm("v_max_f32 %0, %1, %2" : "=v"(pmax_) : "v"(m0_), "v"(m1_)); \
    { auto rr_ = __builtin_amdgcn_permlane32_swap(__float_as_uint(pmax_), __float_as_uint(pmax_), false, false); asm("v_max_f32 %0, %1, %2" : "=v"(pmax_) : "v"(rr_[0]), "v"(rr_[1])); } \
    alC = 1.f; \
    if (__builtin_expect(!__all(pmax_ <= FP8_P_LOG2 + THR_LOG2), 0)) {     \
        const float d_ = fmaxf(pmax_ - FP8_P_LOG2, 0.f); alC = __builtin_amdgcn_exp2f(-d_); m_reg += d_; \
        _Pragma("unroll") for (int r_ = 0; r_ < 16; ++r_) { pC0[r_] -= d_; pC1[r_] -= d_; negm[r_] = FP8_P_LOG2 - m_reg; } } SBAR8(); \
    MFMA8(o[2], pf, vc_); \
    _Pragma("unroll") for (int r_ = 0; r_ < 16; ++r_) pC0[r_] = __builtin_amdgcn_exp2f(pC0[r_]); SBAR8(); \
    MFMA8(o[3], pf, vd_); \
    MFMA8(osum, pf, ones8);        \
    \
  } while (0)

template <bool WAITMFMA> __device__ __forceinline__ void partialSM8(f32x16& p0, f32x16& p1, float& m_reg, float& alpha) {
  if (WAITMFMA) asm volatile("s_nop 15\n\ts_nop 7" : "+v"(p0), "+v"(p1));
  float pa = max3f(p0[0], p0[1], p1[0]), pb = max3f(p0[2], p0[3], p1[1]); pa = max3f(pa, p1[2], p1[3]);
#pragma unroll
  for (int r = 4; r < 16; r += 4) { pa = max3f(pa, p0[r], p0[r + 1]); pb = max3f(pb, p0[r + 2], p0[r + 3]); pa = max3f(pa, p1[r], p1[r + 1]); pb = max3f(pb, p1[r + 2], p1[r + 3]); }
  float pmax = fmaxf(pa, pb);
  { auto rr = __builtin_amdgcn_permlane32_swap(__float_as_uint(pmax), __float_as_uint(pmax), false, false);
    pmax = fmaxf(__uint_as_float(rr[0]), __uint_as_float(rr[1])); }
  float mn;
  if (__builtin_expect(__all(pmax - m_reg <= THR_LOG2), 1)) { mn = m_reg; alpha = 1.f; }
  else { mn = fmaxf(m_reg, pmax); alpha = __builtin_amdgcn_exp2f(m_reg - mn); m_reg = mn; }
  const float mnC = FP8_P_LOG2 - mn;
#pragma unroll
  for (int r = 0; r < 16; ++r) p0[r] = __builtin_amdgcn_exp2f(p0[r] + mnC);
#pragma unroll
  for (int r = 0; r < 16; ++r) p1[r] += mnC;
}
__device__ __forceinline__ void finishSM8(f32x16& p0, f32x16& p1, i32x8& pf) {
#pragma unroll
  for (int r = 0; r < 16; ++r) p1[r] = __builtin_amdgcn_exp2f(p1[r]);
#pragma unroll
  for (int q = 0; q < 4; ++q) { pf[q] = (int)pk4(p0[4 * q], p0[4 * q + 1], p0[4 * q + 2], p0[4 * q + 3]); pf[4 + q] = (int)pk4(p1[4 * q], p1[4 * q + 1], p1[4 * q + 2], p1[4 * q + 3]); }
}

__device__ __forceinline__ void attn_unit8(const unsigned short* __restrict__ Qb, const unsigned char* __restrict__ Kh8, const unsigned char* __restrict__ Vt, unsigned char* __restrict__ Ob,
                                           char* lds, __attribute__((address_space(3))) unsigned char* ldsl, const int wid, const float* __restrict__ qg, const int t0) {
  const int lane = lane_id_asm(), tid = wid * 64 + lane, r32 = lane & 31, hi = lane >> 5;
  char* K_lds = lds; char* V_lds = lds + NSLOT * SHM_K;
  float* ws = (float*)(lds + NSLOT * SHM_K + NSLOT * SHM_V) + wid * 64; float* al_l = ws + 32;
  float m_reg = -1e30f; f32x16 o[4] = {}; f32x16 osum = {}; i32x8 qf[2];
  const i32x8 ones8 = {0x38383838, 0x38383838, 0x38383838, 0x38383838, 0x38383838, 0x38383838, 0x38383838, 0x38383838};
  __syncthreads();
  { att::bf16x8 qr[8];
    const unsigned qoff = (unsigned)((wid * QBLK + r32) * LDQ + hi * 8) * 2u;
#pragma unroll
    for (int d0 = 0; d0 < 8; ++d0) qr[d0] = *reinterpret_cast<const att::bf16x8*>((const char*)Qb + qoff + d0 * 32);
    float xf[8][8]; float ss = 0.f;
#pragma unroll
    for (int d0 = 0; d0 < 8; ++d0)
#pragma unroll
      for (int k = 0; k < 8; ++k) { xf[d0][k] = __uint_as_float((unsigned)(unsigned short)qr[d0][k] << 16); ss += xf[d0][k] * xf[d0][k]; }
    { auto rr = __builtin_amdgcn_permlane32_swap(__float_as_uint(ss), __float_as_uint(ss), false, false); ss = __uint_as_float(rr[0]) + __uint_as_float(rr[1]); }
    const float rs = __builtin_amdgcn_rsqf(ss * (1.0f / (float)D) + RMS_EPS) * FP8_Q_SCALE;
#pragma unroll
    for (int d0 = 0; d0 < 8; ++d0) { const f32x4 g0 = *(const f32x4*)(qg + 16 * d0 + 8 * hi), g1 = *(const f32x4*)(qg + 16 * d0 + 8 * hi + 4);
#pragma unroll
      for (int k = 0; k < 4; ++k) { xf[d0][k] *= rs * g0[k]; xf[d0][4 + k] *= rs * g1[k]; } }
    const int t = t0 + wid * QBLK + r32; const float pos[2] = {(float)(t >> 6), (float)(t & 63)};
#pragma unroll
    for (int ax = 0; ax < 2; ++ax)
#pragma unroll
      for (int dd = 0; dd < 2; ++dd)
#pragma unroll
        for (int k = 0; k < 8; ++k) {
          const float inv_freq = __builtin_amdgcn_exp2f(-(float)(16 * dd + 8 * hi + k) * 0.41524101186092029f);
          const float rev = pos[ax] * inv_freq * 0.15915494309189535f, c = __builtin_amdgcn_cosf(rev), s = __builtin_amdgcn_sinf(rev);
          const float y1 = xf[4 * ax + dd][k], y2 = xf[4 * ax + dd + 2][k];
          xf[4 * ax + dd][k] = y1 * c - y2 * s; xf[4 * ax + dd + 2][k] = y2 * c + y1 * s; }
#pragma unroll
    for (int s = 0; s < 2; ++s)
#pragma unroll
      for (int j = 0; j < 4; ++j) { const int d0 = 4 * s + j;
        qf[s][2 * j] = (int)pk4(sat8(xf[d0][0]), sat8(xf[d0][1]), sat8(xf[d0][2]), sat8(xf[d0][3])); qf[s][2 * j + 1] = (int)pk4(sat8(xf[d0][4]), sat8(xf[d0][5]), sat8(xf[d0][6]), sat8(xf[d0][7])); }
  }
  const int skey = tid >> 3, sd = tid >> 2;
  const unsigned kg_off = (unsigned)(skey * LDK8 + (((tid & 7) ^ ((skey >> 1) & 7)) << 4)), vg_off = (unsigned)(sd * 64 + (((tid & 3) ^ ((sd >> 2) & 3)) << 4));
#define TCLAMP(t) ((t) < NT ? (t) : NT - 1)
#define DMAK8(kt, ks) __builtin_amdgcn_global_load_lds((const unsigned*)(Kh8 + (size_t)TCLAMP(kt) * (KVBLK * LDK8) + kg_off), (__attribute__((address_space(3))) unsigned*)(ldsl + (ks) * SHM_K + wid * 1024), 16, 0, 0)
#define DMAV8(vt, vs) __builtin_amdgcn_global_load_lds((const unsigned*)(Vt + (size_t)TCLAMP(vt) * (KVBLK * D) + vg_off), (__attribute__((address_space(3))) unsigned*)(ldsl + NSLOT * SHM_K + (vs) * SHM_V + wid * 1024), 16, 0, 0)
#define STEP_END8() do { asm volatile("s_waitcnt vmcnt(2) lgkmcnt(0)" ::: "memory"); __builtin_amdgcn_s_barrier(); asm volatile("" ::: "memory"); } while (0)
#define RESC8(a) do { if (__any((a) < 1.f)) { if (hi == 0) al_l[r32] = (a); asm volatile("s_waitcnt lgkmcnt(0)" ::: "memory"); asm volatile("s_nop 15\n\ts_nop 7" : "+v"(o[0]), "+v"(o[1]), "+v"(o[2]), "+v"(o[3]), "+v"(osum)); \
    _Pragma("unroll") for (int r = 0; r < 16; ++r) { const float a_ = al_l[crow(r, hi)]; osum[r] *= a_; _Pragma("unroll") for (int d = 0; d < 4; ++d) o[d][r] *= a_; } } } while (0)
  f32x16 pA0, pA1, pB0, pB1, negm; float alA, alB; i32x8 pf;
  DMAK8(0, 0); DMAV8(0, 0); DMAK8(1, 1); DMAK8(2, 2); DMAV8(1, 1);
  STEP_END8();
  qkt8(pA0, pA1, K_lds, qf, r32, hi);
  asm volatile("s_nop 15\n\ts_nop 7" : "+v"(pA0), "+v"(pA1));
#pragma unroll
  for (int r = 8; r < 16; ++r) pA0[r] = -INFINITY;
#pragma unroll
  for (int r = 0; r < 16; ++r) pA1[r] = -INFINITY;
  partialSM8<false>(pA0, pA1, m_reg, alA);
#pragma unroll
  for (int r = 0; r < 16; ++r) negm[r] = FP8_P_LOG2 - m_reg;
  asm volatile("s_waitcnt lgkmcnt(0)" ::: "memory"); __builtin_amdgcn_s_barrier(); asm volatile("" ::: "memory");
  for (int j = 1; j < NT; j += 4) {
    STEP8(pB0, pB1, pA0, pA1, alB, 1, 0, j);     RESC8(alB); STEP_END8();
    STEP8(pA0, pA1, pB0, pB1, alA, 2, 1, j + 1); RESC8(alA); STEP_END8();
    STEP8(pB0, pB1, pA0, pA1, alB, 3, 2, j + 2); RESC8(alB); STEP_END8();
    STEP8(pA0, pA1, pB0, pB1, alA, 0, 3, j + 3); RESC8(alA); STEP_END8();
  }
  asm volatile("s_waitcnt vmcnt(0)" ::: "memory");
  finishSM8(pA0, pA1, pf); SBAR8();
  pv8(o, V_lds + ((NT - 1) & 3) * SHM_V, pf, r32, hi); MFMA8(osum, pf, ones8);
  asm volatile("s_nop 15\n\ts_nop 15\n\ts_nop 15\n\ts_nop 7" : "+v"(o[0]), "+v"(o[1]), "+v"(o[2]), "+v"(o[3]), "+v"(osum));
  float rli[16];
#pragma unroll
  for (int r = 0; r < 16; ++r) rli[r] = __builtin_amdgcn_rcpf(osum[r]) * (pg8::FP8_O_SCALE / FP8_V_SCALE);
  { const int l2 = lane_id_asm(), c32 = l2 & 31, h2 = l2 >> 5; unsigned char* Ow = Ob + (size_t)(wid * QBLK) * LDO;
#pragma unroll
    for (int r = 0; r < 16; ++r) { const unsigned ooff = (unsigned)(crow(r, h2) * LDO + c32);
#pragma unroll
      for (int d0 = 0; d0 < 4; ++d0) { const float v = sat8(o[d0][r] * rli[r]); Ow[ooff + d0 * 32] = (unsigned char)(__builtin_amdgcn_cvt_pk_fp8_f32(v, 0.f, 0, false) & 0xff); } } }
#undef DMAK8
#undef DMAV8
#undef MAXCH8
#undef STEP_END8
#undef TCLAMP
#undef STEP8
#undef RESC8
}
}

#define GAS __attribute__((address_space(1)))
#define LAS __attribute__((address_space(3)))
typedef unsigned short bf16;
typedef unsigned v4u __attribute__((ext_vector_type(4)));
typedef float f32x4 __attribute__((ext_vector_type(4)));
typedef short bf16x8 __attribute__((ext_vector_type(8)));
typedef GAS unsigned gu32;
typedef GAS unsigned long long gu64;
#define RLX_AGENT __ATOMIC_RELAXED, __HIP_MEMORY_SCOPE_AGENT
#define LDS_WAIT() asm volatile("s_waitcnt lgkmcnt(0)" ::: "memory")
#define VM_WAIT() asm volatile("s_waitcnt vmcnt(0)" ::: "memory")
__device__ __forceinline__ unsigned long long rt() { return __builtin_amdgcn_s_memrealtime(); }
__device__ __forceinline__ unsigned f2bf(float f) { unsigned u = __builtin_bit_cast(unsigned, f); return (u + 0x7fffu + ((u >> 16) & 1u)) >> 16; }
__device__ __forceinline__ unsigned pk2(float lo, float hi) { return f2bf(lo) | (f2bf(hi) << 16); }

#define XB_TMO      128
#define XB_XCNT(j)  (256  + 64 * (j))
#define XB_XSUB(j)  (1280 + 64 * (j))
#define XB_XGEN(j)  (2304 + 64 * (j))
#define XB_TOP      3328
#define XB_TOPGEN   3392
#define XCD_BAR_WORDS 3456
#define XB_SPIN_CAP (1u << 18)

__device__ __forceinline__ unsigned xb_ld(unsigned* p)              { return __hip_atomic_load(p, __ATOMIC_RELAXED, __HIP_MEMORY_SCOPE_AGENT); }
__device__ __forceinline__ unsigned xb_add(unsigned* p, unsigned v) { return __hip_atomic_fetch_add(p, v, __ATOMIC_RELAXED, __HIP_MEMORY_SCOPE_AGENT); }
__device__ __forceinline__ unsigned xb_xcc_id() { return (unsigned)__builtin_amdgcn_s_getreg((3 << 11) | 20) & 0xFu; }
#define XB_SPIN(cond, bar) do { unsigned _sp = 0; while (cond) { __builtin_amdgcn_s_sleep(1); \
    if ((++_sp & 255u) == 0u) { if (xb_ld(&(bar)[XB_TMO])) break; if (_sp > XB_SPIN_CAP) { atomicAdd(&(bar)[XB_TMO], 1u); break; } } } } while (0)

struct XcdBarrier {
    unsigned* bar; unsigned x;
    volatile LAS unsigned* st;
};

__device__ __forceinline__ XcdBarrier xcd_barrier_post(unsigned* bar, volatile LAS unsigned* st, const bool t0) {
    XcdBarrier b; b.bar = bar; b.x = xb_xcc_id(); b.st = st;
    if (t0) (void)xb_add(&bar[XB_XCNT(b.x)], 1u);
    return b;
}
__device__ __forceinline__ void xcd_barrier_complete(unsigned* bar, unsigned x, unsigned& nloc, unsigned& nx) {
    const unsigned G = gridDim.x * gridDim.y * gridDim.z;
    unsigned sum, cnt, mine, sp = 0u;
    for (;;) {
        sum = 0u; cnt = 0u; mine = 0u;
#pragma unroll
        for (unsigned j = 0; j < 16; ++j) { const unsigned c = xb_ld(&bar[XB_XCNT(j)]); sum += c; cnt += (c > 0u) ? 1u : 0u; mine = (j == x) ? c : mine; }
        if (sum == G) break;
        __builtin_amdgcn_s_sleep(1);
        if ((++sp & 255u) == 0u) { if (xb_ld(&bar[XB_TMO])) break; if (sp > XB_SPIN_CAP) { atomicAdd(&bar[XB_TMO], 1u); break; } }
    }
    nloc = mine > 0u ? mine : 1u; nx = cnt > 0u ? cnt : 1u;
}

__device__ __forceinline__ void xcd_barrier(const XcdBarrier& b, const bool t0) {
    asm volatile("s_waitcnt vmcnt(0)" ::: "memory");
    __syncthreads();
    if (t0) {
        unsigned* bar = b.bar;
        __builtin_amdgcn_s_waitcnt(0);
        unsigned nloc = b.st[0], nx = b.st[1];
        if (nloc == 0u) { xcd_barrier_complete(bar, b.x, nloc, nx); b.st[0] = nloc; b.st[1] = nx; }
        const unsigned old = xb_add(&bar[XB_XSUB(b.x)], 1u);
        const unsigned gen = old / nloc;
        if (old + 1u == (gen + 1u) * nloc) {
            __builtin_amdgcn_fence(__ATOMIC_RELEASE, "agent");
            asm volatile("s_waitcnt vmcnt(0)" ::: "memory");
            const unsigned og = xb_add(&bar[XB_TOP], 1u);
            const unsigned tg = og / nx;
            if (og + 1u == (tg + 1u) * nx) xb_add(&bar[XB_TOPGEN], 1u);
            else XB_SPIN(xb_ld(&bar[XB_TOPGEN]) == tg, bar);
            __builtin_amdgcn_fence(__ATOMIC_ACQUIRE, "agent");
            xb_add(&bar[XB_XGEN(b.x)], 1u);
            asm volatile("s_waitcnt vmcnt(0)" ::: "memory");
        } else {
            XB_SPIN(xb_ld(&bar[XB_XGEN(b.x)]) == gen, bar);
            __builtin_amdgcn_fence(__ATOMIC_ACQUIRE, "agent");
            asm volatile("s_waitcnt vmcnt(0)" ::: "memory");
        }
    }
    __syncthreads();
}

constexpr size_t MiB = 1u << 20;
constexpr size_t CTL_ZERO_BYTES = 2 * MiB;
constexpr int CW_BAR = 4096;
constexpr size_t RSS_OFF = 256 * 1024;
constexpr int NRSS = 7;
static_assert((CW_BAR + XCD_BAR_WORDS) * 4 <= (int)RSS_OFF && RSS_OFF + (size_t)NRSS * MPAD * 8 <= CTL_ZERO_BYTES, "control region");
constexpr size_t SZ_WGU = (size_t)2 * DFF * DM * 2, SZ_WD = (size_t)DM * DFF * 2, SZ_WCI = (size_t)3 * DM * DM * 2, SZ_WSQ = (size_t)DM * DM * 2, SZ_WQKV = (size_t)NQKV * DM * 2;
constexpr size_t WS_WGU = 2 * MiB;
constexpr size_t WS_WD = WS_WGU + 4 * SZ_WGU;
constexpr size_t WS_WCI = WS_WD + 4 * SZ_WD;
constexpr size_t WS_WCO = WS_WCI + SZ_WCI;
constexpr size_t WS_WQKV = WS_WCO + SZ_WSQ;
constexpr size_t WS_WO = WS_WQKV + SZ_WQKV;
constexpr size_t WS_H = WS_WO + SZ_WSQ;
constexpr size_t WS_HB = WS_H + (size_t)MPAD * DM * 4;
constexpr size_t WS_ACT = WS_HB + (size_t)MPAD * DM * 2;
constexpr size_t SZ_ACT = (size_t)MPAD * DFF * 2;
constexpr size_t WS_BB = WS_ACT, WS_UB = WS_ACT + (size_t)MPAD * DM * 2;
constexpr size_t WS_Q = WS_ACT, WS_K = WS_Q + (size_t)MREAL * DM * 2, WS_V = WS_K + (size_t)NB * KVROWS * NKV * HD * 2;
static_assert(WS_UB + (size_t)MPAD * DM * 2 <= WS_ACT + SZ_ACT && WS_V + (size_t)NB * KVROWS * NKV * HD * 2 <= WS_ACT + SZ_ACT, "overlays fit the FFN hidden buffer");
constexpr size_t WS_AUX = WS_ACT + SZ_ACT;
constexpr size_t SZ_WD8 = (size_t)DM * DFF;
constexpr size_t WS_WD8 = WS_AUX + (size_t)MPAD * DM * 2;
constexpr size_t WS_WQKV8 = WS_WD8 + 4 * SZ_WD8;
constexpr size_t WS_WO8 = WS_WQKV8 + (size_t)NQKV * DM;
constexpr size_t WS_HB8 = WS_WO8 + (size_t)DM * DM;
constexpr size_t WS_K8 = WS_HB8 + (size_t)MPAD * DM;
constexpr size_t WS_VT8 = WS_K8 + (size_t)NB * KVROWS * NKV * HD;
constexpr size_t WS_END = WS_VT8 + (size_t)NB * NKV * (KVROWS / 64) * 128 * 64;
static_assert(WS_WD8 % 256 == 0 && WS_WQKV8 % 256 == 0 && WS_WO8 % 256 == 0 && WS_HB8 % 256 == 0 && WS_K8 % 256 == 0 && WS_VT8 % 256 == 0, "alignment");
static_assert(WS_WGU % 256 == 0 && WS_WD % 256 == 0 && WS_H % 256 == 0 && WS_HB % 256 == 0 && WS_ACT % 256 == 0 && WS_K % 256 == 0 && WS_V % 256 == 0 && WS_AUX % 256 == 0, "alignment");

constexpr int NWAVES = 8;
constexpr int RING_BYTES = 131072;
constexpr int MISC_OFF = 139264 + 320;
constexpr int LDS_BYTES = 147456;

struct Frame {
    LAS unsigned char* lds;
    int tid, lane, wave, G, bid;
};
#define REFRAME(F) do { (F).lane = att::lane_id_asm(); (F).tid = (F).wave * 64 + (F).lane; } while (0)

__device__ __forceinline__ float wave_sum(float v) {
#pragma unroll
    for (int o = 1; o < 64; o <<= 1) v += __shfl_xor(v, o);
    return v;
}
__device__ __forceinline__ float bf2f(unsigned short b) { return __uint_as_float((unsigned)b << 16); }

#define CVT_LOAD32(t, wp, ldw, koff) do { _Pragma("unroll") for (int i_ = 0; i_ < 32; ++i_) (t)[i_] = __builtin_nontemporal_load((wp) + (size_t)((koff) + 2 * i_) * (ldw)); } while (0)
#define CVT_LDSW32(t, scr, koff, lane) do { _Pragma("unroll") for (int i_ = 0; i_ < 32; ++i_) (scr)[((koff) + 2 * i_ + ((lane) >> 5)) * 33 + ((lane) & 31)] = (t)[i_]; } while (0)
__device__ __forceinline__ void cvt_finish(const float (&t)[32], const float* g, bf16* WT, int K, int drow, int k0, LAS float* scr, int lane) {
    const int c = lane & 7;
    f32x4 g0 = {1.f, 1.f, 1.f, 1.f}, g1 = g0;
    if (g) { g0 = *(const f32x4*)(g + k0 + 8 * c); g1 = *(const f32x4*)(g + k0 + 8 * c + 4); }
    CVT_LDSW32(t, scr, 0, lane);
    LDS_WAIT(); asm volatile("" ::: "memory");
#pragma unroll
    for (int j = 0; j < 4; ++j) { const int n = (lane >> 3) + 8 * j; const LAS float* s = scr + (8 * c) * 33 + n;
        v4u o; o.x = pg8::cvt_pk_bf16(s[0 * 33] * g0[0], s[1 * 33] * g0[1]); o.y = pg8::cvt_pk_bf16(s[2 * 33] * g0[2], s[3 * 33] * g0[3]);
        o.z = pg8::cvt_pk_bf16(s[4 * 33] * g1[0], s[5 * 33] * g1[1]); o.w = pg8::cvt_pk_bf16(s[6 * 33] * g1[2], s[7 * 33] * g1[3]);
        __builtin_nontemporal_store(o, (GAS v4u*)(WT + (size_t)(drow + n) * K + k0 + 8 * c)); }
    LDS_WAIT(); asm volatile("" ::: "memory");
}
template <int MODE>
__device__ __forceinline__ const float* cvt_src(const float* W, const float* W2, int ldw, int nblk, int it, int lane, int& drow, int& k0) {
    const int kb = it / nblk, nb = it - kb * nblk; drow = nb * 32; k0 = kb * 64;
    const float* src = W; int scol = drow;
    if (MODE == 1) { src = ((drow >> 7) & 1) ? W2 : W; scol = (drow >> 8) * 128 + (drow & 127); }
    if (MODE == 2) { if (drow < 2 * DM) scol = (((drow >> 7) & 1) ? 2 * DM : DM) + (drow >> 8) * 128 + (drow & 127); else scol = drow - 2 * DM; }
    return src + (size_t)(k0 + (lane >> 5)) * ldw + scol + (lane & 31);
}
template <int MODE>
__device__ __forceinline__ void cvt_matrix(Frame& F, const float* W, const float* W2, int ldw, const float* g, bf16* WT, int K, int ndst) {
    LAS float* scr = (LAS float*)(F.lds + F.wave * 16896);
    const int gw = F.bid * NWAVES + F.wave, NGW = F.G * NWAVES, lane = F.lane;
    const int nblk = ndst / 32, nitems = nblk * (K / 64);
    float ta[32], tb[32]; int da, ka, db, kb;
    int it = gw;
    if (it < nitems) { const float* wp = cvt_src<MODE>(W, W2, ldw, nblk, it, lane, da, ka); CVT_LOAD32(ta, wp, ldw, 0); }
    while (it < nitems) {
        const int it1 = it + NGW;
        if (it1 < nitems) { const float* wp = cvt_src<MODE>(W, W2, ldw, nblk, it1, lane, db, kb); CVT_LOAD32(tb, wp, ldw, 0); }
        __builtin_amdgcn_sched_barrier(0);
        cvt_finish(ta, g, WT, K, da, ka, scr, lane);
        if (it1 >= nitems) break;
        it = it1 + NGW;
        if (it < nitems) { const float* wp = cvt_src<MODE>(W, W2, ldw, nblk, it, lane, da, ka); CVT_LOAD32(ta, wp, ldw, 0); }
        __builtin_amdgcn_sched_barrier(0);
        cvt_finish(tb, g, WT, K, db, kb, scr, lane);
    }
}
__device__ __forceinline__ void cvt_finish8(const float* g, float scale, unsigned char* WT, int K, int drow, int k0, LAS float* scr, int lane) {
    const int c = lane & 7;
    f32x4 gv[4];
#pragma unroll
    for (int q = 0; q < 4; ++q) gv[q] = g ? *(const f32x4*)(g + k0 + 16 * c + 4 * q) * scale : (f32x4){scale, scale, scale, scale};
    LDS_WAIT(); asm volatile("" ::: "memory");
#pragma unroll
    for (int j = 0; j < 4; ++j) { const int n = (lane >> 3) + 8 * j; const LAS float* s = scr + (16 * c) * 33 + n;
        v4u o;
#pragma unroll
        for (int q = 0; q < 4; ++q) o[q] = pg8::pack_fp8x4((f32x4){s[(4 * q + 0) * 33], s[(4 * q + 1) * 33], s[(4 * q + 2) * 33], s[(4 * q + 3) * 33]} * gv[q]);
        __builtin_nontemporal_store(o, (GAS v4u*)(WT + (size_t)(drow + n) * K + k0 + 16 * c)); }
    LDS_WAIT(); asm volatile("" ::: "memory");
}
__device__ __forceinline__ void cvt_matrix8(Frame& F, const float* W, int ldw, const float* g, float scale, unsigned char* WT, int K, int ndst) {
    LAS float* scr = (LAS float*)(F.lds + F.wave * 16896);
    const int gw = F.bid * NWAVES + F.wave, NGW = F.G * NWAVES, lane = F.lane;
    const int nblk = ndst / 32, nitems = nblk * (K / 128);
    float ta[32], tb[32];
    int it = gw;
    if (it < nitems) { const int kb = it / nblk, nb = it - kb * nblk; const float* wp = W + (size_t)(kb * 128 + (lane >> 5)) * ldw + nb * 32 + (lane & 31); CVT_LOAD32(ta, wp, ldw, 0); }
    for (; it < nitems; it += NGW) {
        const int kb = it / nblk, nb = it - kb * nblk; const float* wp = W + (size_t)(kb * 128 + (lane >> 5)) * ldw + nb * 32 + (lane & 31);
        CVT_LOAD32(tb, wp, ldw, 64);
        __builtin_amdgcn_sched_barrier(0);
        CVT_LDSW32(ta, scr, 0, lane);
        const int itn = it + NGW;
        if (itn < nitems) { const int kbn = itn / nblk, nbn = itn - kbn * nblk; const float* wpn = W + (size_t)(kbn * 128 + (lane >> 5)) * ldw + nbn * 32 + (lane & 31); CVT_LOAD32(ta, wpn, ldw, 0); }
        __builtin_amdgcn_sched_barrier(0);
        CVT_LDSW32(tb, scr, 64, lane);
        cvt_finish8(g, scale, WT, K, nb * 32, kb * 128, scr, lane);
    }
}

template <int MODE>
__device__ __forceinline__ void cvt_one(const float* W, const float* W2, int ldw, const float* g, bf16* WT, int K, int ndst, int it, LAS float* scr, int lane) {
    int drow, k0; const float* wp = cvt_src<MODE>(W, W2, ldw, ndst / 32, it, lane, drow, k0);
    float t[32]; CVT_LOAD32(t, wp, ldw, 0);
    cvt_finish(t, g, WT, K, drow, k0, scr, lane);
}
__device__ __forceinline__ void cvt_one8(const float* W, int ldw, const float* g, float scale, unsigned char* WT, int K, int ndst, int it, LAS float* scr, int lane) {
    const int nblk = ndst / 32, kb = it / nblk, nb = it - kb * nblk; const float* wp = W + (size_t)(kb * 128 + (lane >> 5)) * ldw + nb * 32 + (lane & 31);
    float ta[32], tb[32]; CVT_LOAD32(ta, wp, ldw, 0); CVT_LOAD32(tb, wp, ldw, 64);
    CVT_LDSW32(ta, scr, 0, lane); CVT_LDSW32(tb, scr, 64, lane);
    cvt_finish8(g, scale, WT, K, nb * 32, kb * 128, scr, lane);
}
constexpr int BG_N0 = (2 * DFF / 32) * (DM / 64), BG_N1 = (DM / 32) * (DFF / 128), BG_N2 = (NQKV / 32) * (DM / 128), BG_N3 = (2 * NKV * HD / 32) * (DM / 64), BG_N4 = (DM / 32) * (DM / 128);
constexpr int BG_L0 = (DM / 32) * (DFF / 64), BG_L1 = BG_L0 + (3 * DM / 32) * (DM / 64), BG_L2 = BG_L1 + (DM / 32) * (DM / 64), BG_L3 = BG_L2 + BG_N0, BG_L4 = BG_L3 + BG_N1;
constexpr int BG_B1 = BG_L4 + BG_N0, BG_B2 = BG_B1 + BG_N1, BG_B3 = BG_B2 + BG_N2, BG_B4 = BG_B3 + BG_N3, BG_B5 = BG_B4 + BG_N4, BG_B6 = BG_B5 + BG_N0, BG_TOTAL = BG_B6 + BG_N1;
constexpr int BG_END_A = BG_B5;
constexpr size_t BG_CTL_OFF = 1536 * 1024;
constexpr int BG_CH = 2;
__device__ __forceinline__ void bg_item(Frame& F, const float* const* in, unsigned char* ws, int it) {
    LAS float* scr = (LAS float*)(F.lds + F.wave * 16896);
    const size_t LW = (size_t)DM * DFF;
    if (it < BG_L0) cvt_one<0>(in[5], nullptr, DM, nullptr, (bf16*)(ws + WS_WD), DFF, DM, it, scr, F.lane);
    else if (it < BG_L1) cvt_one<2>(in[11], nullptr, 3 * DM, in[10], (bf16*)(ws + WS_WCI), DM, 3 * DM, it - BG_L0, scr, F.lane);
    else if (it < BG_L2) cvt_one<0>(in[14], nullptr, DM, nullptr, (bf16*)(ws + WS_WCO), DM, DM, it - BG_L1, scr, F.lane);
    else if (it < BG_L3) cvt_one<1>(in[7], in[8], DFF, in[6], (bf16*)(ws + WS_WGU) + 1 * (size_t)2 * DFF * DM, DM, 2 * DFF, it - BG_L2, scr, F.lane);
    else if (it < BG_L4) cvt_one8(in[9], DM, nullptr, pg8::FP8_W_SCALE, ws + WS_WD8 + 1 * SZ_WD8, DFF, DM, it - BG_L3, scr, F.lane);
    else if (it < BG_B1) cvt_one<1>(in[3] + LW, in[4] + LW, DFF, in[2] + DM, (bf16*)(ws + WS_WGU) + 2 * (size_t)2 * DFF * DM, DM, 2 * DFF, it - BG_L4, scr, F.lane);
    else if (it < BG_B2) cvt_one8(in[5] + LW, DM, nullptr, pg8::FP8_W_SCALE, ws + WS_WD8 + 2 * SZ_WD8, DFF, DM, it - BG_B1, scr, F.lane);
    else if (it < BG_B3) cvt_one8(in[16], NQKV, in[15], pg8::FP8_W_SCALE, ws + WS_WQKV8, DM, NQKV, it - BG_B2, scr, F.lane);
    else if (it < BG_B4) cvt_one<0>(in[16] + NHEAD * HD, nullptr, NQKV, in[15], (bf16*)(ws + WS_WQKV) + (size_t)NHEAD * HD * DM, DM, 2 * NKV * HD, it - BG_B3, scr, F.lane);
    else if (it < BG_B5) cvt_one8(in[19], DM, nullptr, pg8::FP8_W_SCALE, ws + WS_WO8, DM, DM, it - BG_B4, scr, F.lane);
    else if (it < BG_B6) cvt_one<1>(in[7] + LW, in[8] + LW, DFF, in[6] + DM, (bf16*)(ws + WS_WGU) + 3 * (size_t)2 * DFF * DM, DM, 2 * DFF, it - BG_B5, scr, F.lane);
    else cvt_one8(in[9] + LW, DM, nullptr, pg8::FP8_W_SCALE, ws + WS_WD8 + 3 * SZ_WD8, DFF, DM, it - BG_B6, scr, F.lane);
}
__device__ __forceinline__ void bg_drain(Frame& F, const float* const* in, unsigned char* ws, volatile LAS unsigned* MISC, int k, int need) {
    unsigned* ctl = (unsigned*)(ws + BG_CTL_OFF);
    __syncthreads();
    if (F.tid == 0) (void)__hip_atomic_fetch_add(ctl + 64 * (k + 1), 1u, __ATOMIC_RELAXED, __HIP_MEMORY_SCOPE_AGENT);
    for (;;) {
        if (F.tid == 0) {
            const int c = (int)__hip_atomic_load(ctl, __ATOMIC_RELAXED, __HIP_MEMORY_SCOPE_AGENT);
            const int d = (int)__hip_atomic_load(ctl + 64 * (k + 1), __ATOMIC_RELAXED, __HIP_MEMORY_SCOPE_AGENT);
            const bool go = c < BG_TOTAL && (c < need || d < F.G);
            MISC[20] = go ? 1u : 0u;
            if (go) MISC[21] = __hip_atomic_fetch_add(ctl, (unsigned)(NWAVES * BG_CH), __ATOMIC_RELAXED, __HIP_MEMORY_SCOPE_AGENT);
        }
        __syncthreads();
        const unsigned go = MISC[20]; const int base = (int)MISC[21];
        __syncthreads();
        if (!go) break;
#pragma unroll 1
        for (int i = 0; i < BG_CH; ++i) { const int it = base + F.wave * BG_CH + i; if (it < BG_TOTAL) bg_item(F, in, ws, it); }
    }
}

typedef float f32x16 __attribute__((ext_vector_type(16)));
template <int NT, class Epi>
__device__ __forceinline__ void skinny_phase(Frame& F, const bf16* A, const bf16* Bt, int K, int n_items, const Epi& E) {
    const int r32 = F.lane & 31, hi = F.lane >> 5, kc = K / 8, k0 = F.wave * kc;
    LAS float* P = (LAS float*)F.lds;
    for (int item = F.bid; item < n_items; item += F.G) {
        f32x16 acc[NT];
        const bf16* bp[NT];
        const bf16* ap = A + (size_t)r32 * K + k0 + hi * 16;
#pragma unroll
        for (int t = 0; t < NT; ++t) { acc[t] = f32x16{}; bp[t] = Bt + (size_t)(E.tile_row(item, t) + r32) * K + k0 + hi * 16; }
        constexpr int U = (NT == 1) ? 4 : 2;
        int kk = 0;
        for (; kk + 32 * U <= kc; kk += 32 * U) {
            bf16x8 a[2 * U], b[NT][2 * U];
#pragma unroll
            for (int u = 0; u < 2 * U; ++u) a[u] = *(const bf16x8*)(ap + kk + hi * (16 * U - 16) + 8 * u);
#pragma unroll
            for (int t = 0; t < NT; ++t)
#pragma unroll
                for (int u = 0; u < 2 * U; ++u) b[t][u] = *(const bf16x8*)(bp[t] + kk + hi * (16 * U - 16) + 8 * u);
            __builtin_amdgcn_sched_barrier(0);
#pragma unroll
            for (int t = 0; t < NT; ++t)
#pragma unroll
                for (int u = 0; u < 2 * U; ++u) acc[t] = __builtin_amdgcn_mfma_f32_32x32x16_bf16(a[u], b[t][u], acc[t], 0, 0, 0);
            __builtin_amdgcn_sched_barrier(0);
        }
        for (; kk < kc; kk += 32) {
            const bf16x8 a0 = *(const bf16x8*)(ap + kk), a1 = *(const bf16x8*)(ap + kk + 8);
#pragma unroll
            for (int t = 0; t < NT; ++t) {
                const bf16x8 b0 = *(const bf16x8*)(bp[t] + kk), b1 = *(const bf16x8*)(bp[t] + kk + 8);
                acc[t] = __builtin_amdgcn_mfma_f32_32x32x16_bf16(a0, b0, acc[t], 0, 0, 0);
                acc[t] = __builtin_amdgcn_mfma_f32_32x32x16_bf16(a1, b1, acc[t], 0, 0, 0);
            }
        }
#pragma unroll
        for (int t = 0; t < NT; ++t)
#pragma unroll
            for (int r = 0; r < 16; ++r) P[((F.wave * NT + t) * 32 + att::crow(r, hi)) * 32 + r32] = acc[t][r];
        __syncthreads();
#pragma unroll
        for (int h = 0; h < 2; ++h) {
            const int e = F.tid + h * 512; float v[NT];
#pragma unroll
            for (int t = 0; t < NT; ++t) { float s = 0.f;
#pragma unroll
                for (int w = 0; w < NWAVES; ++w) s += P[(w * NT + t) * 1024 + e];
                v[t] = s; }
            E.apply(item, e >> 5, e & 31, v);
        }
        __syncthreads();
    }
}
template <class Epi>
__device__ __forceinline__ void skinny_phase8(Frame& F, const unsigned char* A, const unsigned char* Bt, int K, int n_items, const Epi& E) {
    typedef int i32x8 __attribute__((ext_vector_type(8))); typedef int i32x4 __attribute__((ext_vector_type(4)));
    const int r32 = F.lane & 31, hi = F.lane >> 5, nst = K / 64, base = nst / 8, rem = nst - base * 8;
    const int st0 = F.wave * base + (F.wave < rem ? F.wave : rem), nmy = base + (F.wave < rem ? 1 : 0);
    LAS float* P = (LAS float*)F.lds;
    for (int item = F.bid; item < n_items; item += F.G) {
        f32x16 acc = f32x16{};
        const unsigned char* ap = A + (size_t)r32 * K + (size_t)st0 * 64 + hi * 32;
        const unsigned char* bp = Bt + (size_t)(E.tile_row(item, 0) + r32) * K + (size_t)st0 * 64 + hi * 32;
        int s = 0;
        for (; s + 4 <= nmy; s += 4) {
            i32x4 a[8], b[8];
#pragma unroll
            for (int u = 0; u < 4; ++u) { a[2 * u] = *(const i32x4*)(ap + (s + u) * 64); a[2 * u + 1] = *(const i32x4*)(ap + (s + u) * 64 + 16); b[2 * u] = *(const i32x4*)(bp + (s + u) * 64); b[2 * u + 1] = *(const i32x4*)(bp + (s + u) * 64 + 16); }
            __builtin_amdgcn_sched_barrier(0);
#pragma unroll
            for (int u = 0; u < 4; ++u) asm volatile("v_mfma_f32_32x32x64_f8f6f4 %0, %1, %2, %0" : "+v"(acc) : "v"((i32x8){a[2*u][0], a[2*u][1], a[2*u][2], a[2*u][3], a[2*u+1][0], a[2*u+1][1], a[2*u+1][2], a[2*u+1][3]}), "v"((i32x8){b[2*u][0], b[2*u][1], b[2*u][2], b[2*u][3], b[2*u+1][0], b[2*u+1][1], b[2*u+1][2], b[2*u+1][3]}));
            __builtin_amdgcn_sched_barrier(0);
        }
        for (; s < nmy; ++s) {
            const i32x4 a0 = *(const i32x4*)(ap + s * 64), a1 = *(const i32x4*)(ap + s * 64 + 16), b0 = *(const i32x4*)(bp + s * 64), b1 = *(const i32x4*)(bp + s * 64 + 16);
            asm volatile("v_mfma_f32_32x32x64_f8f6f4 %0, %1, %2, %0" : "+v"(acc) : "v"((i32x8){a0[0], a0[1], a0[2], a0[3], a1[0], a1[1], a1[2], a1[3]}), "v"((i32x8){b0[0], b0[1], b0[2], b0[3], b1[0], b1[1], b1[2], b1[3]}));
        }
        asm volatile("s_nop 15\n\ts_nop 15\n\ts_nop 7" : "+v"(acc));
#pragma unroll
        for (int r = 0; r < 16; ++r) P[(F.wave * 32 + att::crow(r, hi)) * 32 + r32] = acc[r];
        __syncthreads();
#pragma unroll
        for (int h = 0; h < 2; ++h) {
            const int e = F.tid + h * 512; float v[1]; float sm = 0.f;
#pragma unroll
            for (int w = 0; w < NWAVES; ++w) sm += P[w * 1024 + e];
            v[0] = sm;
            E.apply(item, e >> 5, e & 31, v);
        }
        __syncthreads();
    }
}
struct SkResid {
    const float* hin; float* h; bf16* hb; rss_t* rss_out; float scale;
    __device__ __forceinline__ int tile_row(int item, int) const { return item * 32; }
    __device__ __forceinline__ void apply(int item, int row, int col, const float (&v)[1]) const {
        const size_t o = (size_t)(MREAL + row) * DM + item * 32 + col;
        const float x = hin[o] + scale * v[0];
        h[o] = x; hb[o] = (bf16)f2bf(x);
        float ss = x * x;
#pragma unroll
        for (int d = 1; d < 32; d <<= 1) ss += __shfl_xor(ss, d);
        if (col == 0) rss_add(rss_out + MREAL + row, ss);
    }
};
struct SkConvIn {
    bf16* bbuf; bf16* ubuf; const rss_t* rss;
    __device__ __forceinline__ int tile_row(int item, int t) const { const int ch = item * 32; return t == 0 ? 2 * DM + ch : (ch >> 7) * 256 + (t == 2 ? 128 : 0) + (ch & 127); }
    __device__ __forceinline__ void apply(int item, int row, int col, const float (&v)[3]) const {
        const float rs = rstd_from_ss(rss[MREAL + row]); const size_t o = (size_t)(MREAL + row) * DM + item * 32 + col;
        bbuf[o] = (bf16)f2bf(v[0] * rs); ubuf[o] = (bf16)f2bf((v[1] * rs) * (v[2] * rs));
    }
};
struct SkKV {
    bf16* k; bf16* v; const rss_t* rss;
    __device__ __forceinline__ int tile_row(int item, int) const { return item * 32; }
    __device__ __forceinline__ void apply(int item, int row, int col, const float (&x)[1]) const {
        const float rs = rstd_from_ss(rss[MREAL + row]); const int kvr = (row >> 4) * KVROWS + (row & 15);
        bf16* dst = item < 32 ? k : v; const int c = (item & 31) * 32 + col;
        dst[(size_t)kvr * (NKV * HD) + c] = (bf16)f2bf(x[0] * rs);
    }
};

__device__ __forceinline__ void rows_init(Frame& F, const float* x, const float* meta, float* h, bf16* hb, rss_t* rss0) {
    const int gw = F.bid * NWAVES + F.wave, NGW = F.G * NWAVES;
    for (int r = gw; r < MVALID; r += NGW) {
        const float* src = r < MREAL ? x + (size_t)r * DM : meta + (size_t)((r - MREAL) & (NMETA - 1)) * DM;
        float ss = 0.f;
#pragma unroll
        for (int j = 0; j < 16; ++j) {
            const f32x4 v = *(const GAS f32x4*)(src + (size_t)(64 * j + F.lane) * 4);
            ss += (v.x * v.x + v.y * v.y) + (v.z * v.z + v.w * v.w);
            const unsigned long long pk = (unsigned long long)pg8::cvt_pk_bf16(v.x, v.y) | ((unsigned long long)pg8::cvt_pk_bf16(v.z, v.w) << 32);
            *(GAS unsigned long long*)(hb + (size_t)r * DM + (size_t)(64 * j + F.lane) * 4) = pk;
            if (r >= MREAL) *(GAS f32x4*)(h + (size_t)r * DM + (size_t)(64 * j + F.lane) * 4) = v;
        }
        ss = wave_sum(ss);
        if (F.lane == 0) rss0[r] = rss_fix(ss);
    }
}
__device__ __forceinline__ void seq_neighbours(int r, int& prev, int& next) {
    if (r < MREAL) { const int b = r >> 13, t = r & (SEQ - 1); prev = t > 0 ? r - 1 : MREAL + b * NMETA + (NMETA - 1); next = t < SEQ - 1 ? r + 1 : -1; }
    else { const int b = (r - MREAL) >> 4, j = (r - MREAL) & 15; prev = j > 0 ? r - 1 : -1; next = j < NMETA - 1 ? r + 1 : b * SEQ; }
}
__device__ __forceinline__ void conv_pass(Frame& F, const bf16* bbuf, const bf16* ubuf, const float* cw, const float* cb, bf16* cv) {
    const int gt = F.bid * (NWAVES * 64) + F.tid, NGT = F.G * NWAVES * 64;
    for (int it = gt; it < (MVALID / 8) * (DM / 8); it += NGT) {
        const int r0 = (it >> 9) * 8, c = (it & 511) * 8; int prev, next, dummy; seq_neighbours(r0, prev, dummy); seq_neighbours(r0 + 7, dummy, next);
        const bf16x8 zero = {0, 0, 0, 0, 0, 0, 0, 0};
        bf16x8 uu[10], bv[8];
        uu[0] = prev >= 0 ? *(const GAS bf16x8*)(ubuf + (size_t)prev * DM + c) : zero;
#pragma unroll
        for (int k = 0; k < 8; ++k) { uu[k + 1] = *(const GAS bf16x8*)(ubuf + (size_t)(r0 + k) * DM + c); bv[k] = *(const GAS bf16x8*)(bbuf + (size_t)(r0 + k) * DM + c); }
        uu[9] = next >= 0 ? *(const GAS bf16x8*)(ubuf + (size_t)next * DM + c) : zero;
        float w0[8], w1[8], w2[8], bb[8];
#pragma unroll
        for (int q = 0; q < 2; ++q) {
            const f32x4 a0 = *(const GAS f32x4*)(cw + c + 4 * q), a1 = *(const GAS f32x4*)(cw + DM + c + 4 * q), a2 = *(const GAS f32x4*)(cw + 2 * DM + c + 4 * q), a3 = *(const GAS f32x4*)(cb + c + 4 * q);
#pragma unroll
            for (int j = 0; j < 4; ++j) { w0[4 * q + j] = a0[j]; w1[4 * q + j] = a1[j]; w2[4 * q + j] = a2[j]; bb[4 * q + j] = a3[j]; }
        }
#pragma unroll
        for (int k = 0; k < 8; ++k) {
            float o[8];
#pragma unroll
            for (int e = 0; e < 8; ++e)
                o[e] = bf2f((unsigned short)bv[k][e]) * (w0[e] * bf2f((unsigned short)uu[k][e]) + w1[e] * bf2f((unsigned short)uu[k + 1][e]) + w2[e] * bf2f((unsigned short)uu[k + 2][e]) + bb[e]);
            v4u w; w.x = pg8::cvt_pk_bf16(o[0], o[1]); w.y = pg8::cvt_pk_bf16(o[2], o[3]); w.z = pg8::cvt_pk_bf16(o[4], o[5]); w.w = pg8::cvt_pk_bf16(o[6], o[7]);
            *(GAS v4u*)(cv + (size_t)(r0 + k) * DM + c) = w;
        }
    }
}
__device__ __forceinline__ void rope_head(bf16* p, const float* gain, float rowpos, float colpos, int i) {
    const float x0 = bf2f(p[i]), x1 = bf2f(p[32 + i]), x2 = bf2f(p[64 + i]), x3 = bf2f(p[96 + i]);
    float ss = (x0 * x0 + x1 * x1) + (x2 * x2 + x3 * x3);
#pragma unroll
    for (int d = 1; d < 32; d <<= 1) ss += __shfl_xor(ss, d);
    const float rs = __builtin_amdgcn_rsqf(ss * (1.0f / (float)HD) + RMS_EPS);
    const float y0 = x0 * rs * gain[i], y1 = x1 * rs * gain[32 + i], y2 = x2 * rs * gain[64 + i], y3 = x3 * rs * gain[96 + i];
    const float inv_freq = __builtin_amdgcn_exp2f(-(float)i * 0.41524101186092029f);
    const float ar = rowpos * inv_freq * 0.15915494309189535f, ac = colpos * inv_freq * 0.15915494309189535f;
    const float cr = __builtin_amdgcn_cosf(ar), sr = __builtin_amdgcn_sinf(ar), cc = __builtin_amdgcn_cosf(ac), sc = __builtin_amdgcn_sinf(ac);
    p[i] = (bf16)f2bf(y0 * cr - y1 * sr); p[32 + i] = (bf16)f2bf(y1 * cr + y0 * sr);
    p[64 + i] = (bf16)f2bf(y2 * cc - y3 * sc); p[96 + i] = (bf16)f2bf(y3 * cc + y2 * sc);
}
__device__ __forceinline__ void k_prep_pass(Frame& F, bf16* K, const float* kg) {
    const int ghw = (F.bid * NWAVES + F.wave) * 2 + (F.lane >> 5), NGHW = F.G * NWAVES * 2, i = F.lane & 31;
    constexpr int NK = NB * (NMETA + SEQ) * NKV;
    static_assert(NK % 2 == 0, "both half-waves of a wave leave the loop together");
    for (int j = ghw; j < NK; j += NGHW) {
        const int key = j >> 3, g = j & 7, b = key / (NMETA + SEQ), p = key - b * (NMETA + SEQ);
        const int kvr = b * KVROWS + (p < NMETA ? p : 64 + (p - NMETA));
        const float rowpos = p < NMETA ? -1.f : (float)((p - NMETA) >> 6), colpos = p < NMETA ? (float)p : (float)((p - NMETA) & 63);
        rope_head(K + (size_t)kvr * (NKV * HD) + g * HD, kg, rowpos, colpos, i);
    }
}
template <bool KEEP16>
__device__ __forceinline__ void kv_prep8_pass(Frame& F, bf16* K, const bf16* V, const float* kg, unsigned char* K8, unsigned char* VT8) {
    {   const int ghw = (F.bid * NWAVES + F.wave) * 2 + (F.lane >> 5), NGHW = F.G * NWAVES * 2, i = F.lane & 31;
        constexpr int NK = NB * (NMETA + SEQ) * NKV;
        for (int j = ghw; j < NK; j += NGHW) {
            const int key = j >> 3, g = j & 7, b = key / (NMETA + SEQ), p = key - b * (NMETA + SEQ);
            const int kvr = b * KVROWS + (p < NMETA ? p : 64 + (p - NMETA));
            const float rowpos = p < NMETA ? -1.f : (float)((p - NMETA) >> 6), colpos = p < NMETA ? (float)p : (float)((p - NMETA) & 63);
            bf16* kp = K + (size_t)kvr * (NKV * HD) + g * HD; unsigned char* k8 = K8 + (size_t)kvr * (NKV * HD) + g * HD;
            const float x0 = bf2f(kp[i]), x1 = bf2f(kp[32 + i]), x2 = bf2f(kp[64 + i]), x3 = bf2f(kp[96 + i]);
            float ss = (x0 * x0 + x1 * x1) + (x2 * x2 + x3 * x3);
#pragma unroll
            for (int d = 1; d < 32; d <<= 1) ss += __shfl_xor(ss, d);
            const float rs = __builtin_amdgcn_rsqf(ss * (1.0f / (float)HD) + RMS_EPS);
            const float y0 = x0 * rs * kg[i], y1 = x1 * rs * kg[32 + i], y2 = x2 * rs * kg[64 + i], y3 = x3 * rs * kg[96 + i];
            const float inv_freq = __builtin_amdgcn_exp2f(-(float)i * 0.41524101186092029f);
            const float ar = rowpos * inv_freq * 0.15915494309189535f, ac = colpos * inv_freq * 0.15915494309189535f;
            const float cr = __builtin_amdgcn_cosf(ar), sr = __builtin_amdgcn_sinf(ar), cc = __builtin_amdgcn_cosf(ac), sc = __builtin_amdgcn_sinf(ac);
            const float o0 = y0 * cr - y1 * sr, o1 = y1 * cr + y0 * sr, o2 = y2 * cc - y3 * sc, o3 = y3 * cc + y2 * sc;
            if (KEEP16) { kp[i] = (bf16)f2bf(o0); kp[32 + i] = (bf16)f2bf(o1); kp[64 + i] = (bf16)f2bf(o2); kp[96 + i] = (bf16)f2bf(o3); }
            const float s8 = att8::FP8_KQ_SCALE;
            k8[att8::k8_pos(i)] = (unsigned char)(att8::pk4(att8::sat8(o0 * s8), 0.f, 0.f, 0.f) & 0xff); k8[att8::k8_pos(32 + i)] = (unsigned char)(att8::pk4(att8::sat8(o1 * s8), 0.f, 0.f, 0.f) & 0xff);
            k8[att8::k8_pos(64 + i)] = (unsigned char)(att8::pk4(att8::sat8(o2 * s8), 0.f, 0.f, 0.f) & 0xff); k8[att8::k8_pos(96 + i)] = (unsigned char)(att8::pk4(att8::sat8(o3 * s8), 0.f, 0.f, 0.f) & 0xff);
        }
    }
    {   const int gw = F.bid * NWAVES + F.wave, NGW = F.G * NWAVES; constexpr int NTILE = KVROWS / 64, NITEM = NB * NKV * NTILE * 2;
        for (int it = gw; it < NITEM; it += NGW) {
            const int dh = it & 1, tile = (it >> 1) % NTILE, bk = (it >> 1) / NTILE, b = bk >> 3, g = bk & 7, d = dh * 64 + F.lane;
            const bf16* vp = V + (size_t)(b * KVROWS + tile * 64) * (NKV * HD) + g * HD + d;
            unsigned char* op = VT8 + ((size_t)(bk * NTILE + tile) * 128 + d) * 64;
#pragma unroll
            for (int q = 0; q < 4; ++q) { v4u w;
#pragma unroll
                for (int c = 0; c < 4; ++c) { float x[4];
#pragma unroll
                    for (int e = 0; e < 4; ++e) { const int key = att8::v8_key(16 * q + 4 * c + e); x[e] = (tile == 0 && key >= NMETA) ? 0.f : att8::sat8(bf2f(vp[(size_t)key * (NKV * HD)]) * att8::FP8_V_SCALE); }
                    w[c] = att8::pk4(x[0], x[1], x[2], x[3]); }
                *(GAS v4u*)(op + 16 * q) = w; }
        }
    }
}
__device__ __forceinline__ void final_norm_pass(Frame& F, const float* h, const rss_t* rss, const float* g, float* out) {
    const int gw = F.bid * NWAVES + F.wave, NGW = F.G * NWAVES;
    for (int r = gw; r < MREAL; r += NGW) {
        const float rs = rstd_from_ss(rss[r]);
#pragma unroll
        for (int j = 0; j < 16; ++j) { const size_t o = (size_t)(64 * j + F.lane) * 4;
            const f32x4 v = *(const GAS f32x4*)(h + (size_t)r * DM + o), gv = *(const GAS f32x4*)(g + o);
            *(GAS f32x4*)(out + (size_t)r * DM + o) = v * rs * gv; }
    }
}

#ifndef MK_ONE_LAUNCH
#define MK_ONE_LAUNCH 1
#endif
#ifndef FP8_DOWN_MASK
#define FP8_DOWN_MASK 0xE
#endif
#ifndef FP8_QKV
#define FP8_QKV 1
#endif
#ifndef FP8_ATTN
#define FP8_ATTN 1
#endif
#ifndef FP8_WO
#define FP8_WO 1
#endif
#ifndef BG_DEFER
#define BG_DEFER 1
#endif
constexpr int N_PHASES = 17;
struct Args { const float* in[21]; float* out; unsigned char* ws; int ph_lo, ph_hi; };
static_assert(sizeof(Args) == 192, "Args has no padding bytes");

__global__ void __launch_bounds__(NWAVES * 64, 2) fwd_kernel(Args args) {
    extern __shared__ __attribute__((aligned(16))) unsigned char lds_raw[];
    Frame F;
    F.lds = (LAS unsigned char*)lds_raw;
    F.tid = threadIdx.x; F.lane = F.tid & 63; F.wave = __builtin_amdgcn_readfirstlane(F.tid >> 6);
    F.G = gridDim.x; F.bid = blockIdx.x;
    volatile LAS unsigned* MISC = (volatile LAS unsigned*)(F.lds + MISC_OFF);
    unsigned char* ws = args.ws;
    gu32* ctl = (gu32*)ws;
    for (int u = F.tid; u < (LDS_BYTES - 139264) / 4; u += NWAVES * 64) ((LAS unsigned*)(F.lds + 139264))[u] = 0u;
    __syncthreads();
    XcdBarrier bar; bar.bar = (unsigned*)(ctl + CW_BAR); bar.x = 0; bar.st = nullptr;
    if (MK_ONE_LAUNCH) bar = xcd_barrier_post((unsigned*)(ctl + CW_BAR), MISC + 8, F.tid == 0);
    const int lo = args.ph_lo, hi = args.ph_hi;
#define REFRAME_(F) ((F).lane = att::lane_id_asm(), (F).tid = (F).wave * 64 + (F).lane)
#define IN(k) (lo <= (k) && (k) < hi && (REFRAME_(F), true))
#define SEAM(k) do { if (MK_ONE_LAUNCH && (lo <= (k) + 1 && (k) + 1 < hi)) xcd_barrier(bar, (REFRAME_(F), F.tid == 0)); } while (0)
#define PH_BEGIN(k) if (IN(k)) {
#define BG_NEED(k) ((k) >= 14 ? BG_TOTAL : (k) == 13 ? BG_B6 : (k) == 12 ? BG_B5 : ((k) == 11 || (k) == 10 || (k) == 9) ? BG_B4 : (k) == 8 ? BG_B2 : (k) == 7 ? BG_B1 : (k) == 6 ? BG_L4 : (k) == 5 ? BG_L3 : ((k) == 4 || (k) == 3) ? BG_L2 : (k) == 2 ? BG_L1 : (k) == 1 ? BG_L0 : 0)
#define BG_SITE(k) ((k) <= 10 || (k) == 12 || (k) == 13 || (k) == 14)
#define PH_END(k) if (BG_DEFER && MK_ONE_LAUNCH && BG_SITE(k)) { REFRAME_(F); bg_drain(F, args.in, ws, MISC, (k), BG_NEED(k)); } SEAM(k); }

    const float* x = args.in[0]; const float* meta = args.in[1];
    const float* conv_norm = args.in[10]; const float* conv_w_in = args.in[11]; const float* conv_w = args.in[12]; const float* conv_b = args.in[13]; const float* conv_w_out = args.in[14];
    const float* attn_norm = args.in[15]; const float* attn_w_qkv = args.in[16]; const float* q_gain = args.in[17]; const float* k_gain = args.in[18]; const float* attn_w_o = args.in[19];
    const float* final_g = args.in[20];
    bf16* WGU = (bf16*)(ws + WS_WGU); bf16* WD = (bf16*)(ws + WS_WD); bf16* WCI = (bf16*)(ws + WS_WCI); bf16* WCO = (bf16*)(ws + WS_WCO); bf16* WQKV = (bf16*)(ws + WS_WQKV); bf16* WO = (bf16*)(ws + WS_WO);
    float* H = (float*)(ws + WS_H); bf16* HB = (bf16*)(ws + WS_HB); bf16* ACT = (bf16*)(ws + WS_ACT); bf16* BB = (bf16*)(ws + WS_BB); bf16* UB = (bf16*)(ws + WS_UB);
    bf16* QB = (bf16*)(ws + WS_Q); bf16* KB = (bf16*)(ws + WS_K); bf16* VB = (bf16*)(ws + WS_V); bf16* AUX = (bf16*)(ws + WS_AUX);
    rss_t* RSS = (rss_t*)(ws + RSS_OFF);
#define RSSK(k) (RSS + (size_t)(k) * MPAD)
    constexpr size_t NWGU = (size_t)2 * DFF * DM, NWD = (size_t)DM * DFF;
#define D8(f) (((FP8_DOWN_MASK >> (f)) & 1) != 0)
    unsigned char* HB8 = ws + WS_HB8; unsigned char* K8 = ws + WS_K8; unsigned char* VT8 = ws + WS_VT8;

    PH_BEGIN(0)
        cvt_matrix<1>(F, args.in[3] + (size_t)0 * DM * DFF, args.in[4] + (size_t)0 * DM * DFF, DFF, args.in[2] + 0 * DM, WGU + 0 * NWGU, DM, 2 * DFF);
        if (D8(0)) cvt_matrix8(F, args.in[5] + (size_t)0 * DFF * DM, DM, nullptr, pg8::FP8_W_SCALE, ws + WS_WD8 + 0 * SZ_WD8, DFF, DM);
        if (!BG_DEFER && (!D8(0))) cvt_matrix<0>(F, args.in[5] + (size_t)0 * DFF * DM, nullptr, DM, nullptr, WD + 0 * NWD, DFF, DM);
        if (!BG_DEFER) { cvt_matrix<1>(F, args.in[7] + (size_t)0 * DM * DFF, args.in[8] + (size_t)0 * DM * DFF, DFF, args.in[6] + 0 * DM, WGU + 1 * NWGU, DM, 2 * DFF); }
        if (!BG_DEFER && (D8(1))) cvt_matrix8(F, args.in[9] + (size_t)0 * DFF * DM, DM, nullptr, pg8::FP8_W_SCALE, ws + WS_WD8 + 1 * SZ_WD8, DFF, DM);
        if (!D8(1)) cvt_matrix<0>(F, args.in[9] + (size_t)0 * DFF * DM, nullptr, DM, nullptr, WD + 1 * NWD, DFF, DM);
        if (!BG_DEFER) cvt_matrix<1>(F, args.in[3] + (size_t)1 * DM * DFF, args.in[4] + (size_t)1 * DM * DFF, DFF, args.in[2] + 1 * DM, WGU + 2 * NWGU, DM, 2 * DFF);
        if (D8(2) && !BG_DEFER) cvt_matrix8(F, args.in[5] + (size_t)1 * DFF * DM, DM, nullptr, pg8::FP8_W_SCALE, ws + WS_WD8 + 2 * SZ_WD8, DFF, DM);
        if (!D8(2)) cvt_matrix<0>(F, args.in[5] + (size_t)1 * DFF * DM, nullptr, DM, nullptr, WD + 2 * NWD, DFF, DM);
        if (!BG_DEFER) cvt_matrix<1>(F, args.in[7] + (size_t)1 * DM * DFF, args.in[8] + (size_t)1 * DM * DFF, DFF, args.in[6] + 1 * DM, WGU + 3 * NWGU, DM, 2 * DFF);
        if (D8(3) && !BG_DEFER) cvt_matrix8(F, args.in[9] + (size_t)1 * DFF * DM, DM, nullptr, pg8::FP8_W_SCALE, ws + WS_WD8 + 3 * SZ_WD8, DFF, DM);
        if (!D8(3)) cvt_matrix<0>(F, args.in[9] + (size_t)1 * DFF * DM, nullptr, DM, nullptr, WD + 3 * NWD, DFF, DM);
        if (!BG_DEFER) { cvt_matrix<2>(F, conv_w_in, nullptr, 3 * DM, conv_norm, WCI, DM, 3 * DM); }
        if (!BG_DEFER) { cvt_matrix<0>(F, conv_w_out, nullptr, DM, nullptr, WCO, DM, DM); }
        if (BG_DEFER) { static_assert(!BG_DEFER || (D8(1) && D8(2) && D8(3) && !D8(0) && FP8_QKV && FP8_WO), "the background queue is written for this configuration"); }
        else if (FP8_QKV) {
            cvt_matrix8(F, attn_w_qkv, NQKV, attn_norm, pg8::FP8_W_SCALE, ws + WS_WQKV8, DM, NQKV);
            cvt_matrix<0>(F, attn_w_qkv + NHEAD * HD, nullptr, NQKV, attn_norm, WQKV + (size_t)NHEAD * HD * DM, DM, 2 * NKV * HD);
        } else cvt_matrix<0>(F, attn_w_qkv, nullptr, NQKV, attn_norm, WQKV, DM, NQKV);
        if (!BG_DEFER) { if (FP8_WO) cvt_matrix8(F, attn_w_o, DM, nullptr, pg8::FP8_W_SCALE, ws + WS_WO8, DM, DM); else cvt_matrix<0>(F, attn_w_o, nullptr, DM, nullptr, WO, DM, DM); }
        rows_init(F, x, meta, H, HB, RSSK(0));
    PH_END(0)

#define FFN_UP(ph, f, rows, rin) PH_BEGIN(ph) \
        pg8::Gemm g{HB, WGU + (size_t)(f) * NWGU, (rows), 2 * DFF, DM}; pg8::StaticOrder S; S.init((rows), 2 * DFF, F.G, F.bid); \
        pg8::EpiSwiGLU<D8(f)> E{ACT, RSSK(rin)}; \
        pg8::gemm_phase<pg8::EpiSwiGLU<D8(f)>, pg8::StaticOrder, true, true>(F.lds, g, S, E, F.wave); \
        PH_END(ph)
#define FFN_DOWN(ph, f, basep, hbp, hb8p, rout, with_meta) PH_BEGIN(ph) \
        pg8::Gemm g{ACT, D8(f) ? (const bf16*)(ws + WS_WD8 + (f) * SZ_WD8) : WD + (size_t)(f) * NWD, MREAL, DM, DFF}; pg8::StaticOrder S; S.init(MREAL, DM, F.G, F.bid); \
        pg8::EpiResid E{(basep), H, (hbp), (hb8p), RSSK(rout), D8(f) ? 0.5f / (pg8::FP8_ACT_SCALE * pg8::FP8_W_SCALE) : 0.5f}; \
        pg8::gemm_phase<pg8::EpiResid, pg8::StaticOrder, true, true, D8(f)>(F.lds, g, S, E, F.wave); \
        if (with_meta) { SkResid SE{H, H, HB, RSSK(rout), D8(f) ? 0.5f / (pg8::FP8_ACT_SCALE * pg8::FP8_W_SCALE) : 0.5f}; \
            if (D8(f)) skinny_phase8<SkResid>(F, (const unsigned char*)ACT + (size_t)MREAL * DFF, ws + WS_WD8 + (f) * SZ_WD8, DFF, DM / 32, SE); \
            else skinny_phase<1, SkResid>(F, ACT + (size_t)MREAL * DFF, WD + (size_t)(f) * NWD, DFF, DM / 32, SE); } \
        PH_END(ph)

    FFN_UP(1, 0, MPAD, 0)
    FFN_DOWN(2, 0, x, HB, (unsigned char*)nullptr, 1, true)
    PH_BEGIN(3)
        pg8::Gemm g{HB, WCI, MREAL, 3 * DM, DM}; pg8::StaticOrder S; S.init(MREAL, 3 * DM, F.G, F.bid);
        pg8::EpiConvIn E{BB, UB, RSSK(1)};
        pg8::gemm_phase<pg8::EpiConvIn, pg8::StaticOrder, true, true>(F.lds, g, S, E, F.wave);
        SkConvIn SE{BB, UB, RSSK(1)}; skinny_phase<3, SkConvIn>(F, HB + (size_t)MREAL * DM, WCI, DM, DM / 32, SE);
    PH_END(3)
    PH_BEGIN(4) conv_pass(F, BB, UB, conv_w, conv_b, AUX); PH_END(4)
    PH_BEGIN(5)
        pg8::Gemm g{AUX, WCO, MREAL, DM, DM}; pg8::StaticOrder S; S.init(MREAL, DM, F.G, F.bid);
        pg8::EpiResid E{H, H, HB, (unsigned char*)nullptr, RSSK(2), 1.0f};
        pg8::gemm_phase<pg8::EpiResid, pg8::StaticOrder, true, true>(F.lds, g, S, E, F.wave);
        SkResid SE{H, H, HB, RSSK(2), 1.0f}; skinny_phase<1, SkResid>(F, AUX + (size_t)MREAL * DM, WCO, DM, DM / 32, SE);
    PH_END(5)
    FFN_UP(6, 1, MPAD, 2)
    FFN_DOWN(7, 1, H, HB, (unsigned char*)nullptr, 3, true)
    FFN_UP(8, 2, MPAD, 3)
    FFN_DOWN(9, 2, H, HB, FP8_QKV ? HB8 : (unsigned char*)nullptr, 4, true)
    PH_BEGIN(10)
        pg8::Gemm g{FP8_QKV ? (const bf16*)HB8 : HB, FP8_QKV ? (const bf16*)(ws + WS_WQKV8) : WQKV, MREAL, NQKV, DM}; pg8::StaticOrder S; S.init(MREAL, NQKV, F.G, F.bid);
        pg8::EpiQKV E{QB, KB, VB, RSSK(4), FP8_QKV ? 1.0f / (pg8::FP8_H_SCALE * pg8::FP8_W_SCALE) : 1.0f};
        pg8::gemm_phase<pg8::EpiQKV, pg8::StaticOrder, true, true, FP8_QKV != 0>(F.lds, g, S, E, F.wave);
        SkKV SE{KB, VB, RSSK(4)}; skinny_phase<1, SkKV>(F, HB + (size_t)MREAL * DM, WQKV + (size_t)NHEAD * HD * DM, DM, 2 * NKV * HD / 32, SE);
        for (int i = F.bid * (NWAVES * 64) + F.tid; i < NB * 48 * (NKV * HD / 8); i += F.G * NWAVES * 64) {
            const int b = i / (48 * 128), r = (i / 128) % 48, c = (i & 127) * 8; const size_t o = (size_t)(b * KVROWS + NMETA + r) * (NKV * HD) + c;
            *(GAS v4u*)(KB + o) = (v4u){0u, 0u, 0u, 0u}; *(GAS v4u*)(VB + o) = (v4u){0u, 0u, 0u, 0u};
        }
    PH_END(10)
    PH_BEGIN(11) if (FP8_ATTN) kv_prep8_pass<false>(F, KB, VB, k_gain, K8, VT8); else k_prep_pass(F, KB, k_gain); PH_END(11)
    PH_BEGIN(12)
        constexpr int NUNITS = NB * NHEAD * (SEQ / 256);
        const bool xcd_deal = (F.G == 256);
        for (int i = 0;; ++i) {
            int un;
            if (xcd_deal) { if (i >= 8) break; un = (F.bid & 7) * 256 + i * 32 + (F.bid >> 3); } else { un = i * F.G + F.bid; if (un >= NUNITS) break; }
            const int grp = un >> 7, rem = un & 127, b = grp >> 3, kvh = grp & 7, hq = kvh * 4 + (rem >> 5), qb = rem & 31;
            const size_t qoff = (size_t)(b * SEQ + qb * 256) * DM + hq * HD, koff = (size_t)(b * KVROWS) * (NKV * HD) + kvh * HD;
            if (FP8_ATTN) att8::attn_unit8(QB + qoff, K8 + koff, VT8 + (size_t)grp * (KVROWS / 64) * 8192, (unsigned char*)AUX + qoff, (char*)lds_raw, F.lds, F.wave, q_gain, qb * 256);
            else att::attn_unit<FP8_WO != 0>(QB + qoff, KB + koff, VB + koff, FP8_WO ? (void*)((unsigned char*)AUX + qoff) : (void*)(AUX + qoff), (char*)lds_raw, F.wave, q_gain, qb * 256);
        }
    PH_END(12)
    PH_BEGIN(13)
        pg8::Gemm g{AUX, FP8_WO ? (const bf16*)(ws + WS_WO8) : WO, MREAL, DM, DM}; pg8::StaticOrder S; S.init(MREAL, DM, F.G, F.bid);
        pg8::EpiResid E{H, H, HB, (unsigned char*)nullptr, RSSK(5), FP8_WO ? 1.0f / (pg8::FP8_O_SCALE * pg8::FP8_W_SCALE) : 1.0f};
        pg8::gemm_phase<pg8::EpiResid, pg8::StaticOrder, true, true, FP8_WO != 0>(F.lds, g, S, E, F.wave);
    PH_END(13)
    FFN_UP(14, 3, MREAL, 5)
    FFN_DOWN(15, 3, H, (bf16*)nullptr, (unsigned char*)nullptr, 6, false)
    PH_BEGIN(16) final_norm_pass(F, H, RSSK(6), final_g, args.out); PH_END(16)
#undef IN
#undef SEAM
}

extern "C" void kernel_launch(void* const* d_in, const int* in_sizes, int n_in, void* d_out, int out_size, void* d_ws, size_t ws_size, hipStream_t stream) {
    static int grid = 0;
    if (grid == 0) {
        if (n_in != 21 || in_sizes[0] != MREAL * DM || out_size != MREAL * DM || ws_size < WS_END) {
            fprintf(stderr, "kernel_launch: built for 21 inputs, x/out of %d floats, >= %zu bytes of workspace; got n_in %d, in0 %d, out %d, ws %zu; nothing launched\n", MREAL * DM, (size_t)WS_END, n_in, n_in > 0 ? in_sizes[0] : -1, out_size, ws_size);
            grid = -1; return; }
        int dev = 0, cus = 0, per_cu = 0;
        if (hipGetDevice(&dev) != hipSuccess || hipDeviceGetAttribute(&cus, hipDeviceAttributeMultiprocessorCount, dev) != hipSuccess) { fprintf(stderr, "kernel_launch: device query failed\n"); grid = -1; return; }
        if (hipFuncSetAttribute((const void*)fwd_kernel, hipFuncAttributeMaxDynamicSharedMemorySize, LDS_BYTES) != hipSuccess) { fprintf(stderr, "kernel_launch: hipFuncSetAttribute failed\n"); grid = -1; return; }
        if (hipOccupancyMaxActiveBlocksPerMultiprocessor(&per_cu, (const void*)fwd_kernel, NWAVES * 64, LDS_BYTES) != hipSuccess || per_cu < 1)
            fprintf(stderr, "kernel_launch: note: occupancy query reports %d workgroups per CU\n", per_cu);
        (void)hipGetLastError();
        grid = cus;
    }
    if (grid < 0) return;
    if (hipMemsetAsync(d_ws, 0, CTL_ZERO_BYTES, stream) != hipSuccess) { fprintf(stderr, "kernel_launch: hipMemsetAsync failed\n"); return; }
    Args a{};
    for (int i = 0; i < 21; ++i) a.in[i] = (const float*)d_in[i];
    a.out = (float*)d_out; a.ws = (unsigned char*)d_ws;
#if MK_ONE_LAUNCH
    a.ph_lo = 0; a.ph_hi = N_PHASES;
    hipLaunchKernelGGL(fwd_kernel, dim3(grid), dim3(NWAVES * 64), LDS_BYTES, stream, a);
#else
    for (int p = 0; p < N_PHASES; ++p) { a.ph_lo = p; a.ph_hi = p + 1; hipLaunchKernelGGL(fwd_kernel, dim3(grid), dim3(NWAVES * 64), LDS_BYTES, stream, a); }
#endif
    const hipError_t le = hipPeekAtLastError();
    if (le != hipSuccess) fprintf(stderr, "kernel_launch: launch failed: %s\n", hipGetErrorName(le));
}
```

```cpp
#include <hip/hip_runtime.h>
#include <hip/hip_bf16.h>
#include <cstdio>
#include <cstdint>

constexpr int DM = 4096, DFF = 11008, SEQ = 8192, NB = 2, NMETA = 16, NHEAD = 32, NKV = 8, HD = 128;
constexpr int MREAL = NB * SEQ;
constexpr int MVALID = MREAL + NB * NMETA;
constexpr int MPAD = 16640;
constexpr int KVROWS = 64 + SEQ;
constexpr int NQKV = (NHEAD + 2 * NKV) * HD;
constexpr float RMS_EPS = 1e-6f;

typedef unsigned long long rss_t;
constexpr float RSS_FX = 16777216.0f;
__device__ __forceinline__ rss_t rss_fix(float ss) { return (rss_t)(ss * RSS_FX + 0.5f); }
__device__ __forceinline__ void rss_add(rss_t* p, float ss) { (void)__hip_atomic_fetch_add(p, rss_fix(ss), __ATOMIC_RELAXED, __HIP_MEMORY_SCOPE_AGENT); }
__device__ __forceinline__ float rstd_from_ss(rss_t v) { return __builtin_amdgcn_rsqf((float)v * (1.0f / (RSS_FX * (float)DM)) + RMS_EPS); }
__device__ __forceinline__ float silu_f(float x) { return x * __builtin_amdgcn_rcpf(1.0f + __builtin_amdgcn_exp2f(-1.4426950408889634f * x)); }
__device__ __forceinline__ int kv_row_of_real(int row) { return (row >> 13) * KVROWS + 64 + (row & (SEQ - 1)); }

namespace pg8 {
#define PG8_LAS __attribute__((address_space(3)))
typedef unsigned short bf16_t;
typedef short bf16x8 __attribute__((ext_vector_type(8)));
typedef float f32x4 __attribute__((ext_vector_type(4)));
typedef unsigned u32x4 __attribute__((ext_vector_type(4)));
constexpr int BM = 256, BK = 64, HALF = 128, HTB = HALF * BK * 2  , STAGE_BYTES = 8 * HTB, NXCD = 8, WGM = 8;

__host__ __device__ __forceinline__ int lds_byte(int r, int c) { const int st = (r >> 4) * 2 + (c >> 5), rr = r & 15, cc = c & 31, ob = rr * 64 + cc * 2; return st * 1024 + (ob ^ (((ob >> 9) & 1) << 5)); }
__host__ __device__ __forceinline__ void stage_rc(int b, int& R, int& C) { const int st = b / 1024, sb = b % 1024, swz = sb ^ (((sb >> 9) & 1) << 5); R = (st >> 1) * 16 + swz / 64; C = (st & 1) * 32 + (swz % 64) / 2; }
__host__ __device__ __forceinline__ int perm32(int rho) { const int n = rho >> 4, i = rho & 15; return 8 * (i >> 2) + 4 * n + (i & 3); }

struct Unit { int pm, pn; };
struct Gemm { const bf16_t* A; const bf16_t* Bt; int M, N, K; };

struct StaticOrder {
    int nM, nN, nwg, G, c;
    __host__ __device__ void init(int M, int N, int G_, int c_) { nM = M / BM; nN = N / BM; nwg = nM * nN; G = G_; c = c_; }
    __host__ __device__ bool next(int i, Unit& u) const {
        const long L = (long)i * G + c; if (L >= nwg) return false;
        int wgid = (int)L; { const int q = nwg / NXCD, r = nwg % NXCD, xcd = wgid % NXCD, off = wgid / NXCD; wgid = (xcd < r ? xcd * (q + 1) : r * (q + 1) + (xcd - r) * q) + off; }
        const int nig = WGM * nN, gid = wgid / nig, fm = gid * WGM, gsz = (nM - fm) < WGM ? (nM - fm) : WGM;
        u.pm = fm + ((wgid % nig) % gsz); u.pn = (wgid % nig) / gsz; return true;
    }
    __device__ __forceinline__ void a_ready(const Unit&) const {}
    __device__ __forceinline__ void done(const Unit&) const {}
};

__device__ __forceinline__ unsigned cvt_pk_bf16(float lo, float hi) { unsigned r; asm volatile("v_cvt_pk_bf16_f32 %0, %1, %2" : "=v"(r) : "v"(lo), "v"(hi)); return r; }

__device__ __forceinline__ u32x4 pack8(const f32x4 a, const f32x4 b) { u32x4 w; w.x = cvt_pk_bf16(a[0], a[1]); w.y = cvt_pk_bf16(a[2], a[3]); w.z = cvt_pk_bf16(b[0], b[1]); w.w = cvt_pk_bf16(b[2], b[3]); return w; }

typedef int i32x8 __attribute__((ext_vector_type(8)));
__device__ __forceinline__ i32x8 cat8(const bf16x8 a, const bf16x8 b) { typedef int i32x4 __attribute__((ext_vector_type(4))); const i32x4 x = __builtin_bit_cast(i32x4, a), y = __builtin_bit_cast(i32x4, b); return (i32x8){x[0], x[1], x[2], x[3], y[0], y[1], y[2], y[3]}; }
__device__ __forceinline__ unsigned pack_fp8x4(const f32x4 v) {
    int w = 0;
    w = __builtin_amdgcn_cvt_pk_fp8_f32(__builtin_amdgcn_fmed3f(v[0], -448.f, 448.f), __builtin_amdgcn_fmed3f(v[1], -448.f, 448.f), w, false);
    w = __builtin_amdgcn_cvt_pk_fp8_f32(__builtin_amdgcn_fmed3f(v[2], -448.f, 448.f), __builtin_amdgcn_fmed3f(v[3], -448.f, 448.f), w, true);
    return (unsigned)w;
}
constexpr float FP8_ACT_SCALE = 4.f, FP8_W_SCALE = 64.f, FP8_H_SCALE = 8.f, FP8_O_SCALE = 16.f;

template <bool OUT8> struct EpiSwiGLU {
    static constexpr bool PERM = true, AFTER_DRAIN = false;
    bf16_t* act; const rss_t* rss;
    __device__ __forceinline__ void operator()(const f32x4 (&acc)[2][2][4][2], const Unit& u, int wr, int wc, int fr, int fq) const {
        const int row0 = u.pm * BM + wr * 64 + fr, col0 = u.pn * 128 + wc * 32 + 8 * fq;
#pragma unroll
        for (int ai = 0; ai < 2; ++ai)
#pragma unroll
            for (int m = 0; m < 4; ++m) {
                const int row = row0 + ai * HALF + m * 16;
                const float rs = rstd_from_ss(rss[row]);
                f32x4 o[2];
#pragma unroll
                for (int n = 0; n < 2; ++n)
#pragma unroll
                    for (int j = 0; j < 4; ++j) o[n][j] = silu_f(acc[ai][0][m][n][j] * rs) * (acc[ai][1][m][n][j] * rs);
                if constexpr (OUT8) { typedef unsigned u32x2 __attribute__((ext_vector_type(2))); *(u32x2*)((unsigned char*)act + (size_t)row * DFF + col0) = (u32x2){pack_fp8x4(o[0] * FP8_ACT_SCALE), pack_fp8x4(o[1] * FP8_ACT_SCALE)}; }
                else *(u32x4*)(act + (size_t)row * DFF + col0) = pack8(o[0], o[1]);
            }
    }
};

struct EpiResid {
    static constexpr bool PERM = true, AFTER_DRAIN = false;
    const float* base; float* out; bf16_t* hb; unsigned char* hb8; rss_t* rss_out; float scale;
    __device__ __forceinline__ void operator()(const f32x4 (&acc)[2][2][4][2], const Unit& u, int wr, int wc, int fr, int fq) const {
        const int lane = fq * 16 + fr;
        const int row0 = u.pm * BM + wr * 64 + fr, colb = u.pn * BM + wc * 32 + 8 * fq;
#pragma unroll
        for (int ai = 0; ai < 2; ++ai) {
            float sel = 0.f;
            f32x4 bv[4][2][2];
#pragma unroll
            for (int m = 0; m < 4; ++m)
#pragma unroll
                for (int bj = 0; bj < 2; ++bj) { const size_t o = (size_t)(row0 + ai * HALF + m * 16) * DM + colb + bj * HALF;
                    bv[m][bj][0] = *(const f32x4*)(base + o); bv[m][bj][1] = *(const f32x4*)(base + o + 4); }
#pragma unroll
            for (int m = 0; m < 4; ++m) {
                const size_t ro = (size_t)(row0 + ai * HALF + m * 16) * DM + colb;
                float ss = 0.f;
#pragma unroll
                for (int bj = 0; bj < 2; ++bj) {
                    const size_t o = ro + bj * HALF;
                    const f32x4 v0 = bv[m][bj][0] + acc[ai][bj][m][0] * scale, v1 = bv[m][bj][1] + acc[ai][bj][m][1] * scale;
                    *(f32x4*)(out + o) = v0; *(f32x4*)(out + o + 4) = v1;
                    if (hb) *(u32x4*)(hb + o) = pack8(v0, v1);
                    if (hb8) { typedef unsigned u32x2 __attribute__((ext_vector_type(2))); *(u32x2*)(hb8 + o) = (u32x2){pack_fp8x4(v0 * FP8_H_SCALE), pack_fp8x4(v1 * FP8_H_SCALE)}; }
                    ss += (v0[0] * v0[0] + v0[1] * v0[1]) + (v0[2] * v0[2] + v0[3] * v0[3]) + (v1[0] * v1[0] + v1[1] * v1[1]) + (v1[2] * v1[2] + v1[3] * v1[3]);
                }
                ss += __shfl_xor(ss, 16); ss += __shfl_xor(ss, 32);
                sel = (fq == m) ? ss : sel;
            }
            rss_add(rss_out + u.pm * BM + ai * HALF + wr * 64 + lane, sel);
            asm volatile("" ::: "memory");
        }
    }
};

struct EpiConvIn {
    static constexpr bool PERM = true, AFTER_DRAIN = false;
    bf16_t* bbuf; bf16_t* ubuf; const rss_t* rss;
    __device__ __forceinline__ void operator()(const f32x4 (&acc)[2][2][4][2], const Unit& u, int wr, int wc, int fr, int fq) const {
        const int row0 = u.pm * BM + wr * 64 + fr;
        if (u.pn < 32) {
            const int col0 = u.pn * 128 + wc * 32 + 8 * fq;
#pragma unroll
            for (int ai = 0; ai < 2; ++ai)
#pragma unroll
                for (int m = 0; m < 4; ++m) {
                    const int row = row0 + ai * HALF + m * 16;
                    const float rs = rstd_from_ss(rss[row]);
                    f32x4 o[2];
#pragma unroll
                    for (int n = 0; n < 2; ++n) o[n] = (acc[ai][0][m][n] * rs) * (acc[ai][1][m][n] * rs);
                    *(u32x4*)(ubuf + (size_t)row * DM + col0) = pack8(o[0], o[1]);
                }
        } else {
            const int colb = (u.pn - 32) * BM + wc * 32 + 8 * fq;
#pragma unroll
            for (int ai = 0; ai < 2; ++ai)
#pragma unroll
                for (int m = 0; m < 4; ++m) {
                    const int row = row0 + ai * HALF + m * 16;
                    const float rs = rstd_from_ss(rss[row]);
#pragma unroll
                    for (int bj = 0; bj < 2; ++bj) *(u32x4*)(bbuf + (size_t)row * DM + colb + bj * HALF) = pack8(acc[ai][bj][m][0] * rs, acc[ai][bj][m][1] * rs);
                }
        }
    }
};

struct EpiQKV {
    static constexpr bool PERM = true, AFTER_DRAIN = false;
    bf16_t* q; bf16_t* k; bf16_t* v; const rss_t* rss; float cs;
    __device__ __forceinline__ void operator()(const f32x4 (&acc)[2][2][4][2], const Unit& u, int wr, int wc, int fr, int fq) const {
        const int row0 = u.pm * BM + wr * 64 + fr;
        bf16_t* dst; int ld, colb; const bool isq = u.pn < 16;
        if (isq) { dst = q; ld = DM; colb = u.pn * BM; } else if (u.pn < 20) { dst = k; ld = NKV * HD; colb = (u.pn - 16) * BM; } else { dst = v; ld = NKV * HD; colb = (u.pn - 20) * BM; }
        colb += wc * 32 + 8 * fq;
#pragma unroll
        for (int ai = 0; ai < 2; ++ai)
#pragma unroll
            for (int m = 0; m < 4; ++m) {
                const int row = row0 + ai * HALF + m * 16;
                const float rs = rstd_from_ss(rss[row]) * cs;
                const int drow = isq ? row : kv_row_of_real(row);
#pragma unroll
                for (int bj = 0; bj < 2; ++bj) *(u32x4*)(dst + (size_t)drow * ld + colb + bj * HALF) = pack8(acc[ai][bj][m][0] * rs, acc[ai][bj][m][1] * rs);
            }
    }
};

template <class Epi, class Sched, bool ALIGN_EPI = false, bool SP2 = false, bool FP8 = false>
__device__ __forceinline__ void gemm_phase(PG8_LAS unsigned char* lds, const Gemm g, const Sched& S, const Epi& E, const int wid) {
    int lane; asm volatile("v_mbcnt_lo_u32_b32 %0, -1, 0\n\tv_mbcnt_hi_u32_b32 %0, -1, %0" : "=v"(lane));
    const int tid = wid * 64 + lane, wr = wid >> 2, wc = wid & 3, fr = lane & 15, fq = lane >> 4;
    const int KB = FP8 ? g.K : 2 * g.K, nt = KB / (BK * 2);
    unsigned voffA[2], voffB[2];
#pragma unroll
    for (int i = 0; i < 2; ++i) { int R, C; stage_rc(tid * 16 + i * 8192, R, C); const int Rb = Epi::PERM ? ((R & ~31) + perm32(R & 31)) : R;
        voffA[i] = (unsigned)(R * KB + C * 2); voffB[i] = (unsigned)(Rb * KB + C * 2); }
    const size_t kstep = (size_t)(BK * 2);
    const size_t hstep = (size_t)HALF * KB;
    const size_t tstep = 2 * hstep;
    const unsigned ldsw = (unsigned)wid * 1024u;
    const int aoff = lds_byte(wr * 64 + fr, fq * 8), boff = lds_byte(wc * 32 + fr, fq * 8);
#define PG8_SA(b, h) (((b) * 2 + (h)) * HTB)
#define PG8_SB(b, h) ((4 + (b) * 2 + (h)) * HTB)
#define PG8_STAGE(bufoff, gbase, voff) do { _Pragma("unroll") for (int _i = 0; _i < 2; ++_i) \
        __builtin_amdgcn_global_load_lds((const unsigned*)((const char*)(gbase) + (voff)[_i]), (PG8_LAS unsigned*)(lds + (bufoff) + ldsw + _i * 8192), 16, 0, 0); } while (0)
#define PG8_LDA(dst, b, h) do { _Pragma("unroll") for (int m = 0; m < 4; ++m) _Pragma("unroll") for (int k = 0; k < 2; ++k) dst[m][k] = *(const PG8_LAS bf16x8*)(lds + PG8_SA(b, h) + aoff + m * 2048 + k * 1024); } while (0)
#define PG8_LDB(dst, b, h) do { _Pragma("unroll") for (int n = 0; n < 2; ++n) _Pragma("unroll") for (int k = 0; k < 2; ++k) dst[n][k] = *(const PG8_LAS bf16x8*)(lds + PG8_SB(b, h) + boff + n * 2048 + k * 1024); } while (0)
#define PG8_MMA(ai, bj, At, Bt) do { __builtin_amdgcn_s_setprio(1); if constexpr (FP8) { _Pragma("unroll") for (int m = 0; m < 4; ++m) _Pragma("unroll") for (int n = 0; n < 2; ++n) \
        asm volatile("v_mfma_f32_16x16x128_f8f6f4 %0, %1, %2, %0" : "+v"(acc[ai][bj][m][n]) : "v"(cat8(Bt[n][0], Bt[n][1])), "v"(cat8(At[m][0], At[m][1]))); } \
        else { _Pragma("unroll") for (int m = 0; m < 4; ++m) _Pragma("unroll") for (int n = 0; n < 2; ++n) _Pragma("unroll") for (int k = 0; k < 2; ++k) \
        acc[ai][bj][m][n] = __builtin_amdgcn_mfma_f32_16x16x32_bf16(Bt[n][k], At[m][k], acc[ai][bj][m][n], 0, 0, 0); } __builtin_amdgcn_s_setprio(0); } while (0)
#define PG8_WAIT_V(n) asm volatile("s_waitcnt vmcnt(" #n ")" ::: "memory")
#define PG8_WAIT_L(n) asm volatile("s_waitcnt lgkmcnt(" #n ")" ::: "memory")
#define PG8_BAR __builtin_amdgcn_s_barrier()
#define PG8_SCHED __builtin_amdgcn_sched_barrier(0)
    Unit cur, nxt; int ui = 0;
    if (!S.next(0, cur)) return;
    f32x4 acc[2][2][4][2];
#pragma unroll
    for (int a = 0; a < 2; ++a)
#pragma unroll
        for (int b = 0; b < 2; ++b)
#pragma unroll
            for (int m = 0; m < 4; ++m)
#pragma unroll
                for (int n = 0; n < 2; ++n) acc[a][b][m][n] = (f32x4){0.f, 0.f, 0.f, 0.f};
    bf16x8 At[4][2], B0[2][2], B1[2][2];
    const char* cA = (const char*)g.A + (size_t)cur.pm * tstep; const char* cB = (const char*)g.Bt + (size_t)cur.pn * tstep;
    S.a_ready(cur);
    if constexpr (SP2) {
        PG8_STAGE(PG8_SB(0, 0), cB, voffB); PG8_STAGE(PG8_SB(0, 1), cB + hstep, voffB); PG8_STAGE(PG8_SA(0, 0), cA, voffA); PG8_STAGE(PG8_SA(0, 1), cA + hstep, voffA);
        if (wr == 1) PG8_BAR;
        PG8_WAIT_V(2); PG8_BAR;
        PG8_STAGE(PG8_SB(1, 0), cB + kstep, voffB); PG8_STAGE(PG8_SA(1, 0), cA + kstep, voffA); PG8_STAGE(PG8_SB(1, 1), cB + hstep + kstep, voffB);
        PG8_WAIT_V(6); PG8_BAR;
    } else {
        PG8_STAGE(PG8_SB(0, 0), cB, voffB); PG8_STAGE(PG8_SA(0, 0), cA, voffA); PG8_STAGE(PG8_SB(0, 1), cB + hstep, voffB); PG8_STAGE(PG8_SA(0, 1), cA + hstep, voffA);
        if (wr == 1) PG8_BAR;
        PG8_WAIT_V(4); PG8_BAR;
        PG8_STAGE(PG8_SB(1, 0), cB + kstep, voffB); PG8_STAGE(PG8_SA(1, 0), cA + kstep, voffA); PG8_STAGE(PG8_SB(1, 1), cB + hstep + kstep, voffB);
        PG8_WAIT_V(6); PG8_BAR;
    }
    for (;;) {
        const bool has_next = S.next(ui + 1, nxt);
        const char* nA = has_next ? (const char*)g.A + (size_t)nxt.pm * tstep : cA; const char* nB = has_next ? (const char*)g.Bt + (size_t)nxt.pn * tstep : cB;
        for (int t = 0; t < nt; t += 2) {
            const bool last = (t == nt - 2);
            const char* a1 = cA + (size_t)(t + 1) * kstep;
            const char* a2 = last ? nA : cA + (size_t)(t + 2) * kstep; const char* b2 = last ? nB : cB + (size_t)(t + 2) * kstep;
            const char* a3 = a2 + kstep; const char* b3 = b2 + kstep;
            if (last && has_next) S.a_ready(nxt);
            if constexpr (SP2) {
            PG8_LDB(B0, 0, 0); PG8_LDB(B1, 0, 1); PG8_SCHED; PG8_LDA(At, 0, 0); PG8_STAGE(PG8_SA(1, 1), a1 + hstep, voffA);
            PG8_WAIT_V(8); PG8_WAIT_L(0); PG8_BAR; PG8_MMA(0, 0, At, B0); PG8_MMA(0, 1, At, B1); PG8_BAR; PG8_SCHED;
            PG8_LDA(At, 0, 1); PG8_STAGE(PG8_SB(0, 0), b2, voffB); PG8_STAGE(PG8_SB(0, 1), b2 + hstep, voffB); PG8_STAGE(PG8_SA(0, 0), a2, voffA);
            PG8_WAIT_V(8); PG8_WAIT_L(0); PG8_BAR; PG8_MMA(1, 0, At, B0); PG8_MMA(1, 1, At, B1); PG8_BAR; PG8_SCHED;
            PG8_LDB(B0, 1, 0); PG8_LDB(B1, 1, 1); PG8_SCHED; PG8_LDA(At, 1, 0); PG8_STAGE(PG8_SA(0, 1), a2 + hstep, voffA);
            PG8_WAIT_V(8); PG8_WAIT_L(0); PG8_BAR; PG8_MMA(0, 0, At, B0); PG8_MMA(0, 1, At, B1); PG8_BAR; PG8_SCHED;
            PG8_LDA(At, 1, 1); PG8_STAGE(PG8_SB(1, 0), b3, voffB); PG8_STAGE(PG8_SB(1, 1), b3 + hstep, voffB); PG8_STAGE(PG8_SA(1, 0), a3, voffA);
            PG8_WAIT_V(8); PG8_WAIT_L(0); PG8_BAR; PG8_MMA(1, 0, At, B0); PG8_MMA(1, 1, At, B1); PG8_BAR; PG8_SCHED;
            } else {
            PG8_LDB(B0, 0, 0); PG8_SCHED; PG8_LDA(At, 0, 0); PG8_STAGE(PG8_SA(1, 1), a1 + hstep, voffA);
            PG8_WAIT_L(8); PG8_BAR; PG8_WAIT_L(0); PG8_MMA(0, 0, At, B0); PG8_BAR; PG8_SCHED;
            PG8_LDB(B1, 0, 1); PG8_STAGE(PG8_SB(0, 0), b2, voffB);
            PG8_BAR; PG8_WAIT_L(0); PG8_MMA(0, 1, At, B1); PG8_BAR;
            PG8_LDA(At, 0, 1); PG8_STAGE(PG8_SA(0, 0), a2, voffA);
            PG8_BAR; PG8_WAIT_L(0); PG8_MMA(1, 0, At, B0); PG8_BAR; PG8_SCHED;
            PG8_STAGE(PG8_SB(0, 1), b2 + hstep, voffB);
            PG8_WAIT_V(6); PG8_BAR; PG8_MMA(1, 1, At, B1); PG8_BAR;
            PG8_LDB(B0, 1, 0); PG8_SCHED; PG8_LDA(At, 1, 0); PG8_STAGE(PG8_SA(0, 1), a2 + hstep, voffA);
            PG8_WAIT_L(8); PG8_BAR; PG8_WAIT_L(0); PG8_MMA(0, 0, At, B0); PG8_BAR; PG8_SCHED;
            PG8_LDB(B1, 1, 1); PG8_STAGE(PG8_SB(1, 0), b3, voffB);
            PG8_BAR; PG8_WAIT_L(0); PG8_MMA(0, 1, At, B1); PG8_BAR;
            PG8_LDA(At, 1, 1); PG8_STAGE(PG8_SA(1, 0), a3, voffA);
            PG8_BAR; PG8_WAIT_L(0); PG8_MMA(1, 0, At, B0); PG8_BAR; PG8_SCHED;
            PG8_STAGE(PG8_SB(1, 1), b3 + hstep, voffB);
            PG8_WAIT_V(6); PG8_BAR; PG8_MMA(1, 1, At, B1); PG8_BAR;
            }
        }
        if constexpr (FP8) {
            asm volatile("s_nop 15\n\ts_nop 15" : "+v"(At[0][0]), "+v"(At[0][1]), "+v"(At[1][0]), "+v"(At[1][1]), "+v"(At[2][0]), "+v"(At[2][1]), "+v"(At[3][0]), "+v"(At[3][1]),
                         "+v"(B0[0][0]), "+v"(B0[0][1]), "+v"(B0[1][0]), "+v"(B0[1][1]), "+v"(B1[0][0]), "+v"(B1[0][1]), "+v"(B1[1][0]), "+v"(B1[1][1]) :: "memory");
        }
        if constexpr (ALIGN_EPI) { if (wr == 0) PG8_BAR; }
        if constexpr (FP8) {
            asm volatile("s_nop 15\n\ts_nop 15\n\ts_nop 7" : "+v"(acc[1][1][0][0]), "+v"(acc[1][1][0][1]), "+v"(acc[1][1][1][0]), "+v"(acc[1][1][1][1]), "+v"(acc[1][1][2][0]), "+v"(acc[1][1][2][1]), "+v"(acc[1][1][3][0]), "+v"(acc[1][1][3][1]) :: "memory");
            asm volatile("" : "+v"(acc[1][0][0][0]), "+v"(acc[1][0][0][1]), "+v"(acc[1][0][1][0]), "+v"(acc[1][0][1][1]), "+v"(acc[1][0][2][0]), "+v"(acc[1][0][2][1]), "+v"(acc[1][0][3][0]), "+v"(acc[1][0][3][1]));
        }
        if constexpr (!Epi::AFTER_DRAIN) { E(acc, cur, wr, wc, fr, fq); S.done(cur); }
        if (!has_next) break;
#pragma unroll
        for (int a = 0; a < 2; ++a)
#pragma unroll
            for (int b = 0; b < 2; ++b)
#pragma unroll
                for (int m = 0; m < 4; ++m)
#pragma unroll
                    for (int n = 0; n < 2; ++n) acc[a][b][m][n] = (f32x4){0.f, 0.f, 0.f, 0.f};
        cur = nxt; cA = nA; cB = nB; ++ui;
        if constexpr (ALIGN_EPI) { if (wr == 1) PG8_BAR; }
    }
    PG8_WAIT_V(0);
    if constexpr (!ALIGN_EPI) { if (wr == 0) PG8_BAR; }
    PG8_BAR;
    if constexpr (Epi::AFTER_DRAIN) { E.fused(acc, cur, wr, wc, fr, fq, lds, wid, lane); S.done(cur); }
#undef PG8_SA
#undef PG8_SB
#undef PG8_STAGE
#undef PG8_LDA
#undef PG8_LDB
#undef PG8_MMA
#undef PG8_WAIT_V
#undef PG8_WAIT_L
#undef PG8_BAR
#undef PG8_SCHED
}
}

namespace att {
typedef unsigned short bf16_t;
using bf16x8 = __attribute__((ext_vector_type(8))) short;
using s16x4  = __attribute__((ext_vector_type(4))) short;
using f32x16 = __attribute__((ext_vector_type(16))) float;
using u32x4  = __attribute__((ext_vector_type(4))) unsigned;
using f32x4  = __attribute__((ext_vector_type(4))) float;
constexpr int D = 128, NW = 8, QBLK = 32, KVBLK = 64;
constexpr float SCALE = 0.088388347648318440f;
constexpr float THR = 8.f;
constexpr int LDQ = NHEAD * HD, LDK = NKV * HD, LDO = NHEAD * HD;
constexpr int SHM_V = KVBLK * D * 2, SHM_K = KVBLK * D * 2, SHM_ATTN = 2 * SHM_V + 2 * SHM_K + NW * 64 * 4;
constexpr int NT = KVROWS / KVBLK;
static_assert(NT % 2 == 1 && NT >= 3, "the loop below is written for an odd tile count");
#define KSWZ(row, colB) ((row) * 256 + ((colB) ^ (((row) & 7) << 4)))
#define SBAR() __builtin_amdgcn_sched_barrier(0)
__device__ __forceinline__ int crow(int r, int hi) { return (r & 3) + 8 * (r >> 2) + 4 * hi; }
__device__ __forceinline__ unsigned cvtpk(float lo, float hi) { unsigned r; asm volatile("v_cvt_pk_bf16_f32 %0, %1, %2" : "=v"(r) : "v"(lo), "v"(hi)); return r; }

__device__ __forceinline__ void partialSM(f32x16& p0, f32x16& p1, float& m_reg, float& mn, float& alpha) {
  constexpr float C = SCALE * 1.4426950408889634f;
  float pmax = p0[0];
#pragma unroll
  for (int r = 1; r < 16; ++r) pmax = fmaxf(pmax, p0[r]);
#pragma unroll
  for (int r = 0; r < 16; ++r) pmax = fmaxf(pmax, p1[r]);
  { auto rr = __builtin_amdgcn_permlane32_swap(__float_as_uint(pmax), __float_as_uint(pmax), false, false);
    pmax = fmaxf(__uint_as_float(rr[0]), __uint_as_float(rr[1])); }
  if (__builtin_expect(__all(pmax - m_reg <= THR / SCALE), 1)) { mn = m_reg; alpha = 1.f; }
  else { mn = fmaxf(m_reg, pmax); alpha = __builtin_amdgcn_exp2f((m_reg - mn) * C); m_reg = mn; }
  float mnC = -mn * C;
#pragma unroll
  for (int r = 0; r < 16; ++r) p0[r] = fmaf(p0[r], C, mnC);
#pragma unroll
  for (int r = 0; r < 16; ++r) p1[r] = fmaf(p1[r], C, mnC);
#pragma unroll
  for (int r = 0; r < 16; ++r) p0[r] = __builtin_amdgcn_exp2f(p0[r]);
}
__device__ __forceinline__ void finishSM(f32x16& p0, f32x16& p1, float alpha, float& l_reg, bf16x8& pa0, bf16x8& pa1, bf16x8& pa2, bf16x8& pa3) {
#pragma unroll
  for (int r = 0; r < 16; ++r) p1[r] = __builtin_amdgcn_exp2f(p1[r]);
  float ps = 0;
#pragma unroll
  for (int r = 0; r < 16; ++r) ps += p0[r];
#pragma unroll
  for (int r = 0; r < 16; ++r) ps += p1[r];
  { auto rr = __builtin_amdgcn_permlane32_swap(__float_as_uint(ps), __float_as_uint(ps), false, false);
    ps = __uint_as_float(rr[0]) + __uint_as_float(rr[1]); }
  l_reg = l_reg * alpha + ps;
#define PK4(P, BASE, OUT) do { unsigned a0 = cvtpk(P[BASE + 0], P[BASE + 1]), a1 = cvtpk(P[BASE + 2], P[BASE + 3]);   \
    unsigned b0 = cvtpk(P[BASE + 4], P[BASE + 5]), b1 = cvtpk(P[BASE + 6], P[BASE + 7]);                              \
    auto r0 = __builtin_amdgcn_permlane32_swap(a0, b0, false, false); auto r1 = __builtin_amdgcn_permlane32_swap(a1, b1, false, false); \
    u32x4 w = {r0[0], r1[0], r0[1], r1[1]}; OUT = *reinterpret_cast<bf16x8*>(&w); } while (0)
  PK4(p0, 0, pa0); PK4(p0, 8, pa1); PK4(p1, 0, pa2); PK4(p1, 8, pa3);
#undef PK4
}
__device__ __forceinline__ void qkt(f32x16& p0, f32x16& p1, const bf16_t* Ks, const bf16x8* qr, int r32, int hi) {
  p0 = f32x16{}; p1 = f32x16{};
#pragma unroll
  for (int d0 = 0; d0 < 8; ++d0) { int cb = (d0 * 16 + hi * 8) * 2;
    bf16x8 b0 = *reinterpret_cast<const bf16x8*>((const char*)Ks + KSWZ(r32, cb));
    bf16x8 b1 = *reinterpret_cast<const bf16x8*>((const char*)Ks + KSWZ(32 + r32, cb));
    p0 = __builtin_amdgcn_mfma_f32_32x32x16_bf16(b0, qr[d0], p0, 0, 0, 0);
    p1 = __builtin_amdgcn_mfma_f32_32x32x16_bf16(b1, qr[d0], p1, 0, 0, 0); }
}
__device__ __forceinline__ int v_st(int k, int c) { const int kk = (k & ~0xC) | ((k & 4) << 1) | ((k & 8) >> 1); return ((kk >> 3) * 4 + (c >> 5)) * 512 + ((kk & 7) * 32 + (c & 31)) * 2; }
__device__ __forceinline__ int v_rd_base(int lane) { return ((lane & 3) << 3) | (((lane >> 2) & 3) << 6) | (((lane >> 4) & 1) << 5) | (((lane >> 5) & 1) << 8); }
constexpr int v_rd_off(int d0, int ks, int half) { return d0 * 512 + ks * 4096 + half * 2048; }
template <int OFF> __device__ __forceinline__ s16x4 tr_read(int vb) {
  s16x4 r; asm volatile("ds_read_b64_tr_b16 %0, %1 offset:%2" : "=&v"(r) : "v"(vb), "i"(OFF) : "memory"); return r;
}
template <int D0> __device__ __forceinline__ void pv_one(f32x16& od, int vb, bf16x8 pa0, bf16x8 pa1, bf16x8 pa2, bf16x8 pa3) {
  const s16x4 l0 = tr_read<v_rd_off(D0, 0, 0)>(vb), h0 = tr_read<v_rd_off(D0, 0, 1)>(vb), l1 = tr_read<v_rd_off(D0, 1, 0)>(vb), h1 = tr_read<v_rd_off(D0, 1, 1)>(vb);
  const s16x4 l2 = tr_read<v_rd_off(D0, 2, 0)>(vb), h2 = tr_read<v_rd_off(D0, 2, 1)>(vb), l3 = tr_read<v_rd_off(D0, 3, 0)>(vb), h3 = tr_read<v_rd_off(D0, 3, 1)>(vb);
  asm volatile("s_waitcnt lgkmcnt(0)" ::: "memory"); SBAR();
#define PK(L, H) (bf16x8){L[0], L[1], L[2], L[3], H[0], H[1], H[2], H[3]}
  od = __builtin_amdgcn_mfma_f32_32x32x16_bf16(pa0, PK(l0, h0), od, 0, 0, 0);
  od = __builtin_amdgcn_mfma_f32_32x32x16_bf16(pa1, PK(l1, h1), od, 0, 0, 0);
  od = __builtin_amdgcn_mfma_f32_32x32x16_bf16(pa2, PK(l2, h2), od, 0, 0, 0);
  od = __builtin_amdgcn_mfma_f32_32x32x16_bf16(pa3, PK(l3, h3), od, 0, 0, 0);
#undef PK
}
__device__ __forceinline__ void pv_d0(f32x16* o, int vb, bf16x8 pa0, bf16x8 pa1, bf16x8 pa2, bf16x8 pa3) {
  pv_one<0>(o[0], vb, pa0, pa1, pa2, pa3); pv_one<1>(o[1], vb, pa0, pa1, pa2, pa3); pv_one<2>(o[2], vb, pa0, pa1, pa2, pa3); pv_one<3>(o[3], vb, pa0, pa1, pa2, pa3);
}

__device__ __forceinline__ int lane_id_asm() { int l; asm volatile("v_mbcnt_lo_u32_b32 %0, -1, 0\n\tv_mbcnt_hi_u32_b32 %0, -1, %0" : "=v"(l)); return l; }
template <bool O8> __device__ __forceinline__ void attn_unit(const bf16_t* __restrict__ Qb, const bf16_t* __restrict__ Kh, const bf16_t* __restrict__ Vh, void* __restrict__ Ob, char* lds, const int wid, const float* __restrict__ qg, const int t0) {
  const int lane = lane_id_asm(), tid = wid * 64 + lane, r32 = lane & 31, hi = lane >> 5;
  bf16_t* V_lds = (bf16_t*)lds; bf16_t* K_lds = (bf16_t*)(lds + 2 * SHM_V);
  float* ws = (float*)(lds + 2 * SHM_V + 2 * SHM_K) + wid * 64; float* li_l = ws; float* al_l = ws + 32;
  float m_reg = -1e30f, l_reg = 0; f32x16 o[4] = {}; bf16x8 qr[8];
  __syncthreads();
  { const unsigned qoff = (unsigned)((wid * QBLK + r32) * LDQ + hi * 8) * 2u;
#pragma unroll
    for (int d0 = 0; d0 < 8; ++d0) qr[d0] = *reinterpret_cast<const bf16x8*>((const char*)Qb + qoff + d0 * 32); }
  { float xf[8][8]; float ss = 0.f;
#pragma unroll
    for (int d0 = 0; d0 < 8; ++d0)
#pragma unroll
      for (int k = 0; k < 8; ++k) { xf[d0][k] = __uint_as_float((unsigned)(unsigned short)qr[d0][k] << 16); ss += xf[d0][k] * xf[d0][k]; }
    { auto rr = __builtin_amdgcn_permlane32_swap(__float_as_uint(ss), __float_as_uint(ss), false, false); ss = __uint_as_float(rr[0]) + __uint_as_float(rr[1]); }
    const float rs = __builtin_amdgcn_rsqf(ss * (1.0f / (float)D) + RMS_EPS);
#pragma unroll
    for (int d0 = 0; d0 < 8; ++d0) { const f32x4 g0 = *(const f32x4*)(qg + 16 * d0 + 8 * hi), g1 = *(const f32x4*)(qg + 16 * d0 + 8 * hi + 4);
#pragma unroll
      for (int k = 0; k < 4; ++k) { xf[d0][k] *= rs * g0[k]; xf[d0][4 + k] *= rs * g1[k]; } }
    const int t = t0 + wid * QBLK + r32; const float pos[2] = {(float)(t >> 6), (float)(t & 63)};
#pragma unroll
    for (int ax = 0; ax < 2; ++ax)
#pragma unroll
      for (int dd = 0; dd < 2; ++dd)
#pragma unroll
        for (int k = 0; k < 8; ++k) {
          const float inv_freq = __builtin_amdgcn_exp2f(-(float)(16 * dd + 8 * hi + k) * 0.41524101186092029f);
          const float rev = pos[ax] * inv_freq * 0.15915494309189535f, c = __builtin_amdgcn_cosf(rev), s = __builtin_amdgcn_sinf(rev);
          const float y1 = xf[4 * ax + dd][k], y2 = xf[4 * ax + dd + 2][k];
          xf[4 * ax + dd][k] = y1 * c - y2 * s; xf[4 * ax + dd + 2][k] = y2 * c + y1 * s; }
#pragma unroll
    for (int d0 = 0; d0 < 8; ++d0) { u32x4 w = {cvtpk(xf[d0][0], xf[d0][1]), cvtpk(xf[d0][2], xf[d0][3]), cvtpk(xf[d0][4], xf[d0][5]), cvtpk(xf[d0][6], xf[d0][7])}; qr[d0] = *reinterpret_cast<bf16x8*>(&w); }
  }
  const int sr = tid >> 4, sc = (tid & 15) * 8, vst0 = v_st(sr, sc), vst1 = v_st(32 + sr, sc);
  const int vb0 = (int)(uintptr_t)V_lds + v_rd_base(lane);
  struct { bf16x8 vs0, vs1, ks0, ks1; } sr_[2];
#define LD8(p) (*reinterpret_cast<const bf16x8*>(p))
  const unsigned goff0 = (unsigned)(sr * LDK + sc) * 2u, goff1 = goff0 + 32u * LDK * 2u;
#define SLOAD(i, k0) do { const char* vt_ = (const char*)Vh + (size_t)(k0) * (LDK * 2); const char* kt_ = (const char*)Kh + (size_t)(k0) * (LDK * 2); \
    sr_[i].vs0 = LD8(vt_ + goff0); sr_[i].vs1 = LD8(vt_ + goff1); sr_[i].ks0 = LD8(kt_ + goff0); sr_[i].ks1 = LD8(kt_ + goff1); } while (0)
#define SWRITE(b, i) do { *(bf16x8*)((char*)V_lds + (b) * SHM_V + vst0) = sr_[i].vs0;          \
    *(bf16x8*)((char*)V_lds + (b) * SHM_V + vst1) = sr_[i].vs1; int kc = sc * 2;               \
    *(bf16x8*)((char*)K_lds + (b) * SHM_K + KSWZ(sr, kc)) = sr_[i].ks0;                       \
    *(bf16x8*)((char*)K_lds + (b) * SHM_K + KSWZ(32 + sr, kc)) = sr_[i].ks1; } while (0)
#define SWAIT() asm volatile("s_waitcnt vmcnt(4)" ::: "memory")
#define RESC(a) do { if (__any((a) < 1.f)) { if (hi == 0) al_l[r32] = (a); asm volatile("s_waitcnt lgkmcnt(0)" ::: "memory"); \
    _Pragma("unroll") for (int d = 0; d < 4; ++d) _Pragma("unroll") for (int r = 0; r < 16; ++r) o[d][r] *= al_l[crow(r, hi)]; } } while (0)
  f32x16 pA0, pA1, pB0, pB1; float mnA, mnB, alA, alB; bf16x8 pa0, pa1, pa2, pa3;
  constexpr int SE = 0, SO = 1;
  SLOAD(SE, 0); asm volatile("s_waitcnt vmcnt(0)" ::: "memory"); SWRITE(0, SE); __syncthreads();
  qkt(pA0, pA1, K_lds, qr, r32, hi);
#pragma unroll
  for (int r = 8; r < 16; ++r) pA0[r] = -INFINITY;
#pragma unroll
  for (int r = 0; r < 16; ++r) pA1[r] = -INFINITY;
  partialSM(pA0, pA1, m_reg, mnA, alA);
  SLOAD(SO, KVBLK); SLOAD(SE, 2 * KVBLK);
  SWAIT(); SWRITE(1, SO); __syncthreads();
  for (int j = 1; j + 1 < NT; j += 2) {
    SBAR(); qkt(pB0, pB1, (bf16_t*)((char*)K_lds + SHM_K), qr, r32, hi);
    finishSM(pA0, pA1, alA, l_reg, pa0, pa1, pa2, pa3); SBAR();
    if (j + 2 < NT) SLOAD(SO, (j + 2) * KVBLK); SBAR();
    pv_d0(o, vb0, pa0, pa1, pa2, pa3); partialSM(pB0, pB1, m_reg, mnB, alB);
    __syncthreads(); SWAIT(); SWRITE(0, SE);
    RESC(alB); __syncthreads();
    SBAR(); qkt(pA0, pA1, K_lds, qr, r32, hi);
    finishSM(pB0, pB1, alB, l_reg, pa0, pa1, pa2, pa3); SBAR();
    if (j + 3 < NT) SLOAD(SE, (j + 3) * KVBLK); SBAR();
    pv_d0(o, vb0 + (int)SHM_V, pa0, pa1, pa2, pa3); partialSM(pA0, pA1, m_reg, mnA, alA);
    __syncthreads(); SWAIT(); if (j + 2 < NT) SWRITE(1, SO);
    RESC(alA); __syncthreads();
  }
  finishSM(pA0, pA1, alA, l_reg, pa0, pa1, pa2, pa3); SBAR();
  pv_d0(o, vb0, pa0, pa1, pa2, pa3);
  if (hi == 0) li_l[r32] = l_reg; asm volatile("s_waitcnt lgkmcnt(0)" ::: "memory");
  float rli[16];
#pragma unroll
  for (int r = 0; r < 16; ++r) rli[r] = __builtin_amdgcn_rcpf(li_l[crow(r, hi)]);
  { const int l2 = lane_id_asm(), c32 = l2 & 31, h2 = l2 >> 5;
    if constexpr (O8) { unsigned char* Ow = (unsigned char*)Ob + (size_t)(wid * QBLK) * LDO;
#pragma unroll
      for (int r = 0; r < 16; ++r) { const unsigned ooff = (unsigned)(crow(r, h2) * LDO + c32);
#pragma unroll
        for (int d0 = 0; d0 < 4; ++d0) { const float v = __builtin_amdgcn_fmed3f(o[d0][r] * rli[r] * pg8::FP8_O_SCALE, -448.f, 448.f); Ow[ooff + d0 * 32] = (unsigned char)(__builtin_amdgcn_cvt_pk_fp8_f32(v, 0.f, 0, false) & 0xff); } } }
    else { char* Ow = (char*)Ob + (size_t)(wid * QBLK) * (LDO * 2);
#pragma unroll
      for (int r = 0; r < 16; ++r) { const unsigned ooff = (unsigned)(crow(r, h2) * LDO + c32) * 2u;
#pragma unroll
        for (int d0 = 0; d0 < 4; ++d0) *(bf16_t*)(Ow + ooff + d0 * 64) = (bf16_t)(cvtpk(o[d0][r] * rli[r], 0.f) & 0xffffu); } } }
#undef LD8
#undef SLOAD
#undef SWRITE
#undef SWAIT
#undef RESC
}
#undef KSWZ
}


namespace att8 {
using att::f32x16; using att::f32x4; using att::u32x4; using att::crow; using att::lane_id_asm;
typedef int i32x8 __attribute__((ext_vector_type(8)));
typedef int i32x4 __attribute__((ext_vector_type(4)));
constexpr int D = 128, NW = 8, QBLK = 32, KVBLK = 64, NT = att::NT;
constexpr float FP8_K_SCALE = 0.5f, FP8_Q_SCALE = att::SCALE * 1.4426950408889634f * 2.0f;
constexpr float FP8_KQ_SCALE = FP8_K_SCALE;
constexpr float FP8_V_SCALE = 16.f, FP8_P_LOG2 = 4.f, THR_LOG2 = 4.f;
constexpr int LDQ = NHEAD * HD, LDK8 = NKV * HD, LDO = NHEAD * HD;
constexpr int SHM_K = KVBLK * D, SHM_V = KVBLK * D, NSLOT = 4, SHM_ATTN8 = NSLOT * SHM_K + NSLOT * SHM_V + NW * 64 * 4;
#define SBAR8() __builtin_amdgcn_sched_barrier(0)
#define MFMA8(acc, a, b) asm volatile("v_mfma_f32_32x32x64_f8f6f4 %0, %1, %2, %0" : "+v"(acc) : "v"(a), "v"(b))
#define MFMA8N(dst, a, b, c) asm volatile("v_mfma_f32_32x32x64_f8f6f4 %0, %1, %2, %3" : "=&v"(dst) : "v"(a), "v"(b), "v"(c))
__device__ __forceinline__ i32x8 cat(const i32x4 x, const i32x4 y) { return (i32x8){x[0], x[1], x[2], x[3], y[0], y[1], y[2], y[3]}; }
__device__ __forceinline__ int k8_pos(int e) { const int d0 = e >> 4, hi = (e >> 3) & 1, k = e & 7; return (d0 >> 2) * 64 + hi * 32 + (d0 & 3) * 8 + k; }
__device__ __forceinline__ int v8_key(int j) { const int h = j >> 5, i = j & 31; return i < 16 ? crow(i, h) : 32 + crow(i - 16, h); }
__device__ __forceinline__ unsigned pk4(float a, float b, float c, float d) { int w = 0; w = __builtin_amdgcn_cvt_pk_fp8_f32(a, b, w, false); w = __builtin_amdgcn_cvt_pk_fp8_f32(c, d, w, true); return (unsigned)w; }
__device__ __forceinline__ unsigned pk4u(float a, float b, float c, float d) { int w; asm volatile("" : "=v"(w)); w = __builtin_amdgcn_cvt_pk_fp8_f32(a, b, w, false); w = __builtin_amdgcn_cvt_pk_fp8_f32(c, d, w, true); return (unsigned)w; }
__device__ __forceinline__ float sat8(float v) { return __builtin_amdgcn_fmed3f(v, -448.f, 448.f); }
__device__ __forceinline__ float max3f(float a, float b, float c) { float r; asm("v_max3_f32 %0, %1, %2, %3" : "=v"(r) : "v"(a), "v"(b), "v"(c)); return r; }

__device__ __forceinline__ void qkt8(f32x16& p0, f32x16& p1, const char* Ks, const i32x8 (&qf)[2], int r32, int hi) {
  p0 = f32x16{}; p1 = f32x16{};
#pragma unroll
  for (int s = 0; s < 2; ++s) {
    const int c0 = s * 4 + hi * 2;
#pragma unroll
    for (int hp = 0; hp < 2; ++hp) { const int key = hp * 32 + r32, swz = (key >> 1) & 7; const char* kr = Ks + key * 128;
      const i32x4 a0 = *reinterpret_cast<const i32x4*>(kr + ((c0 ^ swz) << 4)), a1 = *reinterpret_cast<const i32x4*>(kr + (((c0 + 1) ^ swz) << 4));
      if (hp == 0) MFMA8(p0, cat(a0, a1), qf[s]); else MFMA8(p1, cat(a0, a1), qf[s]); }
  }
}
__device__ __forceinline__ void pv8(f32x16* o, const char* Vs, const i32x8 pf, int r32, int hi) {
#pragma unroll
  for (int d0 = 0; d0 < 4; ++d0) { const int d = d0 * 32 + r32, swz = (d >> 2) & 3; const char* vr = Vs + d * 64;
    const i32x4 b0 = *reinterpret_cast<const i32x4*>(vr + (((hi * 2) ^ swz) << 4)), b1 = *reinterpret_cast<const i32x4*>(vr + (((hi * 2 + 1) ^ swz) << 4));
    MFMA8(o[d0], pf, cat(b0, b1)); }
}
__device__ __forceinline__ i32x8 kfrag8(const char* Ks, int hp, int s, int r32, int hi) { const int key = hp * 32 + r32, swz = (key >> 1) & 7, c0 = s * 4 + hi * 2; const char* kr = Ks + key * 128;
  return cat(*reinterpret_cast<const i32x4*>(kr + ((c0 ^ swz) << 4)), *reinterpret_cast<const i32x4*>(kr + (((c0 + 1) ^ swz) << 4))); }
__device__ __forceinline__ i32x8 vfrag8(const char* Vs, int d0, int r32, int hi) { const int d = d0 * 32 + r32, swz = (d >> 2) & 3; const char* vr = Vs + d * 64;
  return cat(*reinterpret_cast<const i32x4*>(vr + (((hi * 2) ^ swz) << 4)), *reinterpret_cast<const i32x4*>(vr + (((hi * 2 + 1) ^ swz) << 4))); }
#define MAXCH8(m_, p_) do { float b_; asm("v_max3_f32 %0, %2, %3, %4\n\tv_max3_f32 %1, %5, %6, %7\n\tv_max3_f32 %0, %0, %8, %9\n\tv_max3_f32 %1, %1, %10, %11\n\tv_max3_f32 %0, %0, %12, %13\n\tv_max3_f32 %1, %1, %14, %15\n\tv_max3_f32 %0, %0, %16, %17\n\tv_max_f32 %0, %0, %1" \
    : "=&v"(m_), "=&v"(b_) : "v"(p_[0]), "v"(p_[1]), "v"(p_[2]), "v"(p_[3]), "v"(p_[4]), "v"(p_[5]), "v"(p_[6]), "v"(p_[7]), "v"(p_[8]), "v"(p_[9]), "v"(p_[10]), "v"(p_[11]), "v"(p_[12]), "v"(p_[13]), "v"(p_[14]), "v"(p_[15])); } while (0)
#define STEP8(pC0, pC1, pP0, pP1, alC, KS, VS, JT) do { \
    const char* Kb_ = K_lds + (KS) * SHM_K; const char* Vb_ = V_lds + (VS) * SHM_V; \
    DMAK8((JT) + 2, ((KS) + 2) & 3); DMAV8((JT) + 1, ((VS) + 2) & 3); \
    i32x8 ka_ = kfrag8(Kb_, 0, 0, r32, hi), kb_ = kfrag8(Kb_, 1, 0, r32, hi), kc_ = kfrag8(Kb_, 0, 1, r32, hi); SBAR8();     \
    MFMA8N(pC0, ka_, qf[0], negm); \
    i32x8 kd_ = kfrag8(Kb_, 1, 1, r32, hi); _Pragma("unroll") for (int r_ = 0; r_ < 8; ++r_) pP1[r_] = __builtin_amdgcn_exp2f(pP1[r_]); SBAR8(); \
    MFMA8N(pC1, kb_, qf[0], negm); \
    i32x8 va_ = vfrag8(Vb_, 0, r32, hi); _Pragma("unroll") for (int r_ = 8; r_ < 16; ++r_) pP1[r_] = __builtin_amdgcn_exp2f(pP1[r_]); SBAR8(); \
    MFMA8(pC0, kc_, qf[1]); \
    i32x8 vb_ = vfrag8(Vb_, 1, r32, hi); _Pragma("unroll") for (int q_ = 0; q_ < 4; ++q_) { \
        pf[q_] = (int)pk4u(pP0[4 * q_], pP0[4 * q_ + 1], pP0[4 * q_ + 2], pP0[4 * q_ + 3]); pf[4 + q_] = (int)pk4u(pP1[4 * q_], pP1[4 * q_ + 1], pP1[4 * q_ + 2], pP1[4 * q_ + 3]); } SBAR8(); \
    MFMA8(pC1, kd_, qf[1]); \
    i32x8 vc_ = vfrag8(Vb_, 2, r32, hi); SBAR8(); \
    MFMA8(o[0], pf, va_); \
    i32x8 vd_ = vfrag8(Vb_, 3, r32, hi); float m0_; MAXCH8(m0_, pC0); SBAR8(); \
    MFMA8(o[1], pf, vb_); \
    float m1_; MAXCH8(m1_, pC1); float pmax_; asm("v_max_f32 %0, %1, %2" : "=v"(pmax_) : "v"(m0_), "v"(m1_)); \
    { auto rr_ = __builtin_amdgcn_permlane32_swap(__float_as_uint(pmax_), __float_as_uint(pmax_), false, false); asm("v_max_f32 %0, %1, %2" : "=v"(pmax_) : "v"(rr_[0]), "v"(rr_[1])); } \
    alC = 1.f; \
    if (__builtin_expect(!__all(pmax_ <= FP8_P_LOG2 + THR_LOG2), 0)) {     \
        const float d_ = fmaxf(pmax_ - FP8_P_LOG2, 0.f); alC = __builtin_amdgcn_exp2f(-d_); m_reg += d_; \
        _Pragma("unroll") for (int r_ = 0; r_ < 16; ++r_) { pC0[r_] -= d_; pC1[r_] -= d_; negm[r_] = FP8_P_LOG2 - m_reg; } } SBAR8(); \
    MFMA8(o[2], pf, vc_); \
    _Pragma("unroll") for (int r_ = 0; r_ < 16; ++r_) pC0[r_] = __builtin_amdgcn_exp2f(pC0[r_]); SBAR8(); \
    MFMA8(o[3], pf, vd_); \
    MFMA8(osum, pf, ones8);        \
    \
  } while (0)

template <bool WAITMFMA> __device__ __forceinline__ void partialSM8(f32x16& p0, f32x16& p1, float& m_reg, float& alpha) {
  if (WAITMFMA) asm volatile("s_nop 15\n\ts_nop 7" : "+v"(p0), "+v"(p1));
  float pa = max3f(p0[0], p0[1], p1[0]), pb = max3f(p0[2], p0[3], p1[1]); pa = max3f(pa, p1[2], p1[3]);
#pragma unroll
  for (int r = 4; r < 16; r += 4) { pa = max3f(pa, p0[r], p0[r + 1]); pb = max3f(pb, p0[r + 2], p0[r + 3]); pa = max3f(pa, p1[r], p1[r + 1]); pb = max3f(pb, p1[r + 2], p1[r + 3]); }
  float pmax = fmaxf(pa, pb);
  { auto rr = __builtin_amdgcn_permlane32_swap(__float_as_uint(pmax), __float_as_uint(pmax), false, false);
    pmax = fmaxf(__uint_as_float(rr[0]), __uint_as_float(rr[1])); }
  float mn;
  if (__builtin_expect(__all(pmax - m_reg <= THR_LOG2), 1)) { mn = m_reg; alpha = 1.f; }
  else { mn = fmaxf(m_reg, pmax); alpha = __builtin_amdgcn_exp2f(m_reg - mn); m_reg = mn; }
  const float mnC = FP8_P_LOG2 - mn;
#pragma unroll
  for (int r = 0; r < 16; ++r) p0[r] = __builtin_amdgcn_exp2f(p0[r] + mnC);
#pragma unroll
  for (int r = 0; r < 16; ++r) p1[r] += mnC;
}
__device__ __forceinline__ void finishSM8(f32x16& p0, f32x16& p1, i32x8& pf) {
#pragma unroll
  for (int r = 0; r < 16; ++r) p1[r] = __builtin_amdgcn_exp2f(p1[r]);
#pragma unroll
  for (int q = 0; q < 4; ++q) { pf[q] = (int)pk4(p0[4 * q], p0[4 * q + 1], p0[4 * q + 2], p0[4 * q + 3]); pf[4 + q] = (int)pk4(p1[4 * q], p1[4 * q + 1], p1[4 * q + 2], p1[4 * q + 3]); }
}

__device__ __forceinline__ void attn_unit8(const unsigned short* __restrict__ Qb, const unsigned char* __restrict__ Kh8, const unsigned char* __restrict__ Vt, unsigned char* __restrict__ Ob,
                                           char* lds, __attribute__((address_space(3))) unsigned char* ldsl, const int wid, const float* __restrict__ qg, const int t0) {
  const int lane = lane_id_asm(), tid = wid * 64 + lane, r32 = lane & 31, hi = lane >> 5;
  char* K_lds = lds; char* V_lds = lds + NSLOT * SHM_K;
  float* ws = (float*)(lds + NSLOT * SHM_K + NSLOT * SHM_V) + wid * 64; float* al_l = ws + 32;
  float m_reg = -1e30f; f32x16 o[4] = {}; f32x16 osum = {}; i32x8 qf[2];
  const i32x8 ones8 = {0x38383838, 0x38383838, 0x38383838, 0x38383838, 0x38383838, 0x38383838, 0x38383838, 0x38383838};
  __syncthreads();
  { att::bf16x8 qr[8];
    const unsigned qoff = (unsigned)((wid * QBLK + r32) * LDQ + hi * 8) * 2u;
#pragma unroll
    for (int d0 = 0; d0 < 8; ++d0) qr[d0] = *reinterpret_cast<const att::bf16x8*>((const char*)Qb + qoff + d0 * 32);
    float xf[8][8]; float ss = 0.f;
#pragma unroll
    for (int d0 = 0; d0 < 8; ++d0)
#pragma unroll
      for (int k = 0; k < 8; ++k) { xf[d0][k] = __uint_as_float((unsigned)(unsigned short)qr[d0][k] << 16); ss += xf[d0][k] * xf[d0][k]; }
    { auto rr = __builtin_amdgcn_permlane32_swap(__float_as_uint(ss), __float_as_uint(ss), false, false); ss = __uint_as_float(rr[0]) + __uint_as_float(rr[1]); }
    const float rs = __builtin_amdgcn_rsqf(ss * (1.0f / (float)D) + RMS_EPS) * FP8_Q_SCALE;
#pragma unroll
    for (int d0 = 0; d0 < 8; ++d0) { const f32x4 g0 = *(const f32x4*)(qg + 16 * d0 + 8 * hi), g1 = *(const f32x4*)(qg + 16 * d0 + 8 * hi + 4);
#pragma unroll
      for (int k = 0; k < 4; ++k) { xf[d0][k] *= rs * g0[k]; xf[d0][4 + k] *= rs * g1[k]; } }
    const int t = t0 + wid * QBLK + r32; const float pos[2] = {(float)(t >> 6), (float)(t & 63)};
#pragma unroll
    for (int ax = 0; ax < 2; ++ax)
#pragma unroll
      for (int dd = 0; dd < 2; ++dd)
#pragma unroll
        for (int k = 0; k < 8; ++k) {
          const float inv_freq = __builtin_amdgcn_exp2f(-(float)(16 * dd + 8 * hi + k) * 0.41524101186092029f);
          const float rev = pos[ax] * inv_freq * 0.15915494309189535f, c = __builtin_amdgcn_cosf(rev), s = __builtin_amdgcn_sinf(rev);
          const float y1 = xf[4 * ax + dd][k], y2 = xf[4 * ax + dd + 2][k];
          xf[4 * ax + dd][k] = y1 * c - y2 * s; xf[4 * ax + dd + 2][k] = y2 * c + y1 * s; }
#pragma unroll
    for (int s = 0; s < 2; ++s)
#pragma unroll
      for (int j = 0; j < 4; ++j) { const int d0 = 4 * s + j;
        qf[s][2 * j] = (int)pk4(sat8(xf[d0][0]), sat8(xf[d0][1]), sat8(xf[d0][2]), sat8(xf[d0][3])); qf[s][2 * j + 1] = (int)pk4(sat8(xf[d0][4]), sat8(xf[d0][5]), sat8(xf[d0][6]), sat8(xf[d0][7])); }
  }
  const int skey = tid >> 3, sd = tid >> 2;
  const unsigned kg_off = (unsigned)(skey * LDK8 + (((tid & 7) ^ ((skey >> 1) & 7)) << 4)), vg_off = (unsigned)(sd * 64 + (((tid & 3) ^ ((sd >> 2) & 3)) << 4));
#define TCLAMP(t) ((t) < NT ? (t) : NT - 1)
#define DMAK8(kt, ks) do { if (wid < 4) { const unsigned char* kp_ = Kh8 + (size_t)TCLAMP(kt) * (KVBLK * LDK8) + kg_off; __attribute__((address_space(3))) unsigned char* kl_ = ldsl + (ks) * SHM_K + wid * 1024; \
    __builtin_amdgcn_global_load_lds((const unsigned*)kp_, (__attribute__((address_space(3))) unsigned*)kl_, 16, 0, 0); \
    __builtin_amdgcn_global_load_lds((const unsigned*)(kp_ + 32 * LDK8), (__attribute__((address_space(3))) unsigned*)(kl_ + 4096), 16, 0, 0); } } while (0)
#define DMAV8(vt, vs) do { if (wid < 4) { const unsigned char* vp_ = Vt + (size_t)TCLAMP(vt) * (KVBLK * D) + vg_off; __attribute__((address_space(3))) unsigned char* vl_ = ldsl + NSLOT * SHM_K + (vs) * SHM_V + wid * 1024; \
    __builtin_amdgcn_global_load_lds((const unsigned*)vp_, (__attribute__((address_space(3))) unsigned*)vl_, 16, 0, 0); \
    __builtin_amdgcn_global_load_lds((const unsigned*)(vp_ + 4096), (__attribute__((address_space(3))) unsigned*)(vl_ + 4096), 16, 0, 0); } } while (0)
#define STEP_END8() do { asm volatile("s_waitcnt vmcnt(4) lgkmcnt(0)" ::: "memory"); __builtin_amdgcn_s_barrier(); asm volatile("" ::: "memory"); } while (0)
#define RESC8(a) do { if (__any((a) < 1.f)) { if (hi == 0) al_l[r32] = (a); asm volatile("s_waitcnt lgkmcnt(0)" ::: "memory"); asm volatile("s_nop 15\n\ts_nop 7" : "+v"(o[0]), "+v"(o[1]), "+v"(o[2]), "+v"(o[3]), "+v"(osum)); \
    _Pragma("unroll") for (int r = 0; r < 16; ++r) { const float a_ = al_l[crow(r, hi)]; osum[r] *= a_; _Pragma("unroll") for (int d = 0; d < 4; ++d) o[d][r] *= a_; } } } while (0)
  f32x16 pA0, pA1, pB0, pB1, negm; float alA, alB; i32x8 pf;
  DMAK8(0, 0); DMAV8(0, 0); DMAK8(1, 1); DMAK8(2, 2); DMAV8(1, 1);
  STEP_END8();
  qkt8(pA0, pA1, K_lds, qf, r32, hi);
  asm volatile("s_nop 15\n\ts_nop 7" : "+v"(pA0), "+v"(pA1));
#pragma unroll
  for (int r = 8; r < 16; ++r) pA0[r] = -INFINITY;
#pragma unroll
  for (int r = 0; r < 16; ++r) pA1[r] = -INFINITY;
  partialSM8<false>(pA0, pA1, m_reg, alA);
#pragma unroll
  for (int r = 0; r < 16; ++r) negm[r] = FP8_P_LOG2 - m_reg;
  asm volatile("s_waitcnt lgkmcnt(0)" ::: "memory"); __builtin_amdgcn_s_barrier(); asm volatile("" ::: "memory");
  for (int j = 1; j < NT; j += 4) {
    STEP8(pB0, pB1, pA0, pA1, alB, 1, 0, j);     RESC8(alB); STEP_END8();
    STEP8(pA0, pA1, pB0, pB1, alA, 2, 1, j + 1); RESC8(alA); STEP_END8();
    STEP8(pB0, pB1, pA0, pA1, alB, 3, 2, j + 2); RESC8(alB); STEP_END8();
    STEP8(pA0, pA1, pB0, pB1, alA, 0, 3, j + 3); RESC8(alA); STEP_END8();
  }
  asm volatile("s_waitcnt vmcnt(0)" ::: "memory");
  finishSM8(pA0, pA1, pf); SBAR8();
  pv8(o, V_lds + ((NT - 1) & 3) * SHM_V, pf, r32, hi); MFMA8(osum, pf, ones8);
  asm volatile("s_nop 15\n\ts_nop 15\n\ts_nop 15\n\ts_nop 7" : "+v"(o[0]), "+v"(o[1]), "+v"(o[2]), "+v"(o[3]), "+v"(osum));
  float rli[16];
#pragma unroll
  for (int r = 0; r < 16; ++r) rli[r] = __builtin_amdgcn_rcpf(osum[r]) * (pg8::FP8_O_SCALE / FP8_V_SCALE);
  { const int l2 = lane_id_asm(), c32 = l2 & 31, h2 = l2 >> 5; unsigned char* Ow = Ob + (size_t)(wid * QBLK) * LDO;
#pragma unroll
    for (int r = 0; r < 16; ++r) { const unsigned ooff = (unsigned)(crow(r, h2) * LDO + c32);
#pragma unroll
      for (int d0 = 0; d0 < 4; ++d0) { const float v = sat8(o[d0][r] * rli[r]); Ow[ooff + d0 * 32] = (unsigned char)(__builtin_amdgcn_cvt_pk_fp8_f32(v, 0.f, 0, false) & 0xff); } } }
#undef DMAK8
#undef DMAV8
#undef MAXCH8
#undef STEP_END8
#undef TCLAMP
#undef STEP8
#undef RESC8
}
}

#define GAS __attribute__((address_space(1)))
#define LAS __attribute__((address_space(3)))
typedef unsigned short bf16;
typedef unsigned v4u __attribute__((ext_vector_type(4)));
typedef float f32x4 __attribute__((ext_vector_type(4)));
typedef short bf16x8 __attribute__((ext_vector_type(8)));
typedef GAS unsigned gu32;
typedef GAS unsigned long long gu64;
#define RLX_AGENT __ATOMIC_RELAXED, __HIP_MEMORY_SCOPE_AGENT
#define LDS_WAIT() asm volatile("s_waitcnt lgkmcnt(0)" ::: "memory")
#define VM_WAIT() asm volatile("s_waitcnt vmcnt(0)" ::: "memory")
__device__ __forceinline__ unsigned long long rt() { return __builtin_amdgcn_s_memrealtime(); }
__device__ __forceinline__ unsigned f2bf(float f) { unsigned u = __builtin_bit_cast(unsigned, f); return (u + 0x7fffu + ((u >> 16) & 1u)) >> 16; }
__device__ __forceinline__ unsigned pk2(float lo, float hi) { return f2bf(lo) | (f2bf(hi) << 16); }

#define XB_TMO      128
#define XB_XCNT(j)  (256  + 64 * (j))
#define XB_XSUB(j)  (1280 + 64 * (j))
#define XB_XGEN(j)  (2304 + 64 * (j))
#define XB_TOP      3328
#define XB_TOPGEN   3392
#define XCD_BAR_WORDS 3456
#define XB_SPIN_CAP (1u << 18)

__device__ __forceinline__ unsigned xb_ld(unsigned* p)              { return __hip_atomic_load(p, __ATOMIC_RELAXED, __HIP_MEMORY_SCOPE_AGENT); }
__device__ __forceinline__ unsigned xb_add(unsigned* p, unsigned v) { return __hip_atomic_fetch_add(p, v, __ATOMIC_RELAXED, __HIP_MEMORY_SCOPE_AGENT); }
__device__ __forceinline__ unsigned xb_xcc_id() { return (unsigned)__builtin_amdgcn_s_getreg((3 << 11) | 20) & 0xFu; }
#define XB_SPIN(cond, bar) do { unsigned _sp = 0; while (cond) { __builtin_amdgcn_s_sleep(1); \
    if ((++_sp & 255u) == 0u) { if (xb_ld(&(bar)[XB_TMO])) break; if (_sp > XB_SPIN_CAP) { atomicAdd(&(bar)[XB_TMO], 1u); break; } } } } while (0)

struct XcdBarrier {
    unsigned* bar; unsigned x;
    volatile LAS unsigned* st;
};

__device__ __forceinline__ XcdBarrier xcd_barrier_post(unsigned* bar, volatile LAS unsigned* st, const bool t0) {
    XcdBarrier b; b.bar = bar; b.x = xb_xcc_id(); b.st = st;
    if (t0) (void)xb_add(&bar[XB_XCNT(b.x)], 1u);
    return b;
}
__device__ __forceinline__ void xcd_barrier_complete(unsigned* bar, unsigned x, unsigned& nloc, unsigned& nx) {
    const unsigned G = gridDim.x * gridDim.y * gridDim.z;
    unsigned sum, cnt, mine, sp = 0u;
    for (;;) {
        sum = 0u; cnt = 0u; mine = 0u;
#pragma unroll
        for (unsigned j = 0; j < 16; ++j) { const unsigned c = xb_ld(&bar[XB_XCNT(j)]); sum += c; cnt += (c > 0u) ? 1u : 0u; mine = (j == x) ? c : mine; }
        if (sum == G) break;
        __builtin_amdgcn_s_sleep(1);
        if ((++sp & 255u) == 0u) { if (xb_ld(&bar[XB_TMO])) break; if (sp > XB_SPIN_CAP) { atomicAdd(&bar[XB_TMO], 1u); break; } }
    }
    nloc = mine > 0u ? mine : 1u; nx = cnt > 0u ? cnt : 1u;
}

__device__ __forceinline__ void xcd_barrier(const XcdBarrier& b, const bool t0) {
    asm volatile("s_waitcnt vmcnt(0)" ::: "memory");
    __syncthreads();
    if (t0) {
        unsigned* bar = b.bar;
        __builtin_amdgcn_s_waitcnt(0);
        unsigned nloc = b.st[0], nx = b.st[1];
        if (nloc == 0u) { xcd_barrier_complete(bar, b.x, nloc, nx); b.st[0] = nloc; b.st[1] = nx; }
        const unsigned old = xb_add(&bar[XB_XSUB(b.x)], 1u);
        const unsigned gen = old / nloc;
        if (old + 1u == (gen + 1u) * nloc) {
            __builtin_amdgcn_fence(__ATOMIC_RELEASE, "agent");
            asm volatile("s_waitcnt vmcnt(0)" ::: "memory");
            const unsigned og = xb_add(&bar[XB_TOP], 1u);
            const unsigned tg = og / nx;
            if (og + 1u == (tg + 1u) * nx) xb_add(&bar[XB_TOPGEN], 1u);
            else XB_SPIN(xb_ld(&bar[XB_TOPGEN]) == tg, bar);
            __builtin_amdgcn_fence(__ATOMIC_ACQUIRE, "agent");
            xb_add(&bar[XB_XGEN(b.x)], 1u);
            asm volatile("s_waitcnt vmcnt(0)" ::: "memory");
        } else {
            XB_SPIN(xb_ld(&bar[XB_XGEN(b.x)]) == gen, bar);
            __builtin_amdgcn_fence(__ATOMIC_ACQUIRE, "agent");
            asm volatile("s_waitcnt vmcnt(0)" ::: "memory");
        }
    }
    __syncthreads();
}

constexpr size_t MiB = 1u << 20;
constexpr size_t CTL_ZERO_BYTES = 2 * MiB;
constexpr int CW_BAR = 4096;
constexpr size_t RSS_OFF = 256 * 1024;
constexpr int NRSS = 7;
static_assert((CW_BAR + XCD_BAR_WORDS) * 4 <= (int)RSS_OFF && RSS_OFF + (size_t)NRSS * MPAD * 8 <= CTL_ZERO_BYTES, "control region");
constexpr size_t SZ_WGU = (size_t)2 * DFF * DM * 2, SZ_WD = (size_t)DM * DFF * 2, SZ_WCI = (size_t)3 * DM * DM * 2, SZ_WSQ = (size_t)DM * DM * 2, SZ_WQKV = (size_t)NQKV * DM * 2;
constexpr size_t WS_WGU = 2 * MiB;
constexpr size_t WS_WD = WS_WGU + 4 * SZ_WGU;
constexpr size_t WS_WCI = WS_WD + 4 * SZ_WD;
constexpr size_t WS_WCO = WS_WCI + SZ_WCI;
constexpr size_t WS_WQKV = WS_WCO + SZ_WSQ;
constexpr size_t WS_WO = WS_WQKV + SZ_WQKV;
constexpr size_t WS_H = WS_WO + SZ_WSQ;
constexpr size_t WS_HB = WS_H + (size_t)MPAD * DM * 4;
constexpr size_t WS_ACT = WS_HB + (size_t)MPAD * DM * 2;
constexpr size_t SZ_ACT = (size_t)MPAD * DFF * 2;
constexpr size_t WS_BB = WS_ACT, WS_UB = WS_ACT + (size_t)MPAD * DM * 2;
constexpr size_t WS_Q = WS_ACT, WS_K = WS_Q + (size_t)MREAL * DM * 2, WS_V = WS_K + (size_t)NB * KVROWS * NKV * HD * 2;
static_assert(WS_UB + (size_t)MPAD * DM * 2 <= WS_ACT + SZ_ACT && WS_V + (size_t)NB * KVROWS * NKV * HD * 2 <= WS_ACT + SZ_ACT, "overlays fit the FFN hidden buffer");
constexpr size_t WS_AUX = WS_ACT + SZ_ACT;
constexpr size_t SZ_WD8 = (size_t)DM * DFF;
constexpr size_t WS_WD8 = WS_AUX + (size_t)MPAD * DM * 2;
constexpr size_t WS_WQKV8 = WS_WD8 + 4 * SZ_WD8;
constexpr size_t WS_WO8 = WS_WQKV8 + (size_t)NQKV * DM;
constexpr size_t WS_HB8 = WS_WO8 + (size_t)DM * DM;
constexpr size_t WS_K8 = WS_HB8 + (size_t)MPAD * DM;
constexpr size_t WS_VT8 = WS_K8 + (size_t)NB * KVROWS * NKV * HD;
constexpr size_t WS_END = WS_VT8 + (size_t)NB * NKV * (KVROWS / 64) * 128 * 64;
static_assert(WS_WD8 % 256 == 0 && WS_WQKV8 % 256 == 0 && WS_WO8 % 256 == 0 && WS_HB8 % 256 == 0 && WS_K8 % 256 == 0 && WS_VT8 % 256 == 0, "alignment");
static_assert(WS_WGU % 256 == 0 && WS_WD % 256 == 0 && WS_H % 256 == 0 && WS_HB % 256 == 0 && WS_ACT % 256 == 0 && WS_K % 256 == 0 && WS_V % 256 == 0 && WS_AUX % 256 == 0, "alignment");

constexpr int NWAVES = 8;
constexpr int RING_BYTES = 131072;
constexpr int MISC_OFF = 139264 + 320;
constexpr int LDS_BYTES = 147456;

struct Frame {
    LAS unsigned char* lds;
    int tid, lane, wave, G, bid;
};
#define REFRAME(F) do { (F).lane = att::lane_id_asm(); (F).tid = (F).wave * 64 + (F).lane; } while (0)

__device__ __forceinline__ float wave_sum(float v) {
#pragma unroll
    for (int o = 1; o < 64; o <<= 1) v += __shfl_xor(v, o);
    return v;
}
__device__ __forceinline__ float bf2f(unsigned short b) { return __uint_as_float((unsigned)b << 16); }

#define CVT_LOAD32(t, wp, ldw, koff) do { _Pragma("unroll") for (int i_ = 0; i_ < 32; ++i_) (t)[i_] = __builtin_nontemporal_load((wp) + (size_t)((koff) + 2 * i_) * (ldw)); } while (0)
#define CVT_LDSW32(t, scr, koff, lane) do { _Pragma("unroll") for (int i_ = 0; i_ < 32; ++i_) (scr)[((koff) + 2 * i_ + ((lane) >> 5)) * 33 + ((lane) & 31)] = (t)[i_]; } while (0)
__device__ __forceinline__ void cvt_finish(const float (&t)[32], const float* g, bf16* WT, int K, int drow, int k0, LAS float* scr, int lane) {
    const int c = lane & 7;
    f32x4 g0 = {1.f, 1.f, 1.f, 1.f}, g1 = g0;
    if (g) { g0 = *(const f32x4*)(g + k0 + 8 * c); g1 = *(const f32x4*)(g + k0 + 8 * c + 4); }
    CVT_LDSW32(t, scr, 0, lane);
    LDS_WAIT(); asm volatile("" ::: "memory");
#pragma unroll
    for (int j = 0; j < 4; ++j) { const int n = (lane >> 3) + 8 * j; const LAS float* s = scr + (8 * c) * 33 + n;
        v4u o; o.x = pg8::cvt_pk_bf16(s[0 * 33] * g0[0], s[1 * 33] * g0[1]); o.y = pg8::cvt_pk_bf16(s[2 * 33] * g0[2], s[3 * 33] * g0[3]);
        o.z = pg8::cvt_pk_bf16(s[4 * 33] * g1[0], s[5 * 33] * g1[1]); o.w = pg8::cvt_pk_bf16(s[6 * 33] * g1[2], s[7 * 33] * g1[3]);
        __builtin_nontemporal_store(o, (GAS v4u*)(WT + (size_t)(drow + n) * K + k0 + 8 * c)); }
    LDS_WAIT(); asm volatile("" ::: "memory");
}
template <int MODE>
__device__ __forceinline__ const float* cvt_src(const float* W, const float* W2, int ldw, int nblk, int it, int lane, int& drow, int& k0) {
    const int kb = it / nblk, nb = it - kb * nblk; drow = nb * 32; k0 = kb * 64;
    const float* src = W; int scol = drow;
    if (MODE == 1) { src = ((drow >> 7) & 1) ? W2 : W; scol = (drow >> 8) * 128 + (drow & 127); }
    if (MODE == 2) { if (drow < 2 * DM) scol = (((drow >> 7) & 1) ? 2 * DM : DM) + (drow >> 8) * 128 + (drow & 127); else scol = drow - 2 * DM; }
    return src + (size_t)(k0 + (lane >> 5)) * ldw + scol + (lane & 31);
}
template <int MODE>
__device__ __forceinline__ void cvt_matrix(Frame& F, const float* W, const float* W2, int ldw, const float* g, bf16* WT, int K, int ndst) {
    LAS float* scr = (LAS float*)(F.lds + F.wave * 16896);
    const int gw = F.bid * NWAVES + F.wave, NGW = F.G * NWAVES, lane = F.lane;
    const int nblk = ndst / 32, nitems = nblk * (K / 64);
    float ta[32], tb[32]; int da, ka, db, kb;
    int it = gw;
    if (it < nitems) { const float* wp = cvt_src<MODE>(W, W2, ldw, nblk, it, lane, da, ka); CVT_LOAD32(ta, wp, ldw, 0); }
    while (it < nitems) {
        const int it1 = it + NGW;
        if (it1 < nitems) { const float* wp = cvt_src<MODE>(W, W2, ldw, nblk, it1, lane, db, kb); CVT_LOAD32(tb, wp, ldw, 0); }
        __builtin_amdgcn_sched_barrier(0);
        cvt_finish(ta, g, WT, K, da, ka, scr, lane);
        if (it1 >= nitems) break;
        it = it1 + NGW;
        if (it < nitems) { const float* wp = cvt_src<MODE>(W, W2, ldw, nblk, it, lane, da, ka); CVT_LOAD32(ta, wp, ldw, 0); }
        __builtin_amdgcn_sched_barrier(0);
        cvt_finish(tb, g, WT, K, db, kb, scr, lane);
    }
}
__device__ __forceinline__ void cvt_finish8(const float* g, float scale, unsigned char* WT, int K, int drow, int k0, LAS float* scr, int lane) {
    const int c = lane & 7;
    f32x4 gv[4];
#pragma unroll
    for (int q = 0; q < 4; ++q) gv[q] = g ? *(const f32x4*)(g + k0 + 16 * c + 4 * q) * scale : (f32x4){scale, scale, scale, scale};
    LDS_WAIT(); asm volatile("" ::: "memory");
#pragma unroll
    for (int j = 0; j < 4; ++j) { const int n = (lane >> 3) + 8 * j; const LAS float* s = scr + (16 * c) * 33 + n;
        v4u o;
#pragma unroll
        for (int q = 0; q < 4; ++q) o[q] = pg8::pack_fp8x4((f32x4){s[(4 * q + 0) * 33], s[(4 * q + 1) * 33], s[(4 * q + 2) * 33], s[(4 * q + 3) * 33]} * gv[q]);
        __builtin_nontemporal_store(o, (GAS v4u*)(WT + (size_t)(drow + n) * K + k0 + 16 * c)); }
    LDS_WAIT(); asm volatile("" ::: "memory");
}
__device__ __forceinline__ void cvt_matrix8(Frame& F, const float* W, int ldw, const float* g, float scale, unsigned char* WT, int K, int ndst) {
    LAS float* scr = (LAS float*)(F.lds + F.wave * 16896);
    const int gw = F.bid * NWAVES + F.wave, NGW = F.G * NWAVES, lane = F.lane;
    const int nblk = ndst / 32, nitems = nblk * (K / 128);
    float ta[32], tb[32];
    int it = gw;
    if (it < nitems) { const int kb = it / nblk, nb = it - kb * nblk; const float* wp = W + (size_t)(kb * 128 + (lane >> 5)) * ldw + nb * 32 + (lane & 31); CVT_LOAD32(ta, wp, ldw, 0); }
    for (; it < nitems; it += NGW) {
        const int kb = it / nblk, nb = it - kb * nblk; const float* wp = W + (size_t)(kb * 128 + (lane >> 5)) * ldw + nb * 32 + (lane & 31);
        CVT_LOAD32(tb, wp, ldw, 64);
        __builtin_amdgcn_sched_barrier(0);
        CVT_LDSW32(ta, scr, 0, lane);
        const int itn = it + NGW;
        if (itn < nitems) { const int kbn = itn / nblk, nbn = itn - kbn * nblk; const float* wpn = W + (size_t)(kbn * 128 + (lane >> 5)) * ldw + nbn * 32 + (lane & 31); CVT_LOAD32(ta, wpn, ldw, 0); }
        __builtin_amdgcn_sched_barrier(0);
        CVT_LDSW32(tb, scr, 64, lane);
        cvt_finish8(g, scale, WT, K, nb * 32, kb * 128, scr, lane);
    }
}

template <int MODE>
__device__ __forceinline__ void cvt_one(const float* W, const float* W2, int ldw, const float* g, bf16* WT, int K, int ndst, int it, LAS float* scr, int lane) {
    int drow, k0; const float* wp = cvt_src<MODE>(W, W2, ldw, ndst / 32, it, lane, drow, k0);
    float t[32]; CVT_LOAD32(t, wp, ldw, 0);
    cvt_finish(t, g, WT, K, drow, k0, scr, lane);
}
__device__ __forceinline__ void cvt_one8(const float* W, int ldw, const float* g, float scale, unsigned char* WT, int K, int ndst, int it, LAS float* scr, int lane) {
    const int nblk = ndst / 32, kb = it / nblk, nb = it - kb * nblk; const float* wp = W + (size_t)(kb * 128 + (lane >> 5)) * ldw + nb * 32 + (lane & 31);
    float ta[32], tb[32]; CVT_LOAD32(ta, wp, ldw, 0); CVT_LOAD32(tb, wp, ldw, 64);
    CVT_LDSW32(ta, scr, 0, lane); CVT_LDSW32(tb, scr, 64, lane);
    cvt_finish8(g, scale, WT, K, nb * 32, kb * 128, scr, lane);
}
constexpr int BG_N0 = (2 * DFF / 32) * (DM / 64), BG_N1 = (DM / 32) * (DFF / 128), BG_N2 = (NQKV / 32) * (DM / 128), BG_N3 = (2 * NKV * HD / 32) * (DM / 64), BG_N4 = (DM / 32) * (DM / 128);
constexpr int BG_L0 = (DM / 32) * (DFF / 64), BG_L1 = BG_L0 + (3 * DM / 32) * (DM / 64), BG_L2 = BG_L1 + (DM / 32) * (DM / 64), BG_L3 = BG_L2 + BG_N0, BG_L4 = BG_L3 + BG_N1;
constexpr int BG_B1 = BG_L4 + BG_N0, BG_B2 = BG_B1 + BG_N1, BG_B3 = BG_B2 + BG_N2, BG_B4 = BG_B3 + BG_N3, BG_B5 = BG_B4 + BG_N4, BG_B6 = BG_B5 + BG_N0, BG_TOTAL = BG_B6 + BG_N1;
constexpr int BG_END_A = BG_B5;
constexpr size_t BG_CTL_OFF = 1536 * 1024;
constexpr int BG_CH = 2;
__device__ __forceinline__ void bg_item(Frame& F, const float* const* in, unsigned char* ws, int it) {
    LAS float* scr = (LAS float*)(F.lds + F.wave * 16896);
    const size_t LW = (size_t)DM * DFF;
    if (it < BG_L0) cvt_one<0>(in[5], nullptr, DM, nullptr, (bf16*)(ws + WS_WD), DFF, DM, it, scr, F.lane);
    else if (it < BG_L1) cvt_one<2>(in[11], nullptr, 3 * DM, in[10], (bf16*)(ws + WS_WCI), DM, 3 * DM, it - BG_L0, scr, F.lane);
    else if (it < BG_L2) cvt_one<0>(in[14], nullptr, DM, nullptr, (bf16*)(ws + WS_WCO), DM, DM, it - BG_L1, scr, F.lane);
    else if (it < BG_L3) cvt_one<1>(in[7], in[8], DFF, in[6], (bf16*)(ws + WS_WGU) + 1 * (size_t)2 * DFF * DM, DM, 2 * DFF, it - BG_L2, scr, F.lane);
    else if (it < BG_L4) cvt_one8(in[9], DM, nullptr, pg8::FP8_W_SCALE, ws + WS_WD8 + 1 * SZ_WD8, DFF, DM, it - BG_L3, scr, F.lane);
    else if (it < BG_B1) cvt_one<1>(in[3] + LW, in[4] + LW, DFF, in[2] + DM, (bf16*)(ws + WS_WGU) + 2 * (size_t)2 * DFF * DM, DM, 2 * DFF, it - BG_L4, scr, F.lane);
    else if (it < BG_B2) cvt_one8(in[5] + LW, DM, nullptr, pg8::FP8_W_SCALE, ws + WS_WD8 + 2 * SZ_WD8, DFF, DM, it - BG_B1, scr, F.lane);
    else if (it < BG_B3) cvt_one8(in[16], NQKV, in[15], pg8::FP8_W_SCALE, ws + WS_WQKV8, DM, NQKV, it - BG_B2, scr, F.lane);
    else if (it < BG_B4) cvt_one<0>(in[16] + NHEAD * HD, nullptr, NQKV, in[15], (bf16*)(ws + WS_WQKV) + (size_t)NHEAD * HD * DM, DM, 2 * NKV * HD, it - BG_B3, scr, F.lane);
    else if (it < BG_B5) cvt_one8(in[19], DM, nullptr, pg8::FP8_W_SCALE, ws + WS_WO8, DM, DM, it - BG_B4, scr, F.lane);
    else if (it < BG_B6) cvt_one<1>(in[7] + LW, in[8] + LW, DFF, in[6] + DM, (bf16*)(ws + WS_WGU) + 3 * (size_t)2 * DFF * DM, DM, 2 * DFF, it - BG_B5, scr, F.lane);
    else cvt_one8(in[9] + LW, DM, nullptr, pg8::FP8_W_SCALE, ws + WS_WD8 + 3 * SZ_WD8, DFF, DM, it - BG_B6, scr, F.lane);
}
__device__ __forceinline__ void bg_drain(Frame& F, const float* const* in, unsigned char* ws, volatile LAS unsigned* MISC, int k, int need) {
    unsigned* ctl = (unsigned*)(ws + BG_CTL_OFF);
    __syncthreads();
    if (F.tid == 0) (void)__hip_atomic_fetch_add(ctl + 64 * (k + 1), 1u, __ATOMIC_RELAXED, __HIP_MEMORY_SCOPE_AGENT);
    for (;;) {
        if (F.tid == 0) {
            const int c = (int)__hip_atomic_load(ctl, __ATOMIC_RELAXED, __HIP_MEMORY_SCOPE_AGENT);
            const int d = (int)__hip_atomic_load(ctl + 64 * (k + 1), __ATOMIC_RELAXED, __HIP_MEMORY_SCOPE_AGENT);
            const bool go = c < BG_TOTAL && (c < need || d < F.G);
            MISC[20] = go ? 1u : 0u;
            if (go) MISC[21] = __hip_atomic_fetch_add(ctl, (unsigned)(NWAVES * BG_CH), __ATOMIC_RELAXED, __HIP_MEMORY_SCOPE_AGENT);
        }
        __syncthreads();
        const unsigned go = MISC[20]; const int base = (int)MISC[21];
        __syncthreads();
        if (!go) break;
#pragma unroll 1
        for (int i = 0; i < BG_CH; ++i) { const int it = base + F.wave * BG_CH + i; if (it < BG_TOTAL) bg_item(F, in, ws, it); }
    }
}

typedef float f32x16 __attribute__((ext_vector_type(16)));
template <int NT, class Epi>
__device__ __forceinline__ void skinny_phase(Frame& F, const bf16* A, const bf16* Bt, int K, int n_items, const Epi& E) {
    const int r32 = F.lane & 31, hi = F.lane >> 5, kc = K / 8, k0 = F.wave * kc;
    LAS float* P = (LAS float*)F.lds;
    for (int item = F.bid; item < n_items; item += F.G) {
        f32x16 acc[NT];
        const bf16* bp[NT];
        const bf16* ap = A + (size_t)r32 * K + k0 + hi * 16;
#pragma unroll
        for (int t = 0; t < NT; ++t) { acc[t] = f32x16{}; bp[t] = Bt + (size_t)(E.tile_row(item, t) + r32) * K + k0 + hi * 16; }
        constexpr int U = (NT == 1) ? 4 : 2;
        int kk = 0;
        for (; kk + 32 * U <= kc; kk += 32 * U) {
            bf16x8 a[2 * U], b[NT][2 * U];
#pragma unroll
            for (int u = 0; u < 2 * U; ++u) a[u] = *(const bf16x8*)(ap + kk + hi * (16 * U - 16) + 8 * u);
#pragma unroll
            for (int t = 0; t < NT; ++t)
#pragma unroll
                for (int u = 0; u < 2 * U; ++u) b[t][u] = *(const bf16x8*)(bp[t] + kk + hi * (16 * U - 16) + 8 * u);
            __builtin_amdgcn_sched_barrier(0);
#pragma unroll
            for (int t = 0; t < NT; ++t)
#pragma unroll
                for (int u = 0; u < 2 * U; ++u) acc[t] = __builtin_amdgcn_mfma_f32_32x32x16_bf16(a[u], b[t][u], acc[t], 0, 0, 0);
            __builtin_amdgcn_sched_barrier(0);
        }
        for (; kk < kc; kk += 32) {
            const bf16x8 a0 = *(const bf16x8*)(ap + kk), a1 = *(const bf16x8*)(ap + kk + 8);
#pragma unroll
            for (int t = 0; t < NT; ++t) {
                const bf16x8 b0 = *(const bf16x8*)(bp[t] + kk), b1 = *(const bf16x8*)(bp[t] + kk + 8);
                acc[t] = __builtin_amdgcn_mfma_f32_32x32x16_bf16(a0, b0, acc[t], 0, 0, 0);
                acc[t] = __builtin_amdgcn_mfma_f32_32x32x16_bf16(a1, b1, acc[t], 0, 0, 0);
            }
        }
#pragma unroll
        for (int t = 0; t < NT; ++t)
#pragma unroll
            for (int r = 0; r < 16; ++r) P[((F.wave * NT + t) * 32 + att::crow(r, hi)) * 32 + r32] = acc[t][r];
        __syncthreads();
#pragma unroll
        for (int h = 0; h < 2; ++h) {
            const int e = F.tid + h * 512; float v[NT];
#pragma unroll
            for (int t = 0; t < NT; ++t) { float s = 0.f;
#pragma unroll
                for (int w = 0; w < NWAVES; ++w) s += P[(w * NT + t) * 1024 + e];
                v[t] = s; }
            E.apply(item, e >> 5, e & 31, v);
        }
        __syncthreads();
    }
}
template <class Epi>
__device__ __forceinline__ void skinny_phase8(Frame& F, const unsigned char* A, const unsigned char* Bt, int K, int n_items, const Epi& E) {
    typedef int i32x8 __attribute__((ext_vector_type(8))); typedef int i32x4 __attribute__((ext_vector_type(4)));
    const int r32 = F.lane & 31, hi = F.lane >> 5, nst = K / 64, base = nst / 8, rem = nst - base * 8;
    const int st0 = F.wave * base + (F.wave < rem ? F.wave : rem), nmy = base + (F.wave < rem ? 1 : 0);
    LAS float* P = (LAS float*)F.lds;
    for (int item = F.bid; item < n_items; item += F.G) {
        f32x16 acc = f32x16{};
        const unsigned char* ap = A + (size_t)r32 * K + (size_t)st0 * 64 + hi * 32;
        const unsigned char* bp = Bt + (size_t)(E.tile_row(item, 0) + r32) * K + (size_t)st0 * 64 + hi * 32;
        int s = 0;
        for (; s + 4 <= nmy; s += 4) {
            i32x4 a[8], b[8];
#pragma unroll
            for (int u = 0; u < 4; ++u) { a[2 * u] = *(const i32x4*)(ap + (s + u) * 64); a[2 * u + 1] = *(const i32x4*)(ap + (s + u) * 64 + 16); b[2 * u] = *(const i32x4*)(bp + (s + u) * 64); b[2 * u + 1] = *(const i32x4*)(bp + (s + u) * 64 + 16); }
            __builtin_amdgcn_sched_barrier(0);
#pragma unroll
            for (int u = 0; u < 4; ++u) asm volatile("v_mfma_f32_32x32x64_f8f6f4 %0, %1, %2, %0" : "+v"(acc) : "v"((i32x8){a[2*u][0], a[2*u][1], a[2*u][2], a[2*u][3], a[2*u+1][0], a[2*u+1][1], a[2*u+1][2], a[2*u+1][3]}), "v"((i32x8){b[2*u][0], b[2*u][1], b[2*u][2], b[2*u][3], b[2*u+1][0], b[2*u+1][1], b[2*u+1][2], b[2*u+1][3]}));
            __builtin_amdgcn_sched_barrier(0);
        }
        for (; s < nmy; ++s) {
            const i32x4 a0 = *(const i32x4*)(ap + s * 64), a1 = *(const i32x4*)(ap + s * 64 + 16), b0 = *(const i32x4*)(bp + s * 64), b1 = *(const i32x4*)(bp + s * 64 + 16);
            asm volatile("v_mfma_f32_32x32x64_f8f6f4 %0, %1, %2, %0" : "+v"(acc) : "v"((i32x8){a0[0], a0[1], a0[2], a0[3], a1[0], a1[1], a1[2], a1[3]}), "v"((i32x8){b0[0], b0[1], b0[2], b0[3], b1[0], b1[1], b1[2], b1[3]}));
        }
        asm volatile("s_nop 15\n\ts_nop 15\n\ts_nop 7" : "+v"(acc));
#pragma unroll
        for (int r = 0; r < 16; ++r) P[(F.wave * 32 + att::crow(r, hi)) * 32 + r32] = acc[r];
        __syncthreads();
#pragma unroll
        for (int h = 0; h < 2; ++h) {
            const int e = F.tid + h * 512; float v[1]; float sm = 0.f;
#pragma unroll
            for (int w = 0; w < NWAVES; ++w) sm += P[w * 1024 + e];
            v[0] = sm;
            E.apply(item, e >> 5, e & 31, v);
        }
        __syncthreads();
    }
}
struct SkResid {
    const float* hin; float* h; bf16* hb; rss_t* rss_out; float scale;
    __device__ __forceinline__ int tile_row(int item, int) const { return item * 32; }
    __device__ __forceinline__ void apply(int item, int row, int col, const float (&v)[1]) const {
        const size_t o = (size_t)(MREAL + row) * DM + item * 32 + col;
        const float x = hin[o] + scale * v[0];
        h[o] = x; hb[o] = (bf16)f2bf(x);
        float ss = x * x;
#pragma unroll
        for (int d = 1; d < 32; d <<= 1) ss += __shfl_xor(ss, d);
        if (col == 0) rss_add(rss_out + MREAL + row, ss);
    }
};
struct SkConvIn {
    bf16* bbuf; bf16* ubuf; const rss_t* rss;
    __device__ __forceinline__ int tile_row(int item, int t) const { const int ch = item * 32; return t == 0 ? 2 * DM + ch : (ch >> 7) * 256 + (t == 2 ? 128 : 0) + (ch & 127); }
    __device__ __forceinline__ void apply(int item, int row, int col, const float (&v)[3]) const {
        const float rs = rstd_from_ss(rss[MREAL + row]); const size_t o = (size_t)(MREAL + row) * DM + item * 32 + col;
        bbuf[o] = (bf16)f2bf(v[0] * rs); ubuf[o] = (bf16)f2bf((v[1] * rs) * (v[2] * rs));
    }
};
struct SkKV {
    bf16* k; bf16* v; const rss_t* rss;
    __device__ __forceinline__ int tile_row(int item, int) const { return item * 32; }
    __device__ __forceinline__ void apply(int item, int row, int col, const float (&x)[1]) const {
        const float rs = rstd_from_ss(rss[MREAL + row]); const int kvr = (row >> 4) * KVROWS + (row & 15);
        bf16* dst = item < 32 ? k : v; const int c = (item & 31) * 32 + col;
        dst[(size_t)kvr * (NKV * HD) + c] = (bf16)f2bf(x[0] * rs);
    }
};

__device__ __forceinline__ void rows_init(Frame& F, const float* x, const float* meta, float* h, bf16* hb, rss_t* rss0) {
    const int gw = F.bid * NWAVES + F.wave, NGW = F.G * NWAVES;
    for (int r = gw; r < MVALID; r += NGW) {
        const float* src = r < MREAL ? x + (size_t)r * DM : meta + (size_t)((r - MREAL) & (NMETA - 1)) * DM;
        float ss = 0.f;
#pragma unroll
        for (int j = 0; j < 16; ++j) {
            const f32x4 v = *(const GAS f32x4*)(src + (size_t)(64 * j + F.lane) * 4);
            ss += (v.x * v.x + v.y * v.y) + (v.z * v.z + v.w * v.w);
            const unsigned long long pk = (unsigned long long)pg8::cvt_pk_bf16(v.x, v.y) | ((unsigned long long)pg8::cvt_pk_bf16(v.z, v.w) << 32);
            *(GAS unsigned long long*)(hb + (size_t)r * DM + (size_t)(64 * j + F.lane) * 4) = pk;
            if (r >= MREAL) *(GAS f32x4*)(h + (size_t)r * DM + (size_t)(64 * j + F.lane) * 4) = v;
        }
        ss = wave_sum(ss);
        if (F.lane == 0) rss0[r] = rss_fix(ss);
    }
}
__device__ __forceinline__ void seq_neighbours(int r, int& prev, int& next) {
    if (r < MREAL) { const int b = r >> 13, t = r & (SEQ - 1); prev = t > 0 ? r - 1 : MREAL + b * NMETA + (NMETA - 1); next = t < SEQ - 1 ? r + 1 : -1; }
    else { const int b = (r - MREAL) >> 4, j = (r - MREAL) & 15; prev = j > 0 ? r - 1 : -1; next = j < NMETA - 1 ? r + 1 : b * SEQ; }
}
__device__ __forceinline__ void conv_pass(Frame& F, const bf16* bbuf, const bf16* ubuf, const float* cw, const float* cb, bf16* cv) {
    const int gt = F.bid * (NWAVES * 64) + F.tid, NGT = F.G * NWAVES * 64;
    for (int it = gt; it < (MVALID / 8) * (DM / 8); it += NGT) {
        const int r0 = (it >> 9) * 8, c = (it & 511) * 8; int prev, next, dummy; seq_neighbours(r0, prev, dummy); seq_neighbours(r0 + 7, dummy, next);
        const bf16x8 zero = {0, 0, 0, 0, 0, 0, 0, 0};
        bf16x8 uu[10], bv[8];
        uu[0] = prev >= 0 ? *(const GAS bf16x8*)(ubuf + (size_t)prev * DM + c) : zero;
#pragma unroll
        for (int k = 0; k < 8; ++k) { uu[k + 1] = *(const GAS bf16x8*)(ubuf + (size_t)(r0 + k) * DM + c); bv[k] = *(const GAS bf16x8*)(bbuf + (size_t)(r0 + k) * DM + c); }
        uu[9] = next >= 0 ? *(const GAS bf16x8*)(ubuf + (size_t)next * DM + c) : zero;
        float w0[8], w1[8], w2[8], bb[8];
#pragma unroll
        for (int q = 0; q < 2; ++q) {
            const f32x4 a0 = *(const GAS f32x4*)(cw + c + 4 * q), a1 = *(const GAS f32x4*)(cw + DM + c + 4 * q), a2 = *(const GAS f32x4*)(cw + 2 * DM + c + 4 * q), a3 = *(const GAS f32x4*)(cb + c + 4 * q);
#pragma unroll
            for (int j = 0; j < 4; ++j) { w0[4 * q + j] = a0[j]; w1[4 * q + j] = a1[j]; w2[4 * q + j] = a2[j]; bb[4 * q + j] = a3[j]; }
        }
#pragma unroll
        for (int k = 0; k < 8; ++k) {
            float o[8];
#pragma unroll
            for (int e = 0; e < 8; ++e)
                o[e] = bf2f((unsigned short)bv[k][e]) * (w0[e] * bf2f((unsigned short)uu[k][e]) + w1[e] * bf2f((unsigned short)uu[k + 1][e]) + w2[e] * bf2f((unsigned short)uu[k + 2][e]) + bb[e]);
            v4u w; w.x = pg8::cvt_pk_bf16(o[0], o[1]); w.y = pg8::cvt_pk_bf16(o[2], o[3]); w.z = pg8::cvt_pk_bf16(o[4], o[5]); w.w = pg8::cvt_pk_bf16(o[6], o[7]);
            *(GAS v4u*)(cv + (size_t)(r0 + k) * DM + c) = w;
        }
    }
}
__device__ __forceinline__ void rope_head(bf16* p, const float* gain, float rowpos, float colpos, int i) {
    const float x0 = bf2f(p[i]), x1 = bf2f(p[32 + i]), x2 = bf2f(p[64 + i]), x3 = bf2f(p[96 + i]);
    float ss = (x0 * x0 + x1 * x1) + (x2 * x2 + x3 * x3);
#pragma unroll
    for (int d = 1; d < 32; d <<= 1) ss += __shfl_xor(ss, d);
    const float rs = __builtin_amdgcn_rsqf(ss * (1.0f / (float)HD) + RMS_EPS);
    const float y0 = x0 * rs * gain[i], y1 = x1 * rs * gain[32 + i], y2 = x2 * rs * gain[64 + i], y3 = x3 * rs * gain[96 + i];
    const float inv_freq = __builtin_amdgcn_exp2f(-(float)i * 0.41524101186092029f);
    const float ar = rowpos * inv_freq * 0.15915494309189535f, ac = colpos * inv_freq * 0.15915494309189535f;
    const float cr = __builtin_amdgcn_cosf(ar), sr = __builtin_amdgcn_sinf(ar), cc = __builtin_amdgcn_cosf(ac), sc = __builtin_amdgcn_sinf(ac);
    p[i] = (bf16)f2bf(y0 * cr - y1 * sr); p[32 + i] = (bf16)f2bf(y1 * cr + y0 * sr);
    p[64 + i] = (bf16)f2bf(y2 * cc - y3 * sc); p[96 + i] = (bf16)f2bf(y3 * cc + y2 * sc);
}
__device__ __forceinline__ void k_prep_pass(Frame& F, bf16* K, const float* kg) {
    const int ghw = (F.bid * NWAVES + F.wave) * 2 + (F.lane >> 5), NGHW = F.G * NWAVES * 2, i = F.lane & 31;
    constexpr int NK = NB * (NMETA + SEQ) * NKV;
    static_assert(NK % 2 == 0, "both half-waves of a wave leave the loop together");
    for (int j = ghw; j < NK; j += NGHW) {
        const int key = j >> 3, g = j & 7, b = key / (NMETA + SEQ), p = key - b * (NMETA + SEQ);
        const int kvr = b * KVROWS + (p < NMETA ? p : 64 + (p - NMETA));
        const float rowpos = p < NMETA ? -1.f : (float)((p - NMETA) >> 6), colpos = p < NMETA ? (float)p : (float)((p - NMETA) & 63);
        rope_head(K + (size_t)kvr * (NKV * HD) + g * HD, kg, rowpos, colpos, i);
    }
}
template <bool KEEP16>
__device__ __forceinline__ void kv_prep8_pass(Frame& F, bf16* K, const bf16* V, const float* kg, unsigned char* K8, unsigned char* VT8) {
    {   const int ghw = (F.bid * NWAVES + F.wave) * 2 + (F.lane >> 5), NGHW = F.G * NWAVES * 2, i = F.lane & 31;
        constexpr int NK = NB * (NMETA + SEQ) * NKV;
        for (int j = ghw; j < NK; j += NGHW) {
            const int key = j >> 3, g = j & 7, b = key / (NMETA + SEQ), p = key - b * (NMETA + SEQ);
            const int kvr = b * KVROWS + (p < NMETA ? p : 64 + (p - NMETA));
            const float rowpos = p < NMETA ? -1.f : (float)((p - NMETA) >> 6), colpos = p < NMETA ? (float)p : (float)((p - NMETA) & 63);
            bf16* kp = K + (size_t)kvr * (NKV * HD) + g * HD; unsigned char* k8 = K8 + (size_t)kvr * (NKV * HD) + g * HD;
            const float x0 = bf2f(kp[i]), x1 = bf2f(kp[32 + i]), x2 = bf2f(kp[64 + i]), x3 = bf2f(kp[96 + i]);
            float ss = (x0 * x0 + x1 * x1) + (x2 * x2 + x3 * x3);
#pragma unroll
            for (int d = 1; d < 32; d <<= 1) ss += __shfl_xor(ss, d);
            const float rs = __builtin_amdgcn_rsqf(ss * (1.0f / (float)HD) + RMS_EPS);
            const float y0 = x0 * rs * kg[i], y1 = x1 * rs * kg[32 + i], y2 = x2 * rs * kg[64 + i], y3 = x3 * rs * kg[96 + i];
            const float inv_freq = __builtin_amdgcn_exp2f(-(float)i * 0.41524101186092029f);
            const float ar = rowpos * inv_freq * 0.15915494309189535f, ac = colpos * inv_freq * 0.15915494309189535f;
            const float cr = __builtin_amdgcn_cosf(ar), sr = __builtin_amdgcn_sinf(ar), cc = __builtin_amdgcn_cosf(ac), sc = __builtin_amdgcn_sinf(ac);
            const float o0 = y0 * cr - y1 * sr, o1 = y1 * cr + y0 * sr, o2 = y2 * cc - y3 * sc, o3 = y3 * cc + y2 * sc;
            if (KEEP16) { kp[i] = (bf16)f2bf(o0); kp[32 + i] = (bf16)f2bf(o1); kp[64 + i] = (bf16)f2bf(o2); kp[96 + i] = (bf16)f2bf(o3); }
            const float s8 = att8::FP8_KQ_SCALE;
            k8[att8::k8_pos(i)] = (unsigned char)(att8::pk4(att8::sat8(o0 * s8), 0.f, 0.f, 0.f) & 0xff); k8[att8::k8_pos(32 + i)] = (unsigned char)(att8::pk4(att8::sat8(o1 * s8), 0.f, 0.f, 0.f) & 0xff);
            k8[att8::k8_pos(64 + i)] = (unsigned char)(att8::pk4(att8::sat8(o2 * s8), 0.f, 0.f, 0.f) & 0xff); k8[att8::k8_pos(96 + i)] = (unsigned char)(att8::pk4(att8::sat8(o3 * s8), 0.f, 0.f, 0.f) & 0xff);
        }
    }
    {   const int gw = F.bid * NWAVES + F.wave, NGW = F.G * NWAVES; constexpr int NTILE = KVROWS / 64, NITEM = NB * NKV * NTILE * 2;
        for (int it = gw; it < NITEM; it += NGW) {
            const int dh = it & 1, tile = (it >> 1) % NTILE, bk = (it >> 1) / NTILE, b = bk >> 3, g = bk & 7, d = dh * 64 + F.lane;
            const bf16* vp = V + (size_t)(b * KVROWS + tile * 64) * (NKV * HD) + g * HD + d;
            unsigned char* op = VT8 + ((size_t)(bk * NTILE + tile) * 128 + d) * 64;
#pragma unroll
            for (int q = 0; q < 4; ++q) { v4u w;
#pragma unroll
                for (int c = 0; c < 4; ++c) { float x[4];
#pragma unroll
                    for (int e = 0; e < 4; ++e) { const int key = att8::v8_key(16 * q + 4 * c + e); x[e] = (tile == 0 && key >= NMETA) ? 0.f : att8::sat8(bf2f(vp[(size_t)key * (NKV * HD)]) * att8::FP8_V_SCALE); }
                    w[c] = att8::pk4(x[0], x[1], x[2], x[3]); }
                *(GAS v4u*)(op + 16 * q) = w; }
        }
    }
}
__device__ __forceinline__ void final_norm_pass(Frame& F, const float* h, const rss_t* rss, const float* g, float* out) {
    const int gw = F.bid * NWAVES + F.wave, NGW = F.G * NWAVES;
    for (int r = gw; r < MREAL; r += NGW) {
        const float rs = rstd_from_ss(rss[r]);
#pragma unroll
        for (int j = 0; j < 16; ++j) { const size_t o = (size_t)(64 * j + F.lane) * 4;
            const f32x4 v = *(const GAS f32x4*)(h + (size_t)r * DM + o), gv = *(const GAS f32x4*)(g + o);
            *(GAS f32x4*)(out + (size_t)r * DM + o) = v * rs * gv; }
    }
}

#ifndef MK_ONE_LAUNCH
#define MK_ONE_LAUNCH 1
#endif
#ifndef FP8_DOWN_MASK
#define FP8_DOWN_MASK 0xE
#endif
#ifndef FP8_QKV
#define FP8_QKV 1
#endif
#ifndef FP8_ATTN
#define FP8_ATTN 1
#endif
#ifndef FP8_WO
#define FP8_WO 1
#endif
#ifndef BG_DEFER
#define BG_DEFER 1
#endif
constexpr int N_PHASES = 17;
struct Args { const float* in[21]; float* out; unsigned char* ws; int ph_lo, ph_hi; };
static_assert(sizeof(Args) == 192, "Args has no padding bytes");

__global__ void __launch_bounds__(NWAVES * 64, 2) fwd_kernel(Args args) {
    extern __shared__ __attribute__((aligned(16))) unsigned char lds_raw[];
    Frame F;
    F.lds = (LAS unsigned char*)lds_raw;
    F.tid = threadIdx.x; F.lane = F.tid & 63; F.wave = __builtin_amdgcn_readfirstlane(F.tid >> 6);
    F.G = gridDim.x; F.bid = blockIdx.x;
    volatile LAS unsigned* MISC = (volatile LAS unsigned*)(F.lds + MISC_OFF);
    unsigned char* ws = args.ws;
    gu32* ctl = (gu32*)ws;
    for (int u = F.tid; u < (LDS_BYTES - 139264) / 4; u += NWAVES * 64) ((LAS unsigned*)(F.lds + 139264))[u] = 0u;
    __syncthreads();
    XcdBarrier bar; bar.bar = (unsigned*)(ctl + CW_BAR); bar.x = 0; bar.st = nullptr;
    if (MK_ONE_LAUNCH) bar = xcd_barrier_post((unsigned*)(ctl + CW_BAR), MISC + 8, F.tid == 0);
    const int lo = args.ph_lo, hi = args.ph_hi;
#define REFRAME_(F) ((F).lane = att::lane_id_asm(), (F).tid = (F).wave * 64 + (F).lane)
#define IN(k) (lo <= (k) && (k) < hi && (REFRAME_(F), true))
#define SEAM(k) do { if (MK_ONE_LAUNCH && (lo <= (k) + 1 && (k) + 1 < hi)) xcd_barrier(bar, (REFRAME_(F), F.tid == 0)); } while (0)
#define PH_BEGIN(k) if (IN(k)) {
#define BG_NEED(k) ((k) >= 14 ? BG_TOTAL : (k) == 13 ? BG_B6 : (k) == 12 ? BG_B5 : ((k) == 11 || (k) == 10 || (k) == 9) ? BG_B4 : (k) == 8 ? BG_B2 : (k) == 7 ? BG_B1 : (k) == 6 ? BG_L4 : (k) == 5 ? BG_L3 : ((k) == 4 || (k) == 3) ? BG_L2 : (k) == 2 ? BG_L1 : (k) == 1 ? BG_L0 : 0)
#define BG_SITE(k) ((k) <= 10 || (k) == 12 || (k) == 13 || (k) == 14)
#define PH_END(k) if (BG_DEFER && MK_ONE_LAUNCH && BG_SITE(k)) { REFRAME_(F); bg_drain(F, args.in, ws, MISC, (k), BG_NEED(k)); } SEAM(k); }

    const float* x = args.in[0]; const float* meta = args.in[1];
    const float* conv_norm = args.in[10]; const float* conv_w_in = args.in[11]; const float* conv_w = args.in[12]; const float* conv_b = args.in[13]; const float* conv_w_out = args.in[14];
    const float* attn_norm = args.in[15]; const float* attn_w_qkv = args.in[16]; const float* q_gain = args.in[17]; const float* k_gain = args.in[18]; const float* attn_w_o = args.in[19];
    const float* final_g = args.in[20];
    bf16* WGU = (bf16*)(ws + WS_WGU); bf16* WD = (bf16*)(ws + WS_WD); bf16* WCI = (bf16*)(ws + WS_WCI); bf16* WCO = (bf16*)(ws + WS_WCO); bf16* WQKV = (bf16*)(ws + WS_WQKV); bf16* WO = (bf16*)(ws + WS_WO);
    float* H = (float*)(ws + WS_H); bf16* HB = (bf16*)(ws + WS_HB); bf16* ACT = (bf16*)(ws + WS_ACT); bf16* BB = (bf16*)(ws + WS_BB); bf16* UB = (bf16*)(ws + WS_UB);
    bf16* QB = (bf16*)(ws + WS_Q); bf16* KB = (bf16*)(ws + WS_K); bf16* VB = (bf16*)(ws + WS_V); bf16* AUX = (bf16*)(ws + WS_AUX);
    rss_t* RSS = (rss_t*)(ws + RSS_OFF);
#define RSSK(k) (RSS + (size_t)(k) * MPAD)
    constexpr size_t NWGU = (size_t)2 * DFF * DM, NWD = (size_t)DM * DFF;
#define D8(f) (((FP8_DOWN_MASK >> (f)) & 1) != 0)
    unsigned char* HB8 = ws + WS_HB8; unsigned char* K8 = ws + WS_K8; unsigned char* VT8 = ws + WS_VT8;

    PH_BEGIN(0)
        cvt_matrix<1>(F, args.in[3] + (size_t)0 * DM * DFF, args.in[4] + (size_t)0 * DM * DFF, DFF, args.in[2] + 0 * DM, WGU + 0 * NWGU, DM, 2 * DFF);
        if (D8(0)) cvt_matrix8(F, args.in[5] + (size_t)0 * DFF * DM, DM, nullptr, pg8::FP8_W_SCALE, ws + WS_WD8 + 0 * SZ_WD8, DFF, DM);
        if (!BG_DEFER && (!D8(0))) cvt_matrix<0>(F, args.in[5] + (size_t)0 * DFF * DM, nullptr, DM, nullptr, WD + 0 * NWD, DFF, DM);
        if (!BG_DEFER) { cvt_matrix<1>(F, args.in[7] + (size_t)0 * DM * DFF, args.in[8] + (size_t)0 * DM * DFF, DFF, args.in[6] + 0 * DM, WGU + 1 * NWGU, DM, 2 * DFF); }
        if (!BG_DEFER && (D8(1))) cvt_matrix8(F, args.in[9] + (size_t)0 * DFF * DM, DM, nullptr, pg8::FP8_W_SCALE, ws + WS_WD8 + 1 * SZ_WD8, DFF, DM);
        if (!D8(1)) cvt_matrix<0>(F, args.in[9] + (size_t)0 * DFF * DM, nullptr, DM, nullptr, WD + 1 * NWD, DFF, DM);
        if (!BG_DEFER) cvt_matrix<1>(F, args.in[3] + (size_t)1 * DM * DFF, args.in[4] + (size_t)1 * DM * DFF, DFF, args.in[2] + 1 * DM, WGU + 2 * NWGU, DM, 2 * DFF);
        if (D8(2) && !BG_DEFER) cvt_matrix8(F, args.in[5] + (size_t)1 * DFF * DM, DM, nullptr, pg8::FP8_W_SCALE, ws + WS_WD8 + 2 * SZ_WD8, DFF, DM);
        if (!D8(2)) cvt_matrix<0>(F, args.in[5] + (size_t)1 * DFF * DM, nullptr, DM, nullptr, WD + 2 * NWD, DFF, DM);
        if (!BG_DEFER) cvt_matrix<1>(F, args.in[7] + (size_t)1 * DM * DFF, args.in[8] + (size_t)1 * DM * DFF, DFF, args.in[6] + 1 * DM, WGU + 3 * NWGU, DM, 2 * DFF);
        if (D8(3) && !BG_DEFER) cvt_matrix8(F, args.in[9] + (size_t)1 * DFF * DM, DM, nullptr, pg8::FP8_W_SCALE, ws + WS_WD8 + 3 * SZ_WD8, DFF, DM);
        if (!D8(3)) cvt_matrix<0>(F, args.in[9] + (size_t)1 * DFF * DM, nullptr, DM, nullptr, WD + 3 * NWD, DFF, DM);
        if (!BG_DEFER) { cvt_matrix<2>(F, conv_w_in, nullptr, 3 * DM, conv_norm, WCI, DM, 3 * DM); }
        if (!BG_DEFER) { cvt_matrix<0>(F, conv_w_out, nullptr, DM, nullptr, WCO, DM, DM); }
        if (BG_DEFER) { static_assert(!BG_DEFER || (D8(1) && D8(2) && D8(3) && !D8(0) && FP8_QKV && FP8_WO), "the background queue is written for this configuration"); }
        else if (FP8_QKV) {
            cvt_matrix8(F, attn_w_qkv, NQKV, attn_norm, pg8::FP8_W_SCALE, ws + WS_WQKV8, DM, NQKV);
            cvt_matrix<0>(F, attn_w_qkv + NHEAD * HD, nullptr, NQKV, attn_norm, WQKV + (size_t)NHEAD * HD * DM, DM, 2 * NKV * HD);
        } else cvt_matrix<0>(F, attn_w_qkv, nullptr, NQKV, attn_norm, WQKV, DM, NQKV);
        if (!BG_DEFER) { if (FP8_WO) cvt_matrix8(F, attn_w_o, DM, nullptr, pg8::FP8_W_SCALE, ws + WS_WO8, DM, DM); else cvt_matrix<0>(F, attn_w_o, nullptr, DM, nullptr, WO, DM, DM); }
        rows_init(F, x, meta, H, HB, RSSK(0));
    PH_END(0)

#define FFN_UP(ph, f, rows, rin) PH_BEGIN(ph) \
        pg8::Gemm g{HB, WGU + (size_t)(f) * NWGU, (rows), 2 * DFF, DM}; pg8::StaticOrder S; S.init((rows), 2 * DFF, F.G, F.bid); \
        pg8::EpiSwiGLU<D8(f)> E{ACT, RSSK(rin)}; \
        pg8::gemm_phase<pg8::EpiSwiGLU<D8(f)>, pg8::StaticOrder, true, true>(F.lds, g, S, E, F.wave); \
        PH_END(ph)
#define FFN_DOWN(ph, f, basep, hbp, hb8p, rout, with_meta) PH_BEGIN(ph) \
        pg8::Gemm g{ACT, D8(f) ? (const bf16*)(ws + WS_WD8 + (f) * SZ_WD8) : WD + (size_t)(f) * NWD, MREAL, DM, DFF}; pg8::StaticOrder S; S.init(MREAL, DM, F.G, F.bid); \
        pg8::EpiResid E{(basep), H, (hbp), (hb8p), RSSK(rout), D8(f) ? 0.5f / (pg8::FP8_ACT_SCALE * pg8::FP8_W_SCALE) : 0.5f}; \
        pg8::gemm_phase<pg8::EpiResid, pg8::StaticOrder, true, true, D8(f)>(F.lds, g, S, E, F.wave); \
        if (with_meta) { SkResid SE{H, H, HB, RSSK(rout), D8(f) ? 0.5f / (pg8::FP8_ACT_SCALE * pg8::FP8_W_SCALE) : 0.5f}; \
            if (D8(f)) skinny_phase8<SkResid>(F, (const unsigned char*)ACT + (size_t)MREAL * DFF, ws + WS_WD8 + (f) * SZ_WD8, DFF, DM / 32, SE); \
            else skinny_phase<1, SkResid>(F, ACT + (size_t)MREAL * DFF, WD + (size_t)(f) * NWD, DFF, DM / 32, SE); } \
        PH_END(ph)

    FFN_UP(1, 0, MPAD, 0)
    FFN_DOWN(2, 0, x, HB, (unsigned char*)nullptr, 1, true)
    PH_BEGIN(3)
        pg8::Gemm g{HB, WCI, MREAL, 3 * DM, DM}; pg8::StaticOrder S; S.init(MREAL, 3 * DM, F.G, F.bid);
        pg8::EpiConvIn E{BB, UB, RSSK(1)};
        pg8::gemm_phase<pg8::EpiConvIn, pg8::StaticOrder, true, true>(F.lds, g, S, E, F.wave);
        SkConvIn SE{BB, UB, RSSK(1)}; skinny_phase<3, SkConvIn>(F, HB + (size_t)MREAL * DM, WCI, DM, DM / 32, SE);
    PH_END(3)
    PH_BEGIN(4) conv_pass(F, BB, UB, conv_w, conv_b, AUX); PH_END(4)
    PH_BEGIN(5)
        pg8::Gemm g{AUX, WCO, MREAL, DM, DM}; pg8::StaticOrder S; S.init(MREAL, DM, F.G, F.bid);
        pg8::EpiResid E{H, H, HB, (unsigned char*)nullptr, RSSK(2), 1.0f};
        pg8::gemm_phase<pg8::EpiResid, pg8::StaticOrder, true, true>(F.lds, g, S, E, F.wave);
        SkResid SE{H, H, HB, RSSK(2), 1.0f}; skinny_phase<1, SkResid>(F, AUX + (size_t)MREAL * DM, WCO, DM, DM / 32, SE);
    PH_END(5)
    FFN_UP(6, 1, MPAD, 2)
    FFN_DOWN(7, 1, H, HB, (unsigned char*)nullptr, 3, true)
    FFN_UP(8, 2, MPAD, 3)
    FFN_DOWN(9, 2, H, HB, FP8_QKV ? HB8 : (unsigned char*)nullptr, 4, true)
    PH_BEGIN(10)
        pg8::Gemm g{FP8_QKV ? (const bf16*)HB8 : HB, FP8_QKV ? (const bf16*)(ws + WS_WQKV8) : WQKV, MREAL, NQKV, DM}; pg8::StaticOrder S; S.init(MREAL, NQKV, F.G, F.bid);
        pg8::EpiQKV E{QB, KB, VB, RSSK(4), FP8_QKV ? 1.0f / (pg8::FP8_H_SCALE * pg8::FP8_W_SCALE) : 1.0f};
        pg8::gemm_phase<pg8::EpiQKV, pg8::StaticOrder, true, true, FP8_QKV != 0>(F.lds, g, S, E, F.wave);
        SkKV SE{KB, VB, RSSK(4)}; skinny_phase<1, SkKV>(F, HB + (size_t)MREAL * DM, WQKV + (size_t)NHEAD * HD * DM, DM, 2 * NKV * HD / 32, SE);
        for (int i = F.bid * (NWAVES * 64) + F.tid; i < NB * 48 * (NKV * HD / 8); i += F.G * NWAVES * 64) {
            const int b = i / (48 * 128), r = (i / 128) % 48, c = (i & 127) * 8; const size_t o = (size_t)(b * KVROWS + NMETA + r) * (NKV * HD) + c;
            *(GAS v4u*)(KB + o) = (v4u){0u, 0u, 0u, 0u}; *(GAS v4u*)(VB + o) = (v4u){0u, 0u, 0u, 0u};
        }
    PH_END(10)
    PH_BEGIN(11) if (FP8_ATTN) kv_prep8_pass<false>(F, KB, VB, k_gain, K8, VT8); else k_prep_pass(F, KB, k_gain); PH_END(11)
    PH_BEGIN(12)
        constexpr int NUNITS = NB * NHEAD * (SEQ / 256);
        const bool xcd_deal = (F.G == 256);
        for (int i = 0;; ++i) {
            int un;
            if (xcd_deal) { if (i >= 8) break; un = (F.bid & 7) * 256 + i * 32 + (F.bid >> 3); } else { un = i * F.G + F.bid; if (un >= NUNITS) break; }
            const int grp = un >> 7, rem = un & 127, b = grp >> 3, kvh = grp & 7, hq = kvh * 4 + (rem >> 5), qb = rem & 31;
            const size_t qoff = (size_t)(b * SEQ + qb * 256) * DM + hq * HD, koff = (size_t)(b * KVROWS) * (NKV * HD) + kvh * HD;
            if (FP8_ATTN) att8::attn_unit8(QB + qoff, K8 + koff, VT8 + (size_t)grp * (KVROWS / 64) * 8192, (unsigned char*)AUX + qoff, (char*)lds_raw, F.lds, F.wave, q_gain, qb * 256);
            else att::attn_unit<FP8_WO != 0>(QB + qoff, KB + koff, VB + koff, FP8_WO ? (void*)((unsigned char*)AUX + qoff) : (void*)(AUX + qoff), (char*)lds_raw, F.wave, q_gain, qb * 256);
        }
    PH_END(12)
    PH_BEGIN(13)
        pg8::Gemm g{AUX, FP8_WO ? (const bf16*)(ws + WS_WO8) : WO, MREAL, DM, DM}; pg8::StaticOrder S; S.init(MREAL, DM, F.G, F.bid);
        pg8::EpiResid E{H, H, HB, (unsigned char*)nullptr, RSSK(5), FP8_WO ? 1.0f / (pg8::FP8_O_SCALE * pg8::FP8_W_SCALE) : 1.0f};
        pg8::gemm_phase<pg8::EpiResid, pg8::StaticOrder, true, true, FP8_WO != 0>(F.lds, g, S, E, F.wave);
    PH_END(13)
    FFN_UP(14, 3, MREAL, 5)
    FFN_DOWN(15, 3, H, (bf16*)nullptr, (unsigned char*)nullptr, 6, false)
    PH_BEGIN(16) final_norm_pass(F, H, RSSK(6), final_g, args.out); PH_END(16)
#undef IN
#undef SEAM
}

extern "C" void kernel_launch(void* const* d_in, const int* in_sizes, int n_in, void* d_out, int out_size, void* d_ws, size_t ws_size, hipStream_t stream) {
    static int grid = 0;
    if (grid == 0) {
        if (n_in != 21 || in_sizes[0] != MREAL * DM || out_size != MREAL * DM || ws_size < WS_END) {
            fprintf(stderr, "kernel_launch: built for 21 inputs, x/out of %d floats, >= %zu bytes of workspace; got n_in %d, in0 %d, out %d, ws %zu; nothing launched\n", MREAL * DM, (size_t)WS_END, n_in, n_in > 0 ? in_sizes[0] : -1, out_size, ws_size);
            grid = -1; return; }
        int dev = 0, cus = 0, per_cu = 0;
        if (hipGetDevice(&dev) != hipSuccess || hipDeviceGetAttribute(&cus, hipDeviceAttributeMultiprocessorCount, dev) != hipSuccess) { fprintf(stderr, "kernel_launch: device query failed\n"); grid = -1; return; }
        if (hipFuncSetAttribute((const void*)fwd_kernel, hipFuncAttributeMaxDynamicSharedMemorySize, LDS_BYTES) != hipSuccess) { fprintf(stderr, "kernel_launch: hipFuncSetAttribute failed\n"); grid = -1; return; }
        if (hipOccupancyMaxActiveBlocksPerMultiprocessor(&per_cu, (const void*)fwd_kernel, NWAVES * 64, LDS_BYTES) != hipSuccess || per_cu < 1)
            fprintf(stderr, "kernel_launch: note: occupancy query reports %d workgroups per CU\n", per_cu);
        (void)hipGetLastError();
        grid = cus;
    }
    if (grid < 0) return;
    if (hipMemsetAsync(d_ws, 0, CTL_ZERO_BYTES, stream) != hipSuccess) { fprintf(stderr, "kernel_launch: hipMemsetAsync failed\n"); return; }
    Args a{};
    for (int i = 0; i < 21; ++i) a.in[i] = (const float*)d_in[i];
    a.out = (float*)d_out; a.ws = (unsigned char*)d_ws;
#if MK_ONE_LAUNCH
    a.ph_lo = 0; a.ph_hi = N_PHASES;
    hipLaunchKernelGGL(fwd_kernel, dim3(grid), dim3(NWAVES * 64), LDS_BYTES, stream, a);
#else
    for (int p = 0; p < N_PHASES; ++p) { a.ph_lo = p; a.ph_hi = p + 1; hipLaunchKernelGGL(fwd_kernel, dim3(grid), dim3(NWAVES * 64), LDS_BYTES, stream, a); }
#endif
    const hipError_t le = hipPeekAtLastError();
    if (le != hipSuccess) fprintf(stderr, "kernel_launch: launch failed: %s\n", hipGetErrorName(le));
}
```

```cpp
#include <hip/hip_runtime.h>
#include <hip/hip_bf16.h>
#include <cstdio>
#include <cstdint>

constexpr int DM = 4096, DFF = 11008, SEQ = 8192, NB = 2, NMETA = 16, NHEAD = 32, NKV = 8, HD = 128;
constexpr int MREAL = NB * SEQ;
constexpr int MVALID = MREAL + NB * NMETA;
constexpr int MPAD = 16640;
constexpr int KVROWS = 64 + SEQ;
constexpr int NQKV = (NHEAD + 2 * NKV) * HD;
constexpr float RMS_EPS = 1e-6f;

typedef unsigned long long rss_t;
constexpr float RSS_FX = 16777216.0f;
__device__ __forceinline__ rss_t rss_fix(float ss) { return (rss_t)(ss * RSS_FX + 0.5f); }
__device__ __forceinline__ void rss_add(rss_t* p, float ss) { (void)__hip_atomic_fetch_add(p, rss_fix(ss), __ATOMIC_RELAXED, __HIP_MEMORY_SCOPE_AGENT); }
__device__ __forceinline__ float rstd_from_ss(rss_t v) { return __builtin_amdgcn_rsqf((float)v * (1.0f / (RSS_FX * (float)DM)) + RMS_EPS); }
__device__ __forceinline__ float silu_f(float x) { return x * __builtin_amdgcn_rcpf(1.0f + __builtin_amdgcn_exp2f(-1.4426950408889634f * x)); }
__device__ __forceinline__ int kv_row_of_real(int row) { return (row >> 13) * KVROWS + 64 + (row & (SEQ - 1)); }

namespace pg8 {
#define PG8_LAS __attribute__((address_space(3)))
typedef unsigned short bf16_t;
typedef short bf16x8 __attribute__((ext_vector_type(8)));
typedef float f32x4 __attribute__((ext_vector_type(4)));
typedef unsigned u32x4 __attribute__((ext_vector_type(4)));
constexpr int BM = 256, BK = 64, HALF = 128, HTB = HALF * BK * 2  , STAGE_BYTES = 8 * HTB, NXCD = 8, WGM = 8;

__host__ __device__ __forceinline__ int lds_byte(int r, int c) { const int st = (r >> 4) * 2 + (c >> 5), rr = r & 15, cc = c & 31, ob = rr * 64 + cc * 2; return st * 1024 + (ob ^ (((ob >> 9) & 1) << 5)); }
__host__ __device__ __forceinline__ void stage_rc(int b, int& R, int& C) { const int st = b / 1024, sb = b % 1024, swz = sb ^ (((sb >> 9) & 1) << 5); R = (st >> 1) * 16 + swz / 64; C = (st & 1) * 32 + (swz % 64) / 2; }
__host__ __device__ __forceinline__ int perm32(int rho) { const int n = rho >> 4, i = rho & 15; return 8 * (i >> 2) + 4 * n + (i & 3); }

struct Unit { int pm, pn; };
struct Gemm { const bf16_t* A; const bf16_t* Bt; int M, N, K; };

struct StaticOrder {
    int nM, nN, nwg, G, c;
    __host__ __device__ void init(int M, int N, int G_, int c_) { nM = M / BM; nN = N / BM; nwg = nM * nN; G = G_; c = c_; }
    __host__ __device__ bool next(int i, Unit& u) const {
        const long L = (long)i * G + c; if (L >= nwg) return false;
        int wgid = (int)L; { const int q = nwg / NXCD, r = nwg % NXCD, xcd = wgid % NXCD, off = wgid / NXCD; wgid = (xcd < r ? xcd * (q + 1) : r * (q + 1) + (xcd - r) * q) + off; }
        const int nig = WGM * nN, gid = wgid / nig, fm = gid * WGM, gsz = (nM - fm) < WGM ? (nM - fm) : WGM;
        u.pm = fm + ((wgid % nig) % gsz); u.pn = (wgid % nig) / gsz; return true;
    }
    __device__ __forceinline__ void a_ready(const Unit&) const {}
    __device__ __forceinline__ void done(const Unit&) const {}
};

__device__ __forceinline__ unsigned cvt_pk_bf16(float lo, float hi) { unsigned r; asm volatile("v_cvt_pk_bf16_f32 %0, %1, %2" : "=v"(r) : "v"(lo), "v"(hi)); return r; }

__device__ __forceinline__ u32x4 pack8(const f32x4 a, const f32x4 b) { u32x4 w; w.x = cvt_pk_bf16(a[0], a[1]); w.y = cvt_pk_bf16(a[2], a[3]); w.z = cvt_pk_bf16(b[0], b[1]); w.w = cvt_pk_bf16(b[2], b[3]); return w; }

typedef int i32x8 __attribute__((ext_vector_type(8)));
__device__ __forceinline__ i32x8 cat8(const bf16x8 a, const bf16x8 b) { typedef int i32x4 __attribute__((ext_vector_type(4))); const i32x4 x = __builtin_bit_cast(i32x4, a), y = __builtin_bit_cast(i32x4, b); return (i32x8){x[0], x[1], x[2], x[3], y[0], y[1], y[2], y[3]}; }
__device__ __forceinline__ unsigned pack_fp8x4(const f32x4 v) {
    int w = 0;
    w = __builtin_amdgcn_cvt_pk_fp8_f32(__builtin_amdgcn_fmed3f(v[0], -448.f, 448.f), __builtin_amdgcn_fmed3f(v[1], -448.f, 448.f), w, false);
    w = __builtin_amdgcn_cvt_pk_fp8_f32(__builtin_amdgcn_fmed3f(v[2], -448.f, 448.f), __builtin_amdgcn_fmed3f(v[3], -448.f, 448.f), w, true);
    return (unsigned)w;
}
constexpr float FP8_ACT_SCALE = 4.f, FP8_W_SCALE = 64.f, FP8_H_SCALE = 8.f, FP8_O_SCALE = 16.f;

template <bool OUT8> struct EpiSwiGLU {
    static constexpr bool PERM = true, AFTER_DRAIN = false;
    bf16_t* act; const rss_t* rss;
    __device__ __forceinline__ void operator()(const f32x4 (&acc)[2][2][4][2], const Unit& u, int wr, int wc, int fr, int fq) const {
        const int row0 = u.pm * BM + wr * 64 + fr, col0 = u.pn * 128 + wc * 32 + 8 * fq;
        rss_t rv[2][4];
#pragma unroll
        for (int ai = 0; ai < 2; ++ai)
#pragma unroll
            for (int m = 0; m < 4; ++m) rv[ai][m] = rss[row0 + ai * HALF + m * 16];
#pragma unroll
        for (int ai = 0; ai < 2; ++ai)
#pragma unroll
            for (int m = 0; m < 4; ++m) {
                const int row = row0 + ai * HALF + m * 16;
                const float rs = rstd_from_ss(rv[ai][m]);
                f32x4 o[2];
#pragma unroll
                for (int n = 0; n < 2; ++n)
#pragma unroll
                    for (int j = 0; j < 4; ++j) o[n][j] = silu_f(acc[ai][0][m][n][j] * rs) * (acc[ai][1][m][n][j] * rs);
                if constexpr (OUT8) { typedef unsigned u32x2 __attribute__((ext_vector_type(2))); *(u32x2*)((unsigned char*)act + (size_t)row * DFF + col0) = (u32x2){pack_fp8x4(o[0] * FP8_ACT_SCALE), pack_fp8x4(o[1] * FP8_ACT_SCALE)}; }
                else *(u32x4*)(act + (size_t)row * DFF + col0) = pack8(o[0], o[1]);
            }
    }
};

struct EpiResid {
    static constexpr bool PERM = true, AFTER_DRAIN = false;
    const float* base; float* out; bf16_t* hb; unsigned char* hb8; rss_t* rss_out; float scale;
    __device__ __forceinline__ void operator()(const f32x4 (&acc)[2][2][4][2], const Unit& u, int wr, int wc, int fr, int fq) const {
        const int lane = fq * 16 + fr;
        const int row0 = u.pm * BM + wr * 64 + fr, colb = u.pn * BM + wc * 32 + 8 * fq;
#pragma unroll
        for (int ai = 0; ai < 2; ++ai) {
            float sel = 0.f;
            f32x4 bv[4][2][2];
#pragma unroll
            for (int m = 0; m < 4; ++m)
#pragma unroll
                for (int bj = 0; bj < 2; ++bj) { const size_t o = (size_t)(row0 + ai * HALF + m * 16) * DM + colb + bj * HALF;
                    bv[m][bj][0] = *(const f32x4*)(base + o); bv[m][bj][1] = *(const f32x4*)(base + o + 4); }
#pragma unroll
            for (int m = 0; m < 4; ++m) {
                const size_t ro = (size_t)(row0 + ai * HALF + m * 16) * DM + colb;
                float ss = 0.f;
#pragma unroll
                for (int bj = 0; bj < 2; ++bj) {
                    const size_t o = ro + bj * HALF;
                    const f32x4 v0 = bv[m][bj][0] + acc[ai][bj][m][0] * scale, v1 = bv[m][bj][1] + acc[ai][bj][m][1] * scale;
                    *(f32x4*)(out + o) = v0; *(f32x4*)(out + o + 4) = v1;
                    if (hb) *(u32x4*)(hb + o) = pack8(v0, v1);
                    if (hb8) { typedef unsigned u32x2 __attribute__((ext_vector_type(2))); *(u32x2*)(hb8 + o) = (u32x2){pack_fp8x4(v0 * FP8_H_SCALE), pack_fp8x4(v1 * FP8_H_SCALE)}; }
                    ss += (v0[0] * v0[0] + v0[1] * v0[1]) + (v0[2] * v0[2] + v0[3] * v0[3]) + (v1[0] * v1[0] + v1[1] * v1[1]) + (v1[2] * v1[2] + v1[3] * v1[3]);
                }
                ss += __shfl_xor(ss, 16); ss += __shfl_xor(ss, 32);
                sel = (fq == m) ? ss : sel;
            }
            rss_add(rss_out + u.pm * BM + ai * HALF + wr * 64 + lane, sel);
            asm volatile("" ::: "memory");
        }
    }
};

struct EpiConvIn {
    static constexpr bool PERM = true, AFTER_DRAIN = false;
    bf16_t* bbuf; bf16_t* ubuf; const rss_t* rss;
    __device__ __forceinline__ void operator()(const f32x4 (&acc)[2][2][4][2], const Unit& u, int wr, int wc, int fr, int fq) const {
        const int row0 = u.pm * BM + wr * 64 + fr;
        rss_t rv[2][4];
#pragma unroll
        for (int ai = 0; ai < 2; ++ai)
#pragma unroll
            for (int m = 0; m < 4; ++m) rv[ai][m] = rss[row0 + ai * HALF + m * 16];
        if (u.pn < 32) {
            const int col0 = u.pn * 128 + wc * 32 + 8 * fq;
#pragma unroll
            for (int ai = 0; ai < 2; ++ai)
#pragma unroll
                for (int m = 0; m < 4; ++m) {
                    const int row = row0 + ai * HALF + m * 16;
                    const float rs = rstd_from_ss(rv[ai][m]);
                    f32x4 o[2];
#pragma unroll
                    for (int n = 0; n < 2; ++n) o[n] = (acc[ai][0][m][n] * rs) * (acc[ai][1][m][n] * rs);
                    *(u32x4*)(ubuf + (size_t)row * DM + col0) = pack8(o[0], o[1]);
                }
        } else {
            const int colb = (u.pn - 32) * BM + wc * 32 + 8 * fq;
#pragma unroll
            for (int ai = 0; ai < 2; ++ai)
#pragma unroll
                for (int m = 0; m < 4; ++m) {
                    const int row = row0 + ai * HALF + m * 16;
                    const float rs = rstd_from_ss(rv[ai][m]);
#pragma unroll
                    for (int bj = 0; bj < 2; ++bj) *(u32x4*)(bbuf + (size_t)row * DM + colb + bj * HALF) = pack8(acc[ai][bj][m][0] * rs, acc[ai][bj][m][1] * rs);
                }
        }
    }
};

struct EpiQKV {
    static constexpr bool PERM = true, AFTER_DRAIN = false;
    bf16_t* q; bf16_t* k; bf16_t* v; const rss_t* rss; float cs;
    __device__ __forceinline__ void operator()(const f32x4 (&acc)[2][2][4][2], const Unit& u, int wr, int wc, int fr, int fq) const {
        const int row0 = u.pm * BM + wr * 64 + fr;
        bf16_t* dst; int ld, colb; const bool isq = u.pn < 16;
        if (isq) { dst = q; ld = DM; colb = u.pn * BM; } else if (u.pn < 20) { dst = k; ld = NKV * HD; colb = (u.pn - 16) * BM; } else { dst = v; ld = NKV * HD; colb = (u.pn - 20) * BM; }
        colb += wc * 32 + 8 * fq;
        rss_t rv[2][4];
#pragma unroll
        for (int ai = 0; ai < 2; ++ai)
#pragma unroll
            for (int m = 0; m < 4; ++m) rv[ai][m] = rss[row0 + ai * HALF + m * 16];
#pragma unroll
        for (int ai = 0; ai < 2; ++ai)
#pragma unroll
            for (int m = 0; m < 4; ++m) {
                const int row = row0 + ai * HALF + m * 16;
                const float rs = rstd_from_ss(rv[ai][m]) * cs;
                const int drow = isq ? row : kv_row_of_real(row);
#pragma unroll
                for (int bj = 0; bj < 2; ++bj) *(u32x4*)(dst + (size_t)drow * ld + colb + bj * HALF) = pack8(acc[ai][bj][m][0] * rs, acc[ai][bj][m][1] * rs);
            }
    }
};

template <class Epi, class Sched, bool ALIGN_EPI = false, bool SP2 = false, bool FP8 = false>
__device__ __forceinline__ void gemm_phase(PG8_LAS unsigned char* lds, const Gemm g, const Sched& S, const Epi& E, const int wid) {
    int lane; asm volatile("v_mbcnt_lo_u32_b32 %0, -1, 0\n\tv_mbcnt_hi_u32_b32 %0, -1, %0" : "=v"(lane));
    const int tid = wid * 64 + lane, wr = wid >> 2, wc = wid & 3, fr = lane & 15, fq = lane >> 4;
    const int KB = FP8 ? g.K : 2 * g.K, nt = KB / (BK * 2);
    unsigned voffA[2], voffB[2];
#pragma unroll
    for (int i = 0; i < 2; ++i) { int R, C; stage_rc(tid * 16 + i * 8192, R, C); const int Rb = Epi::PERM ? ((R & ~31) + perm32(R & 31)) : R;
        voffA[i] = (unsigned)(R * KB + C * 2); voffB[i] = (unsigned)(Rb * KB + C * 2); }
    const size_t kstep = (size_t)(BK * 2);
    const size_t hstep = (size_t)HALF * KB;
    const size_t tstep = 2 * hstep;
    const unsigned ldsw = (unsigned)wid * 1024u;
    const int aoff = lds_byte(wr * 64 + fr, fq * 8), boff = lds_byte(wc * 32 + fr, fq * 8);
#define PG8_SA(b, h) (((b) * 2 + (h)) * HTB)
#define PG8_SB(b, h) ((4 + (b) * 2 + (h)) * HTB)
#define PG8_STAGE(bufoff, gbase, voff) do { _Pragma("unroll") for (int _i = 0; _i < 2; ++_i) \
        __builtin_amdgcn_global_load_lds((const unsigned*)((const char*)(gbase) + (voff)[_i]), (PG8_LAS unsigned*)(lds + (bufoff) + ldsw + _i * 8192), 16, 0, 0); } while (0)
#define PG8_LDA(dst, b, h) do { _Pragma("unroll") for (int m = 0; m < 4; ++m) _Pragma("unroll") for (int k = 0; k < 2; ++k) dst[m][k] = *(const PG8_LAS bf16x8*)(lds + PG8_SA(b, h) + aoff + m * 2048 + k * 1024); } while (0)
#define PG8_LDB(dst, b, h) do { _Pragma("unroll") for (int n = 0; n < 2; ++n) _Pragma("unroll") for (int k = 0; k < 2; ++k) dst[n][k] = *(const PG8_LAS bf16x8*)(lds + PG8_SB(b, h) + boff + n * 2048 + k * 1024); } while (0)
#define PG8_MMA(ai, bj, At, Bt) do { __builtin_amdgcn_s_setprio(1); if constexpr (FP8) { _Pragma("unroll") for (int m = 0; m < 4; ++m) _Pragma("unroll") for (int n = 0; n < 2; ++n) \
        asm volatile("v_mfma_f32_16x16x128_f8f6f4 %0, %1, %2, %0" : "+v"(acc[ai][bj][m][n]) : "v"(cat8(Bt[n][0], Bt[n][1])), "v"(cat8(At[m][0], At[m][1]))); } \
        else { _Pragma("unroll") for (int m = 0; m < 4; ++m) _Pragma("unroll") for (int n = 0; n < 2; ++n) _Pragma("unroll") for (int k = 0; k < 2; ++k) \
        acc[ai][bj][m][n] = __builtin_amdgcn_mfma_f32_16x16x32_bf16(Bt[n][k], At[m][k], acc[ai][bj][m][n], 0, 0, 0); } __builtin_amdgcn_s_setprio(0); } while (0)
#define PG8_WAIT_V(n) asm volatile("s_waitcnt vmcnt(" #n ")" ::: "memory")
#define PG8_WAIT_L(n) asm volatile("s_waitcnt lgkmcnt(" #n ")" ::: "memory")
#define PG8_BAR __builtin_amdgcn_s_barrier()
#define PG8_SCHED __builtin_amdgcn_sched_barrier(0)
    Unit cur, nxt; int ui = 0;
    if (!S.next(0, cur)) return;
    f32x4 acc[2][2][4][2];
#pragma unroll
    for (int a = 0; a < 2; ++a)
#pragma unroll
        for (int b = 0; b < 2; ++b)
#pragma unroll
            for (int m = 0; m < 4; ++m)
#pragma unroll
                for (int n = 0; n < 2; ++n) acc[a][b][m][n] = (f32x4){0.f, 0.f, 0.f, 0.f};
    bf16x8 At[4][2], B0[2][2], B1[2][2];
    const char* cA = (const char*)g.A + (size_t)cur.pm * tstep; const char* cB = (const char*)g.Bt + (size_t)cur.pn * tstep;
    S.a_ready(cur);
    if constexpr (SP2) {
        PG8_STAGE(PG8_SB(0, 0), cB, voffB); PG8_STAGE(PG8_SB(0, 1), cB + hstep, voffB); PG8_STAGE(PG8_SA(0, 0), cA, voffA); PG8_STAGE(PG8_SA(0, 1), cA + hstep, voffA);
        if (wr == 1) PG8_BAR;
        PG8_WAIT_V(2); PG8_BAR;
        PG8_STAGE(PG8_SB(1, 0), cB + kstep, voffB); PG8_STAGE(PG8_SA(1, 0), cA + kstep, voffA); PG8_STAGE(PG8_SB(1, 1), cB + hstep + kstep, voffB);
        PG8_WAIT_V(6); PG8_BAR;
    } else {
        PG8_STAGE(PG8_SB(0, 0), cB, voffB); PG8_STAGE(PG8_SA(0, 0), cA, voffA); PG8_STAGE(PG8_SB(0, 1), cB + hstep, voffB); PG8_STAGE(PG8_SA(0, 1), cA + hstep, voffA);
        if (wr == 1) PG8_BAR;
        PG8_WAIT_V(4); PG8_BAR;
        PG8_STAGE(PG8_SB(1, 0), cB + kstep, voffB); PG8_STAGE(PG8_SA(1, 0), cA + kstep, voffA); PG8_STAGE(PG8_SB(1, 1), cB + hstep + kstep, voffB);
        PG8_WAIT_V(6); PG8_BAR;
    }
    for (;;) {
        const bool has_next = S.next(ui + 1, nxt);
        const char* nA = has_next ? (const char*)g.A + (size_t)nxt.pm * tstep : cA; const char* nB = has_next ? (const char*)g.Bt + (size_t)nxt.pn * tstep : cB;
        for (int t = 0; t < nt; t += 2) {
            const bool last = (t == nt - 2);
            const char* a1 = cA + (size_t)(t + 1) * kstep;
            const char* a2 = last ? nA : cA + (size_t)(t + 2) * kstep; const char* b2 = last ? nB : cB + (size_t)(t + 2) * kstep;
            const char* a3 = a2 + kstep; const char* b3 = b2 + kstep;
            if (last && has_next) S.a_ready(nxt);
            if constexpr (SP2) {
            PG8_LDB(B0, 0, 0); PG8_LDB(B1, 0, 1); PG8_SCHED; PG8_LDA(At, 0, 0); PG8_STAGE(PG8_SA(1, 1), a1 + hstep, voffA);
            PG8_WAIT_V(8); PG8_WAIT_L(0); PG8_BAR; PG8_MMA(0, 0, At, B0); PG8_MMA(0, 1, At, B1); PG8_BAR; PG8_SCHED;
            PG8_LDA(At, 0, 1); PG8_STAGE(PG8_SB(0, 0), b2, voffB); PG8_STAGE(PG8_SB(0, 1), b2 + hstep, voffB); PG8_STAGE(PG8_SA(0, 0), a2, voffA);
            PG8_WAIT_V(8); PG8_WAIT_L(0); PG8_BAR; PG8_MMA(1, 0, At, B0); PG8_MMA(1, 1, At, B1); PG8_BAR; PG8_SCHED;
            PG8_LDB(B0, 1, 0); PG8_LDB(B1, 1, 1); PG8_SCHED; PG8_LDA(At, 1, 0); PG8_STAGE(PG8_SA(0, 1), a2 + hstep, voffA);
            PG8_WAIT_V(8); PG8_WAIT_L(0); PG8_BAR; PG8_MMA(0, 0, At, B0); PG8_MMA(0, 1, At, B1); PG8_BAR; PG8_SCHED;
            PG8_LDA(At, 1, 1); PG8_STAGE(PG8_SB(1, 0), b3, voffB); PG8_STAGE(PG8_SB(1, 1), b3 + hstep, voffB); PG8_STAGE(PG8_SA(1, 0), a3, voffA);
            PG8_WAIT_V(8); PG8_WAIT_L(0); PG8_BAR; PG8_MMA(1, 0, At, B0); PG8_MMA(1, 1, At, B1); PG8_BAR; PG8_SCHED;
            } else {
            PG8_LDB(B0, 0, 0); PG8_SCHED; PG8_LDA(At, 0, 0); PG8_STAGE(PG8_SA(1, 1), a1 + hstep, voffA);
            PG8_WAIT_L(8); PG8_BAR; PG8_WAIT_L(0); PG8_MMA(0, 0, At, B0); PG8_BAR; PG8_SCHED;
            PG8_LDB(B1, 0, 1); PG8_STAGE(PG8_SB(0, 0), b2, voffB);
            PG8_BAR; PG8_WAIT_L(0); PG8_MMA(0, 1, At, B1); PG8_BAR;
            PG8_LDA(At, 0, 1); PG8_STAGE(PG8_SA(0, 0), a2, voffA);
            PG8_BAR; PG8_WAIT_L(0); PG8_MMA(1, 0, At, B0); PG8_BAR; PG8_SCHED;
            PG8_STAGE(PG8_SB(0, 1), b2 + hstep, voffB);
            PG8_WAIT_V(6); PG8_BAR; PG8_MMA(1, 1, At, B1); PG8_BAR;
            PG8_LDB(B0, 1, 0); PG8_SCHED; PG8_LDA(At, 1, 0); PG8_STAGE(PG8_SA(0, 1), a2 + hstep, voffA);
            PG8_WAIT_L(8); PG8_BAR; PG8_WAIT_L(0); PG8_MMA(0, 0, At, B0); PG8_BAR; PG8_SCHED;
            PG8_LDB(B1, 1, 1); PG8_STAGE(PG8_SB(1, 0), b3, voffB);
            PG8_BAR; PG8_WAIT_L(0); PG8_MMA(0, 1, At, B1); PG8_BAR;
            PG8_LDA(At, 1, 1); PG8_STAGE(PG8_SA(1, 0), a3, voffA);
            PG8_BAR; PG8_WAIT_L(0); PG8_MMA(1, 0, At, B0); PG8_BAR; PG8_SCHED;
            PG8_STAGE(PG8_SB(1, 1), b3 + hstep, voffB);
            PG8_WAIT_V(6); PG8_BAR; PG8_MMA(1, 1, At, B1); PG8_BAR;
            }
        }
        if constexpr (FP8) {
            asm volatile("s_nop 15\n\ts_nop 15" : "+v"(At[0][0]), "+v"(At[0][1]), "+v"(At[1][0]), "+v"(At[1][1]), "+v"(At[2][0]), "+v"(At[2][1]), "+v"(At[3][0]), "+v"(At[3][1]),
                         "+v"(B0[0][0]), "+v"(B0[0][1]), "+v"(B0[1][0]), "+v"(B0[1][1]), "+v"(B1[0][0]), "+v"(B1[0][1]), "+v"(B1[1][0]), "+v"(B1[1][1]) :: "memory");
        }
        if constexpr (ALIGN_EPI) { if (wr == 0) PG8_BAR; }
        if constexpr (FP8) {
            asm volatile("s_nop 15\n\ts_nop 15\n\ts_nop 7" : "+v"(acc[1][1][0][0]), "+v"(acc[1][1][0][1]), "+v"(acc[1][1][1][0]), "+v"(acc[1][1][1][1]), "+v"(acc[1][1][2][0]), "+v"(acc[1][1][2][1]), "+v"(acc[1][1][3][0]), "+v"(acc[1][1][3][1]) :: "memory");
            asm volatile("" : "+v"(acc[1][0][0][0]), "+v"(acc[1][0][0][1]), "+v"(acc[1][0][1][0]), "+v"(acc[1][0][1][1]), "+v"(acc[1][0][2][0]), "+v"(acc[1][0][2][1]), "+v"(acc[1][0][3][0]), "+v"(acc[1][0][3][1]));
        }
        if constexpr (!Epi::AFTER_DRAIN) { E(acc, cur, wr, wc, fr, fq); S.done(cur); }
        if (!has_next) break;
#pragma unroll
        for (int a = 0; a < 2; ++a)
#pragma unroll
            for (int b = 0; b < 2; ++b)
#pragma unroll
                for (int m = 0; m < 4; ++m)
#pragma unroll
                    for (int n = 0; n < 2; ++n) acc[a][b][m][n] = (f32x4){0.f, 0.f, 0.f, 0.f};
        cur = nxt; cA = nA; cB = nB; ++ui;
        if constexpr (ALIGN_EPI) { if (wr == 1) PG8_BAR; }
    }
    PG8_WAIT_V(0);
    if constexpr (!ALIGN_EPI) { if (wr == 0) PG8_BAR; }
    PG8_BAR;
    if constexpr (Epi::AFTER_DRAIN) { E.fused(acc, cur, wr, wc, fr, fq, lds, wid, lane); S.done(cur); }
#undef PG8_SA
#undef PG8_SB
#undef PG8_STAGE
#undef PG8_LDA
#undef PG8_LDB
#undef PG8_MMA
#undef PG8_WAIT_V
#undef PG8_WAIT_L
#undef PG8_BAR
#undef PG8_SCHED
}
}

namespace att {
typedef unsigned short bf16_t;
using bf16x8 = __attribute__((ext_vector_type(8))) short;
using s16x4  = __attribute__((ext_vector_type(4))) short;
using f32x16 = __attribute__((ext_vector_type(16))) float;
using u32x4  = __attribute__((ext_vector_type(4))) unsigned;
using f32x4  = __attribute__((ext_vector_type(4))) float;
constexpr int D = 128, NW = 8, QBLK = 32, KVBLK = 64;
constexpr float SCALE = 0.088388347648318440f;
constexpr float THR = 8.f;
constexpr int LDQ = NHEAD * HD, LDK = NKV * HD, LDO = NHEAD * HD;
constexpr int SHM_V = KVBLK * D * 2, SHM_K = KVBLK * D * 2, SHM_ATTN = 2 * SHM_V + 2 * SHM_K + NW * 64 * 4;
constexpr int NT = KVROWS / KVBLK;
static_assert(NT % 2 == 1 && NT >= 3, "the loop below is written for an odd tile count");
#define KSWZ(row, colB) ((row) * 256 + ((colB) ^ (((row) & 7) << 4)))
#define SBAR() __builtin_amdgcn_sched_barrier(0)
__device__ __forceinline__ int crow(int r, int hi) { return (r & 3) + 8 * (r >> 2) + 4 * hi; }
__device__ __forceinline__ unsigned cvtpk(float lo, float hi) { unsigned r; asm volatile("v_cvt_pk_bf16_f32 %0, %1, %2" : "=v"(r) : "v"(lo), "v"(hi)); return r; }

__device__ __forceinline__ void partialSM(f32x16& p0, f32x16& p1, float& m_reg, float& mn, float& alpha) {
  constexpr float C = SCALE * 1.4426950408889634f;
  float pmax = p0[0];
#pragma unroll
  for (int r = 1; r < 16; ++r) pmax = fmaxf(pmax, p0[r]);
#pragma unroll
  for (int r = 0; r < 16; ++r) pmax = fmaxf(pmax, p1[r]);
  { auto rr = __builtin_amdgcn_permlane32_swap(__float_as_uint(pmax), __float_as_uint(pmax), false, false);
    pmax = fmaxf(__uint_as_float(rr[0]), __uint_as_float(rr[1])); }
  if (__builtin_expect(__all(pmax - m_reg <= THR / SCALE), 1)) { mn = m_reg; alpha = 1.f; }
  else { mn = fmaxf(m_reg, pmax); alpha = __builtin_amdgcn_exp2f((m_reg - mn) * C); m_reg = mn; }
  float mnC = -mn * C;
#pragma unroll
  for (int r = 0; r < 16; ++r) p0[r] = fmaf(p0[r], C, mnC);
#pragma unroll
  for (int r = 0; r < 16; ++r) p1[r] = fmaf(p1[r], C, mnC);
#pragma unroll
  for (int r = 0; r < 16; ++r) p0[r] = __builtin_amdgcn_exp2f(p0[r]);
}
__device__ __forceinline__ void finishSM(f32x16& p0, f32x16& p1, float alpha, float& l_reg, bf16x8& pa0, bf16x8& pa1, bf16x8& pa2, bf16x8& pa3) {
#pragma unroll
  for (int r = 0; r < 16; ++r) p1[r] = __builtin_amdgcn_exp2f(p1[r]);
  float ps = 0;
#pragma unroll
  for (int r = 0; r < 16; ++r) ps += p0[r];
#pragma unroll
  for (int r = 0; r < 16; ++r) ps += p1[r];
  { auto rr = __builtin_amdgcn_permlane32_swap(__float_as_uint(ps), __float_as_uint(ps), false, false);
    ps = __uint_as_float(rr[0]) + __uint_as_float(rr[1]); }
  l_reg = l_reg * alpha + ps;
#define PK4(P, BASE, OUT) do { unsigned a0 = cvtpk(P[BASE + 0], P[BASE + 1]), a1 = cvtpk(P[BASE + 2], P[BASE + 3]);   \
    unsigned b0 = cvtpk(P[BASE + 4], P[BASE + 5]), b1 = cvtpk(P[BASE + 6], P[BASE + 7]);                              \
    auto r0 = __builtin_amdgcn_permlane32_swap(a0, b0, false, false); auto r1 = __builtin_amdgcn_permlane32_swap(a1, b1, false, false); \
    u32x4 w = {r0[0], r1[0], r0[1], r1[1]}; OUT = *reinterpret_cast<bf16x8*>(&w); } while (0)
  PK4(p0, 0, pa0); PK4(p0, 8, pa1); PK4(p1, 0, pa2); PK4(p1, 8, pa3);
#undef PK4
}
__device__ __forceinline__ void qkt(f32x16& p0, f32x16& p1, const bf16_t* Ks, const bf16x8* qr, int r32, int hi) {
  p0 = f32x16{}; p1 = f32x16{};
#pragma unroll
  for (int d0 = 0; d0 < 8; ++d0) { int cb = (d0 * 16 + hi * 8) * 2;
    bf16x8 b0 = *reinterpret_cast<const bf16x8*>((const char*)Ks + KSWZ(r32, cb));
    bf16x8 b1 = *reinterpret_cast<const bf16x8*>((const char*)Ks + KSWZ(32 + r32, cb));
    p0 = __builtin_amdgcn_mfma_f32_32x32x16_bf16(b0, qr[d0], p0, 0, 0, 0);
    p1 = __builtin_amdgcn_mfma_f32_32x32x16_bf16(b1, qr[d0], p1, 0, 0, 0); }
}
__device__ __forceinline__ int v_st(int k, int c) { const int kk = (k & ~0xC) | ((k & 4) << 1) | ((k & 8) >> 1); return ((kk >> 3) * 4 + (c >> 5)) * 512 + ((kk & 7) * 32 + (c & 31)) * 2; }
__device__ __forceinline__ int v_rd_base(int lane) { return ((lane & 3) << 3) | (((lane >> 2) & 3) << 6) | (((lane >> 4) & 1) << 5) | (((lane >> 5) & 1) << 8); }
constexpr int v_rd_off(int d0, int ks, int half) { return d0 * 512 + ks * 4096 + half * 2048; }
template <int OFF> __device__ __forceinline__ s16x4 tr_read(int vb) {
  s16x4 r; asm volatile("ds_read_b64_tr_b16 %0, %1 offset:%2" : "=&v"(r) : "v"(vb), "i"(OFF) : "memory"); return r;
}
template <int D0> __device__ __forceinline__ void pv_one(f32x16& od, int vb, bf16x8 pa0, bf16x8 pa1, bf16x8 pa2, bf16x8 pa3) {
  const s16x4 l0 = tr_read<v_rd_off(D0, 0, 0)>(vb), h0 = tr_read<v_rd_off(D0, 0, 1)>(vb), l1 = tr_read<v_rd_off(D0, 1, 0)>(vb), h1 = tr_read<v_rd_off(D0, 1, 1)>(vb);
  const s16x4 l2 = tr_read<v_rd_off(D0, 2, 0)>(vb), h2 = tr_read<v_rd_off(D0, 2, 1)>(vb), l3 = tr_read<v_rd_off(D0, 3, 0)>(vb), h3 = tr_read<v_rd_off(D0, 3, 1)>(vb);
  asm volatile("s_waitcnt lgkmcnt(0)" ::: "memory"); SBAR();
#define PK(L, H) (bf16x8){L[0], L[1], L[2], L[3], H[0], H[1], H[2], H[3]}
  od = __builtin_amdgcn_mfma_f32_32x32x16_bf16(pa0, PK(l0, h0), od, 0, 0, 0);
  od = __builtin_amdgcn_mfma_f32_32x32x16_bf16(pa1, PK(l1, h1), od, 0, 0, 0);
  od = __builtin_amdgcn_mfma_f32_32x32x16_bf16(pa2, PK(l2, h2), od, 0, 0, 0);
  od = __builtin_amdgcn_mfma_f32_32x32x16_bf16(pa3, PK(l3, h3), od, 0, 0, 0);
#undef PK
}
__device__ __forceinline__ void pv_d0(f32x16* o, int vb, bf16x8 pa0, bf16x8 pa1, bf16x8 pa2, bf16x8 pa3) {
  pv_one<0>(o[0], vb, pa0, pa1, pa2, pa3); pv_one<1>(o[1], vb, pa0, pa1, pa2, pa3); pv_one<2>(o[2], vb, pa0, pa1, pa2, pa3); pv_one<3>(o[3], vb, pa0, pa1, pa2, pa3);
}

__device__ __forceinline__ int lane_id_asm() { int l; asm volatile("v_mbcnt_lo_u32_b32 %0, -1, 0\n\tv_mbcnt_hi_u32_b32 %0, -1, %0" : "=v"(l)); return l; }
template <bool O8> __device__ __forceinline__ void attn_unit(const bf16_t* __restrict__ Qb, const bf16_t* __restrict__ Kh, const bf16_t* __restrict__ Vh, void* __restrict__ Ob, char* lds, const int wid, const float* __restrict__ qg, const int t0) {
  const int lane = lane_id_asm(), tid = wid * 64 + lane, r32 = lane & 31, hi = lane >> 5;
  bf16_t* V_lds = (bf16_t*)lds; bf16_t* K_lds = (bf16_t*)(lds + 2 * SHM_V);
  float* ws = (float*)(lds + 2 * SHM_V + 2 * SHM_K) + wid * 64; float* li_l = ws; float* al_l = ws + 32;
  float m_reg = -1e30f, l_reg = 0; f32x16 o[4] = {}; bf16x8 qr[8];
  __syncthreads();
  { const unsigned qoff = (unsigned)((wid * QBLK + r32) * LDQ + hi * 8) * 2u;
#pragma unroll
    for (int d0 = 0; d0 < 8; ++d0) qr[d0] = *reinterpret_cast<const bf16x8*>((const char*)Qb + qoff + d0 * 32); }
  { float xf[8][8]; float ss = 0.f;
#pragma unroll
    for (int d0 = 0; d0 < 8; ++d0)
#pragma unroll
      for (int k = 0; k < 8; ++k) { xf[d0][k] = __uint_as_float((unsigned)(unsigned short)qr[d0][k] << 16); ss += xf[d0][k] * xf[d0][k]; }
    { auto rr = __builtin_amdgcn_permlane32_swap(__float_as_uint(ss), __float_as_uint(ss), false, false); ss = __uint_as_float(rr[0]) + __uint_as_float(rr[1]); }
    const float rs = __builtin_amdgcn_rsqf(ss * (1.0f / (float)D) + RMS_EPS);
#pragma unroll
    for (int d0 = 0; d0 < 8; ++d0) { const f32x4 g0 = *(const f32x4*)(qg + 16 * d0 + 8 * hi), g1 = *(const f32x4*)(qg + 16 * d0 + 8 * hi + 4);
#pragma unroll
      for (int k = 0; k < 4; ++k) { xf[d0][k] *= rs * g0[k]; xf[d0][4 + k] *= rs * g1[k]; } }
    const int t = t0 + wid * QBLK + r32; const float pos[2] = {(float)(t >> 6), (float)(t & 63)};
#pragma unroll
    for (int ax = 0; ax < 2; ++ax)
#pragma unroll
      for (int dd = 0; dd < 2; ++dd)
#pragma unroll
        for (int k = 0; k < 8; ++k) {
          const float inv_freq = __builtin_amdgcn_exp2f(-(float)(16 * dd + 8 * hi + k) * 0.41524101186092029f);
          const float rev = pos[ax] * inv_freq * 0.15915494309189535f, c = __builtin_amdgcn_cosf(rev), s = __builtin_amdgcn_sinf(rev);
          const float y1 = xf[4 * ax + dd][k], y2 = xf[4 * ax + dd + 2][k];
          xf[4 * ax + dd][k] = y1 * c - y2 * s; xf[4 * ax + dd + 2][k] = y2 * c + y1 * s; }
#pragma unroll
    for (int d0 = 0; d0 < 8; ++d0) { u32x4 w = {cvtpk(xf[d0][0], xf[d0][1]), cvtpk(xf[d0][2], xf[d0][3]), cvtpk(xf[d0][4], xf[d0][5]), cvtpk(xf[d0][6], xf[d0][7])}; qr[d0] = *reinterpret_cast<bf16x8*>(&w); }
  }
  const int sr = tid >> 4, sc = (tid & 15) * 8, vst0 = v_st(sr, sc), vst1 = v_st(32 + sr, sc);
  const int vb0 = (int)(uintptr_t)V_lds + v_rd_base(lane);
  struct { bf16x8 vs0, vs1, ks0, ks1; } sr_[2];
#define LD8(p) (*reinterpret_cast<const bf16x8*>(p))
  const unsigned goff0 = (unsigned)(sr * LDK + sc) * 2u, goff1 = goff0 + 32u * LDK * 2u;
#define SLOAD(i, k0) do { const char* vt_ = (const char*)Vh + (size_t)(k0) * (LDK * 2); const char* kt_ = (const char*)Kh + (size_t)(k0) * (LDK * 2); \
    sr_[i].vs0 = LD8(vt_ + goff0); sr_[i].vs1 = LD8(vt_ + goff1); sr_[i].ks0 = LD8(kt_ + goff0); sr_[i].ks1 = LD8(kt_ + goff1); } while (0)
#define SWRITE(b, i) do { *(bf16x8*)((char*)V_lds + (b) * SHM_V + vst0) = sr_[i].vs0;          \
    *(bf16x8*)((char*)V_lds + (b) * SHM_V + vst1) = sr_[i].vs1; int kc = sc * 2;               \
    *(bf16x8*)((char*)K_lds + (b) * SHM_K + KSWZ(sr, kc)) = sr_[i].ks0;                       \
    *(bf16x8*)((char*)K_lds + (b) * SHM_K + KSWZ(32 + sr, kc)) = sr_[i].ks1; } while (0)
#define SWAIT() asm volatile("s_waitcnt vmcnt(4)" ::: "memory")
#define RESC(a) do { if (__any((a) < 1.f)) { if (hi == 0) al_l[r32] = (a); asm volatile("s_waitcnt lgkmcnt(0)" ::: "memory"); \
    _Pragma("unroll") for (int d = 0; d < 4; ++d) _Pragma("unroll") for (int r = 0; r < 16; ++r) o[d][r] *= al_l[crow(r, hi)]; } } while (0)
  f32x16 pA0, pA1, pB0, pB1; float mnA, mnB, alA, alB; bf16x8 pa0, pa1, pa2, pa3;
  constexpr int SE = 0, SO = 1;
  SLOAD(SE, 0); asm volatile("s_waitcnt vmcnt(0)" ::: "memory"); SWRITE(0, SE); __syncthreads();
  qkt(pA0, pA1, K_lds, qr, r32, hi);
#pragma unroll
  for (int r = 8; r < 16; ++r) pA0[r] = -INFINITY;
#pragma unroll
  for (int r = 0; r < 16; ++r) pA1[r] = -INFINITY;
  partialSM(pA0, pA1, m_reg, mnA, alA);
  SLOAD(SO, KVBLK); SLOAD(SE, 2 * KVBLK);
  SWAIT(); SWRITE(1, SO); __syncthreads();
  for (int j = 1; j + 1 < NT; j += 2) {
    SBAR(); qkt(pB0, pB1, (bf16_t*)((char*)K_lds + SHM_K), qr, r32, hi);
    finishSM(pA0, pA1, alA, l_reg, pa0, pa1, pa2, pa3); SBAR();
    if (j + 2 < NT) SLOAD(SO, (j + 2) * KVBLK); SBAR();
    pv_d0(o, vb0, pa0, pa1, pa2, pa3); partialSM(pB0, pB1, m_reg, mnB, alB);
    __syncthreads(); SWAIT(); SWRITE(0, SE);
    RESC(alB); __syncthreads();
    SBAR(); qkt(pA0, pA1, K_lds, qr, r32, hi);
    finishSM(pB0, pB1, alB, l_reg, pa0, pa1, pa2, pa3); SBAR();
    if (j + 3 < NT) SLOAD(SE, (j + 3) * KVBLK); SBAR();
    pv_d0(o, vb0 + (int)SHM_V, pa0, pa1, pa2, pa3); partialSM(pA0, pA1, m_reg, mnA, alA);
    __syncthreads(); SWAIT(); if (j + 2 < NT) SWRITE(1, SO);
    RESC(alA); __syncthreads();
  }
  finishSM(pA0, pA1, alA, l_reg, pa0, pa1, pa2, pa3); SBAR();
  pv_d0(o, vb0, pa0, pa1, pa2, pa3);
  if (hi == 0) li_l[r32] = l_reg; asm volatile("s_waitcnt lgkmcnt(0)" ::: "memory");
  float rli[16];
#pragma unroll
  for (int r = 0; r < 16; ++r) rli[r] = __builtin_amdgcn_rcpf(li_l[crow(r, hi)]);
  { const int l2 = lane_id_asm(), c32 = l2 & 31, h2 = l2 >> 5;
    if constexpr (O8) { unsigned char* Ow = (unsigned char*)Ob + (size_t)(wid * QBLK) * LDO;
#pragma unroll
      for (int r = 0; r < 16; ++r) { const unsigned ooff = (unsigned)(crow(r, h2) * LDO + c32);
#pragma unroll
        for (int d0 = 0; d0 < 4; ++d0) { const float v = __builtin_amdgcn_fmed3f(o[d0][r] * rli[r] * pg8::FP8_O_SCALE, -448.f, 448.f); Ow[ooff + d0 * 32] = (unsigned char)(__builtin_amdgcn_cvt_pk_fp8_f32(v, 0.f, 0, false) & 0xff); } } }
    else { char* Ow = (char*)Ob + (size_t)(wid * QBLK) * (LDO * 2);
#pragma unroll
      for (int r = 0; r < 16; ++r) { const unsigned ooff = (unsigned)(crow(r, h2) * LDO + c32) * 2u;
#pragma unroll
        for (int d0 = 0; d0 < 4; ++d0) *(bf16_t*)(Ow + ooff + d0 * 64) = (bf16_t)(cvtpk(o[d0][r] * rli[r], 0.f) & 0xffffu); } } }
#undef LD8
#undef SLOAD
#undef SWRITE
#undef SWAIT
#undef RESC
}
#undef KSWZ
}


namespace att8 {
using att::f32x16; using att::f32x4; using att::u32x4; using att::crow; using att::lane_id_asm;
typedef int i32x8 __attribute__((ext_vector_type(8)));
typedef int i32x4 __attribute__((ext_vector_type(4)));
constexpr int D = 128, NW = 8, QBLK = 32, KVBLK = 64, NT = att::NT;
constexpr float FP8_K_SCALE = 0.5f, FP8_Q_SCALE = att::SCALE * 1.4426950408889634f * 2.0f;
constexpr float FP8_KQ_SCALE = FP8_K_SCALE;
constexpr float FP8_V_SCALE = 16.f, FP8_P_LOG2 = 4.f, THR_LOG2 = 4.f;
constexpr int LDQ = NHEAD * HD, LDK8 = NKV * HD, LDO = NHEAD * HD;
constexpr int SHM_K = KVBLK * D, SHM_V = KVBLK * D, NSLOT = 4, SHM_ATTN8 = NSLOT * SHM_K + NSLOT * SHM_V + NW * 64 * 4;
#define SBAR8() __builtin_amdgcn_sched_barrier(0)
#define MFMA8(acc, a, b) asm volatile("v_mfma_f32_32x32x64_f8f6f4 %0, %1, %2, %0" : "+v"(acc) : "v"(a), "v"(b))
#define MFMA8N(dst, a, b, c) asm volatile("v_mfma_f32_32x32x64_f8f6f4 %0, %1, %2, %3" : "=&v"(dst) : "v"(a), "v"(b), "v"(c))
__device__ __forceinline__ i32x8 cat(const i32x4 x, const i32x4 y) { return (i32x8){x[0], x[1], x[2], x[3], y[0], y[1], y[2], y[3]}; }
__device__ __forceinline__ int k8_pos(int e) { const int d0 = e >> 4, hi = (e >> 3) & 1, k = e & 7; return (d0 >> 2) * 64 + hi * 32 + (d0 & 3) * 8 + k; }
__device__ __forceinline__ int v8_key(int j) { const int h = j >> 5, i = j & 31; return i < 16 ? crow(i, h) : 32 + crow(i - 16, h); }
__device__ __forceinline__ unsigned pk4(float a, float b, float c, float d) { int w = 0; w = __builtin_amdgcn_cvt_pk_fp8_f32(a, b, w, false); w = __builtin_amdgcn_cvt_pk_fp8_f32(c, d, w, true); return (unsigned)w; }
__device__ __forceinline__ unsigned pk4u(float a, float b, float c, float d) { int w; asm volatile("" : "=v"(w)); w = __builtin_amdgcn_cvt_pk_fp8_f32(a, b, w, false); w = __builtin_amdgcn_cvt_pk_fp8_f32(c, d, w, true); return (unsigned)w; }
__device__ __forceinline__ float sat8(float v) { return __builtin_amdgcn_fmed3f(v, -448.f, 448.f); }
__device__ __forceinline__ float max3f(float a, float b, float c) { float r; asm("v_max3_f32 %0, %1, %2, %3" : "=v"(r) : "v"(a), "v"(b), "v"(c)); return r; }

__device__ __forceinline__ void qkt8(f32x16& p0, f32x16& p1, const char* Ks, const i32x8 (&qf)[2], int r32, int hi) {
  p0 = f32x16{}; p1 = f32x16{};
#pragma unroll
  for (int s = 0; s < 2; ++s) {
    const int c0 = s * 4 + hi * 2;
#pragma unroll
    for (int hp = 0; hp < 2; ++hp) { const int key = hp * 32 + r32, swz = (key >> 1) & 7; const char* kr = Ks + key * 128;
      const i32x4 a0 = *reinterpret_cast<const i32x4*>(kr + ((c0 ^ swz) << 4)), a1 = *reinterpret_cast<const i32x4*>(kr + (((c0 + 1) ^ swz) << 4));
      if (hp == 0) MFMA8(p0, cat(a0, a1), qf[s]); else MFMA8(p1, cat(a0, a1), qf[s]); }
  }
}
__device__ __forceinline__ void pv8(f32x16* o, const char* Vs, const i32x8 pf, int r32, int hi) {
#pragma unroll
  for (int d0 = 0; d0 < 4; ++d0) { const int d = d0 * 32 + r32, swz = (d >> 2) & 3; const char* vr = Vs + d * 64;
    const i32x4 b0 = *reinterpret_cast<const i32x4*>(vr + (((hi * 2) ^ swz) << 4)), b1 = *reinterpret_cast<const i32x4*>(vr + (((hi * 2 + 1) ^ swz) << 4));
    MFMA8(o[d0], pf, cat(b0, b1)); }
}
__device__ __forceinline__ i32x8 kfrag8(const char* Ks, int hp, int s, int r32, int hi) { const int key = hp * 32 + r32, swz = (key >> 1) & 7, c0 = s * 4 + hi * 2; const char* kr = Ks + key * 128;
  return cat(*reinterpret_cast<const i32x4*>(kr + ((c0 ^ swz) << 4)), *reinterpret_cast<const i32x4*>(kr + (((c0 + 1) ^ swz) << 4))); }
__device__ __forceinline__ i32x8 vfrag8(const char* Vs, int d0, int r32, int hi) { const int d = d0 * 32 + r32, swz = (d >> 2) & 3; const char* vr = Vs + d * 64;
  return cat(*reinterpret_cast<const i32x4*>(vr + (((hi * 2) ^ swz) << 4)), *reinterpret_cast<const i32x4*>(vr + (((hi * 2 + 1) ^ swz) << 4))); }
#define MAXCH8(m_, p_) do { float b_; asm("v_max3_f32 %0, %2, %3, %4\n\tv_max3_f32 %1, %5, %6, %7\n\tv_max3_f32 %0, %0, %8, %9\n\tv_max3_f32 %1, %1, %10, %11\n\tv_max3_f32 %0, %0, %12, %13\n\tv_max3_f32 %1, %1, %14, %15\n\tv_max3_f32 %0, %0, %16, %17\n\tv_max_f32 %0, %0, %1" \
    : "=&v"(m_), "=&v"(b_) : "v"(p_[0]), "v"(p_[1]), "v"(p_[2]), "v"(p_[3]), "v"(p_[4]), "v"(p_[5]), "v"(p_[6]), "v"(p_[7]), "v"(p_[8]), "v"(p_[9]), "v"(p_[10]), "v"(p_[11]), "v"(p_[12]), "v"(p_[13]), "v"(p_[14]), "v"(p_[15])); } while (0)
#define STEP8(pC0, pC1, pP0, pP1, alC, KS, VS, JT) do { \
    const char* Kb_ = K_lds + (KS) * SHM_K; const char* Vb_ = V_lds + (VS) * SHM_V; \
    DMAK8((JT) + 2, ((KS) + 2) & 3); DMAV8((JT) + 1, ((VS) + 2) & 3); \
    i32x8 ka_ = kfrag8(Kb_, 0, 0, r32, hi), kb_ = kfrag8(Kb_, 1, 0, r32, hi), kc_ = kfrag8(Kb_, 0, 1, r32, hi); SBAR8();     \
    MFMA8N(pC0, ka_, qf[0], negm); \
    i32x8 kd_ = kfrag8(Kb_, 1, 1, r32, hi); _Pragma("unroll") for (int r_ = 0; r_ < 8; ++r_) pP1[r_] = __builtin_amdgcn_exp2f(pP1[r_]); SBAR8(); \
    MFMA8N(pC1, kb_, qf[0], negm); \
    i32x8 va_ = vfrag8(Vb_, 0, r32, hi); _Pragma("unroll") for (int r_ = 8; r_ < 16; ++r_) pP1[r_] = __builtin_amdgcn_exp2f(pP1[r_]); SBAR8(); \
    MFMA8(pC0, kc_, qf[1]); \
    i32x8 vb_ = vfrag8(Vb_, 1, r32, hi); _Pragma("unroll") for (int q_ = 0; q_ < 4; ++q_) { \
        pf[q_] = (int)pk4u(pP0[4 * q_], pP0[4 * q_ + 1], pP0[4 * q_ + 2], pP0[4 * q_ + 3]); pf[4 + q_] = (int)pk4u(pP1[4 * q_], pP1[4 * q_ + 1], pP1[4 * q_ + 2], pP1[4 * q_ + 3]); } SBAR8(); \
    MFMA8(pC1, kd_, qf[1]); \
    i32x8 vc_ = vfrag8(Vb_, 2, r32, hi); SBAR8(); \
    MFMA8(o[0], pf, va_); \
    i32x8 vd_ = vfrag8(Vb_, 3, r32, hi); float m0_; MAXCH8(m0_, pC0); SBAR8(); \
    MFMA8(o[1], pf, vb_); \
    float m1_; MAXCH8(m1_, pC1); float pmax_; asm("v_max_f32 %0, %1, %2" : "=v"(pmax_) : "v"(m0_), "v"(m1_)); \
    { auto rr_ = __builtin_amdgcn_permlane32_swap(__float_as_uint(pmax_), __float_as_uint(pmax_), false, false); asm("v_max_f32 %0, %1, %2" : "=v"(pmax_) : "v"(rr_[0]), "v"(rr_[1])); } \
    alC = 1.f; \
    if (__builtin_expect(!__all(pmax_ <= FP8_P_LOG2 + THR_LOG2), 0)) {     \
        const float d_ = fmaxf(pmax_ - FP8_P_LOG2, 0.f); alC = __builtin_amdgcn_exp2f(-d_); m_reg += d_; \
        _Pragma("unroll") for (int r_ = 0; r_ < 16; ++r_) { pC0[r_] -= d_; pC1[r_] -= d_; negm[r_] = FP8_P_LOG2 - m_reg; } } SBAR8(); \
    MFMA8(o[2], pf, vc_); \
    _Pragma("unroll") for (int r_ = 0; r_ < 16; ++r_) pC0[r_] = __builtin_amdgcn_exp2f(pC0[r_]); SBAR8(); \
    MFMA8(o[3], pf, vd_); \
    MFMA8(osum, pf, ones8);        \
    \
  } while (0)

template <bool WAITMFMA> __device__ __forceinline__ void partialSM8(f32x16& p0, f32x16& p1, float& m_reg, float& alpha) {
  if (WAITMFMA) asm volatile("s_nop 15\n\ts_nop 7" : "+v"(p0), "+v"(p1));
  float pa = max3f(p0[0], p0[1], p1[0]), pb = max3f(p0[2], p0[3], p1[1]); pa = max3f(pa, p1[2], p1[3]);
#pragma unroll
  for (int r = 4; r < 16; r += 4) { pa = max3f(pa, p0[r], p0[r + 1]); pb = max3f(pb, p0[r + 2], p0[r + 3]); pa = max3f(pa, p1[r], p1[r + 1]); pb = max3f(pb, p1[r + 2], p1[r + 3]); }
  float pmax = fmaxf(pa, pb);
  { auto rr = __builtin_amdgcn_permlane32_swap(__float_as_uint(pmax), __float_as_uint(pmax), false, false);
    pmax = fmaxf(__uint_as_float(rr[0]), __uint_as_float(rr[1])); }
  float mn;
  if (__builtin_expect(__all(pmax - m_reg <= THR_LOG2), 1)) { mn = m_reg; alpha = 1.f; }
  else { mn = fmaxf(m_reg, pmax); alpha = __builtin_amdgcn_exp2f(m_reg - mn); m_reg = mn; }
  const float mnC = FP8_P_LOG2 - mn;
#pragma unroll
  for (int r = 0; r < 16; ++r) p0[r] = __builtin_amdgcn_exp2f(p0[r] + mnC);
#pragma unroll
  for (int r = 0; r < 16; ++r) p1[r] += mnC;
}
__device__ __forceinline__ void finishSM8(f32x16& p0, f32x16& p1, i32x8& pf) {
#pragma unroll
  for (int r = 0; r < 16; ++r) p1[r] = __builtin_amdgcn_exp2f(p1[r]);
#pragma unroll
  for (int q = 0; q < 4; ++q) { pf[q] = (int)pk4(p0[4 * q], p0[4 * q + 1], p0[4 * q + 2], p0[4 * q + 3]); pf[4 + q] = (int)pk4(p1[4 * q], p1[4 * q + 1], p1[4 * q + 2], p1[4 * q + 3]); }
}

__device__ __forceinline__ void attn_unit8(const unsigned short* __restrict__ Qb, const unsigned char* __restrict__ Kh8, const unsigned char* __restrict__ Vt, unsigned char* __restrict__ Ob,
                                           char* lds, __attribute__((address_space(3))) unsigned char* ldsl, const int wid, const float* __restrict__ qg, const int t0) {
  const int lane = lane_id_asm(), tid = wid * 64 + lane, r32 = lane & 31, hi = lane >> 5;
  char* K_lds = lds; char* V_lds = lds + NSLOT * SHM_K;
  float* ws = (float*)(lds + NSLOT * SHM_K + NSLOT * SHM_V) + wid * 64; float* al_l = ws + 32;
  float m_reg = -1e30f; f32x16 o[4] = {}; f32x16 osum = {}; i32x8 qf[2];
  const i32x8 ones8 = {0x38383838, 0x38383838, 0x38383838, 0x38383838, 0x38383838, 0x38383838, 0x38383838, 0x38383838};
  __syncthreads();
  { att::bf16x8 qr[8];
    const unsigned qoff = (unsigned)((wid * QBLK + r32) * LDQ + hi * 8) * 2u;
#pragma unroll
    for (int d0 = 0; d0 < 8; ++d0) qr[d0] = *reinterpret_cast<const att::bf16x8*>((const char*)Qb + qoff + d0 * 32);
    float xf[8][8]; float ss = 0.f;
#pragma unroll
    for (int d0 = 0; d0 < 8; ++d0)
#pragma unroll
      for (int k = 0; k < 8; ++k) { xf[d0][k] = __uint_as_float((unsigned)(unsigned short)qr[d0][k] << 16); ss += xf[d0][k] * xf[d0][k]; }
    { auto rr = __builtin_amdgcn_permlane32_swap(__float_as_uint(ss), __float_as_uint(ss), false, false); ss = __uint_as_float(rr[0]) + __uint_as_float(rr[1]); }
    const float rs = __builtin_amdgcn_rsqf(ss * (1.0f / (float)D) + RMS_EPS) * FP8_Q_SCALE;
#pragma unroll
    for (int d0 = 0; d0 < 8; ++d0) { const f32x4 g0 = *(const f32x4*)(qg + 16 * d0 + 8 * hi), g1 = *(const f32x4*)(qg + 16 * d0 + 8 * hi + 4);
#pragma unroll
      for (int k = 0; k < 4; ++k) { xf[d0][k] *= rs * g0[k]; xf[d0][4 + k] *= rs * g1[k]; } }
    const int t = t0 + wid * QBLK + r32; const float pos[2] = {(float)(t >> 6), (float)(t & 63)};
#pragma unroll
    for (int ax = 0; ax < 2; ++ax)
#pragma unroll
      for (int dd = 0; dd < 2; ++dd)
#pragma unroll
        for (int k = 0; k < 8; ++k) {
          const float inv_freq = __builtin_amdgcn_exp2f(-(float)(16 * dd + 8 * hi + k) * 0.41524101186092029f);
          const float rev = pos[ax] * inv_freq * 0.15915494309189535f, c = __builtin_amdgcn_cosf(rev), s = __builtin_amdgcn_sinf(rev);
          const float y1 = xf[4 * ax + dd][k], y2 = xf[4 * ax + dd + 2][k];
          xf[4 * ax + dd][k] = y1 * c - y2 * s; xf[4 * ax + dd + 2][k] = y2 * c + y1 * s; }
#pragma unroll
    for (int s = 0; s < 2; ++s)
#pragma unroll
      for (int j = 0; j < 4; ++j) { const int d0 = 4 * s + j;
        qf[s][2 * j] = (int)pk4(sat8(xf[d0][0]), sat8(xf[d0][1]), sat8(xf[d0][2]), sat8(xf[d0][3])); qf[s][2 * j + 1] = (int)pk4(sat8(xf[d0][4]), sat8(xf[d0][5]), sat8(xf[d0][6]), sat8(xf[d0][7])); }
  }
  const int skey = tid >> 3, sd = tid >> 2;
  const unsigned kg_off = (unsigned)(skey * LDK8 + (((tid & 7) ^ ((skey >> 1) & 7)) << 4)), vg_off = (unsigned)(sd * 64 + (((tid & 3) ^ ((sd >> 2) & 3)) << 4));
#define TCLAMP(t) ((t) < NT ? (t) : NT - 1)
#define DMAK8(kt, ks) __builtin_amdgcn_global_load_lds((const unsigned*)(Kh8 + (size_t)TCLAMP(kt) * (KVBLK * LDK8) + kg_off), (__attribute__((address_space(3))) unsigned*)(ldsl + (ks) * SHM_K + wid * 1024), 16, 0, 0)
#define DMAV8(vt, vs) __builtin_amdgcn_global_load_lds((const unsigned*)(Vt + (size_t)TCLAMP(vt) * (KVBLK * D) + vg_off), (__attribute__((address_space(3))) unsigned*)(ldsl + NSLOT * SHM_K + (vs) * SHM_V + wid * 1024), 16, 0, 0)
#define STEP_END8() do { asm volatile("s_waitcnt vmcnt(2) lgkmcnt(0)" ::: "memory"); __builtin_amdgcn_s_barrier(); asm volatile("" ::: "memory"); } while (0)
#define RESC8(a) do { if (__any((a) < 1.f)) { if (hi == 0) al_l[r32] = (a); asm volatile("s_waitcnt lgkmcnt(0)" ::: "memory"); asm volatile("s_nop 15\n\ts_nop 7" : "+v"(o[0]), "+v"(o[1]), "+v"(o[2]), "+v"(o[3]), "+v"(osum)); \
    _Pragma("unroll") for (int r = 0; r < 16; ++r) { const float a_ = al_l[crow(r, hi)]; osum[r] *= a_; _Pragma("unroll") for (int d = 0; d < 4; ++d) o[d][r] *= a_; } } } while (0)
  f32x16 pA0, pA1, pB0, pB1, negm; float alA, alB; i32x8 pf;
  DMAK8(0, 0); DMAV8(0, 0); DMAK8(1, 1); DMAK8(2, 2); DMAV8(1, 1);
  STEP_END8();
  qkt8(pA0, pA1, K_lds, qf, r32, hi);
  asm volatile("s_nop 15\n\ts_nop 7" : "+v"(pA0), "+v"(pA1));
#pragma unroll
  for (int r = 8; r < 16; ++r) pA0[r] = -INFINITY;
#pragma unroll
  for (int r = 0; r < 16; ++r) pA1[r] = -INFINITY;
  partialSM8<false>(pA0, pA1, m_reg, alA);
#pragma unroll
  for (int r = 0; r < 16; ++r) negm[r] = FP8_P_LOG2 - m_reg;
  asm volatile("s_waitcnt lgkmcnt(0)" ::: "memory"); __builtin_amdgcn_s_barrier(); asm volatile("" ::: "memory");
  for (int j = 1; j < NT; j += 4) {
    STEP8(pB0, pB1, pA0, pA1, alB, 1, 0, j);     RESC8(alB); STEP_END8();
    STEP8(pA0, pA1, pB0, pB1, alA, 2, 1, j + 1); RESC8(alA); STEP_END8();
    STEP8(pB0, pB1, pA0, pA1, alB, 3, 2, j + 2); RESC8(alB); STEP_END8();
    STEP8(pA0, pA1, pB0, pB1, alA, 0, 3, j + 3); RESC8(alA); STEP_END8();
  }
  asm volatile("s_waitcnt vmcnt(0)" ::: "memory");
  finishSM8(pA0, pA1, pf); SBAR8();
  pv8(o, V_lds + ((NT - 1) & 3) * SHM_V, pf, r32, hi); MFMA8(osum, pf, ones8);
  asm volatile("s_nop 15\n\ts_nop 15\n\ts_nop 15\n\ts_nop 7" : "+v"(o[0]), "+v"(o[1]), "+v"(o[2]), "+v"(o[3]), "+v"(osum));
  float rli[16];
#pragma unroll
  for (int r = 0; r < 16; ++r) rli[r] = __builtin_amdgcn_rcpf(osum[r]) * (pg8::FP8_O_SCALE / FP8_V_SCALE);
  { const int l2 = lane_id_asm(), c32 = l2 & 31, h2 = l2 >> 5; unsigned char* Ow = Ob + (size_t)(wid * QBLK) * LDO;
#pragma unroll
    for (int r = 0; r < 16; ++r) { const unsigned ooff = (unsigned)(crow(r, h2) * LDO + c32);
#pragma unroll
      for (int d0 = 0; d0 < 4; ++d0) { const float v = sat8(o[d0][r] * rli[r]); Ow[ooff + d0 * 32] = (unsigned char)(__builtin_amdgcn_cvt_pk_fp8_f32(v, 0.f, 0, false) & 0xff); } } }
#undef DMAK8
#undef DMAV8
#undef MAXCH8
#undef STEP_END8
#undef TCLAMP
#undef STEP8
#undef RESC8
}
}

#define GAS __attribute__((address_space(1)))
#define LAS __attribute__((address_space(3)))
typedef unsigned short bf16;
typedef unsigned v4u __attribute__((ext_vector_type(4)));
typedef float f32x4 __attribute__((ext_vector_type(4)));
typedef short bf16x8 __attribute__((ext_vector_type(8)));
typedef GAS unsigned gu32;
typedef GAS unsigned long long gu64;
#define RLX_AGENT __ATOMIC_RELAXED, __HIP_MEMORY_SCOPE_AGENT
#define LDS_WAIT() asm volatile("s_waitcnt lgkmcnt(0)" ::: "memory")
#define VM_WAIT() asm volatile("s_waitcnt vmcnt(0)" ::: "memory")
__device__ __forceinline__ unsigned long long rt() { return __builtin_amdgcn_s_memrealtime(); }
__device__ __forceinline__ unsigned f2bf(float f) { unsigned u = __builtin_bit_cast(unsigned, f); return (u + 0x7fffu + ((u >> 16) & 1u)) >> 16; }
__device__ __forceinline__ unsigned pk2(float lo, float hi) { return f2bf(lo) | (f2bf(hi) << 16); }

#define XB_TMO      128
#define XB_XCNT(j)  (256  + 64 * (j))
#define XB_XSUB(j)  (1280 + 64 * (j))
#define XB_XGEN(j)  (2304 + 64 * (j))
#define XB_TOP      3328
#define XB_TOPGEN   3392
#define XCD_BAR_WORDS 3456
#define XB_SPIN_CAP (1u << 18)

__device__ __forceinline__ unsigned xb_ld(unsigned* p)              { return __hip_atomic_load(p, __ATOMIC_RELAXED, __HIP_MEMORY_SCOPE_AGENT); }
__device__ __forceinline__ unsigned xb_add(unsigned* p, unsigned v) { return __hip_atomic_fetch_add(p, v, __ATOMIC_RELAXED, __HIP_MEMORY_SCOPE_AGENT); }
__device__ __forceinline__ unsigned xb_xcc_id() { return (unsigned)__builtin_amdgcn_s_getreg((3 << 11) | 20) & 0xFu; }
#define XB_SPIN(cond, bar) do { unsigned _sp = 0; while (cond) { __builtin_amdgcn_s_sleep(1); \
    if ((++_sp & 255u) == 0u) { if (xb_ld(&(bar)[XB_TMO])) break; if (_sp > XB_SPIN_CAP) { atomicAdd(&(bar)[XB_TMO], 1u); break; } } } } while (0)

struct XcdBarrier {
    unsigned* bar; unsigned x;
    volatile LAS unsigned* st;
};

__device__ __forceinline__ XcdBarrier xcd_barrier_post(unsigned* bar, volatile LAS unsigned* st, const bool t0) {
    XcdBarrier b; b.bar = bar; b.x = xb_xcc_id(); b.st = st;
    if (t0) (void)xb_add(&bar[XB_XCNT(b.x)], 1u);
    return b;
}
__device__ __forceinline__ void xcd_barrier_complete(unsigned* bar, unsigned x, unsigned& nloc, unsigned& nx) {
    const unsigned G = gridDim.x * gridDim.y * gridDim.z;
    unsigned sum, cnt, mine, sp = 0u;
    for (;;) {
        sum = 0u; cnt = 0u; mine = 0u;
#pragma unroll
        for (unsigned j = 0; j < 16; ++j) { const unsigned c = xb_ld(&bar[XB_XCNT(j)]); sum += c; cnt += (c > 0u) ? 1u : 0u; mine = (j == x) ? c : mine; }
        if (sum == G) break;
        __builtin_amdgcn_s_sleep(1);
        if ((++sp & 255u) == 0u) { if (xb_ld(&bar[XB_TMO])) break; if (sp > XB_SPIN_CAP) { atomicAdd(&bar[XB_TMO], 1u); break; } }
    }
    nloc = mine > 0u ? mine : 1u; nx = cnt > 0u ? cnt : 1u;
}

__device__ __forceinline__ void xcd_barrier(const XcdBarrier& b, const bool t0) {
    asm volatile("s_waitcnt vmcnt(0)" ::: "memory");
    __syncthreads();
    if (t0) {
        unsigned* bar = b.bar;
        __builtin_amdgcn_s_waitcnt(0);
        unsigned nloc = b.st[0], nx = b.st[1];
        if (nloc == 0u) { xcd_barrier_complete(bar, b.x, nloc, nx); b.st[0] = nloc; b.st[1] = nx; }
        const unsigned old = xb_add(&bar[XB_XSUB(b.x)], 1u);
        const unsigned gen = old / nloc;
        if (old + 1u == (gen + 1u) * nloc) {
            __builtin_amdgcn_fence(__ATOMIC_RELEASE, "agent");
            asm volatile("s_waitcnt vmcnt(0)" ::: "memory");
            const unsigned og = xb_add(&bar[XB_TOP], 1u);
            const unsigned tg = og / nx;
            if (og + 1u == (tg + 1u) * nx) xb_add(&bar[XB_TOPGEN], 1u);
            else XB_SPIN(xb_ld(&bar[XB_TOPGEN]) == tg, bar);
            __builtin_amdgcn_fence(__ATOMIC_ACQUIRE, "agent");
            xb_add(&bar[XB_XGEN(b.x)], 1u);
            asm volatile("s_waitcnt vmcnt(0)" ::: "memory");
        } else {
            XB_SPIN(xb_ld(&bar[XB_XGEN(b.x)]) == gen, bar);
            __builtin_amdgcn_fence(__ATOMIC_ACQUIRE, "agent");
            asm volatile("s_waitcnt vmcnt(0)" ::: "memory");
        }
    }
    __syncthreads();
}

constexpr size_t MiB = 1u << 20;
constexpr size_t CTL_ZERO_BYTES = 2 * MiB;
constexpr int CW_BAR = 4096;
constexpr size_t RSS_OFF = 256 * 1024;
constexpr int NRSS = 7;
static_assert((CW_BAR + XCD_BAR_WORDS) * 4 <= (int)RSS_OFF && RSS_OFF + (size_t)NRSS * MPAD * 8 <= CTL_ZERO_BYTES, "control region");
constexpr size_t SZ_WGU = (size_t)2 * DFF * DM * 2, SZ_WD = (size_t)DM * DFF * 2, SZ_WCI = (size_t)3 * DM * DM * 2, SZ_WSQ = (size_t)DM * DM * 2, SZ_WQKV = (size_t)NQKV * DM * 2;
constexpr size_t WS_WGU = 2 * MiB;
constexpr size_t WS_WD = WS_WGU + 4 * SZ_WGU;
constexpr size_t WS_WCI = WS_WD + 4 * SZ_WD;
constexpr size_t WS_WCO = WS_WCI + SZ_WCI;
constexpr size_t WS_WQKV = WS_WCO + SZ_WSQ;
constexpr size_t WS_WO = WS_WQKV + SZ_WQKV;
constexpr size_t WS_H = WS_WO + SZ_WSQ;
constexpr size_t WS_HB = WS_H + (size_t)MPAD * DM * 4;
constexpr size_t WS_ACT = WS_HB + (size_t)MPAD * DM * 2;
constexpr size_t SZ_ACT = (size_t)MPAD * DFF * 2;
constexpr size_t WS_BB = WS_ACT, WS_UB = WS_ACT + (size_t)MPAD * DM * 2;
constexpr size_t WS_Q = WS_ACT, WS_K = WS_Q + (size_t)MREAL * DM * 2, WS_V = WS_K + (size_t)NB * KVROWS * NKV * HD * 2;
static_assert(WS_UB + (size_t)MPAD * DM * 2 <= WS_ACT + SZ_ACT && WS_V + (size_t)NB * KVROWS * NKV * HD * 2 <= WS_ACT + SZ_ACT, "overlays fit the FFN hidden buffer");
constexpr size_t WS_AUX = WS_ACT + SZ_ACT;
constexpr size_t SZ_WD8 = (size_t)DM * DFF;
constexpr size_t WS_WD8 = WS_AUX + (size_t)MPAD * DM * 2;
constexpr size_t WS_WQKV8 = WS_WD8 + 4 * SZ_WD8;
constexpr size_t WS_WO8 = WS_WQKV8 + (size_t)NQKV * DM;
constexpr size_t WS_HB8 = WS_WO8 + (size_t)DM * DM;
constexpr size_t WS_K8 = WS_HB8 + (size_t)MPAD * DM;
constexpr size_t WS_VT8 = WS_K8 + (size_t)NB * KVROWS * NKV * HD;
constexpr size_t WS_END = WS_VT8 + (size_t)NB * NKV * (KVROWS / 64) * 128 * 64;
static_assert(WS_WD8 % 256 == 0 && WS_WQKV8 % 256 == 0 && WS_WO8 % 256 == 0 && WS_HB8 % 256 == 0 && WS_K8 % 256 == 0 && WS_VT8 % 256 == 0, "alignment");
static_assert(WS_WGU % 256 == 0 && WS_WD % 256 == 0 && WS_H % 256 == 0 && WS_HB % 256 == 0 && WS_ACT % 256 == 0 && WS_K % 256 == 0 && WS_V % 256 == 0 && WS_AUX % 256 == 0, "alignment");

constexpr int NWAVES = 8;
constexpr int RING_BYTES = 131072;
constexpr int MISC_OFF = 139264 + 320;
constexpr int LDS_BYTES = 147456;

struct Frame {
    LAS unsigned char* lds;
    int tid, lane, wave, G, bid;
};
#define REFRAME(F) do { (F).lane = att::lane_id_asm(); (F).tid = (F).wave * 64 + (F).lane; } while (0)

__device__ __forceinline__ float wave_sum(float v) {
#pragma unroll
    for (int o = 1; o < 64; o <<= 1) v += __shfl_xor(v, o);
    return v;
}
__device__ __forceinline__ float bf2f(unsigned short b) { return __uint_as_float((unsigned)b << 16); }

#define CVT_LOAD32(t, wp, ldw, koff) do { _Pragma("unroll") for (int i_ = 0; i_ < 32; ++i_) (t)[i_] = __builtin_nontemporal_load((wp) + (size_t)((koff) + 2 * i_) * (ldw)); } while (0)
#define CVT_LDSW32(t, scr, koff, lane) do { _Pragma("unroll") for (int i_ = 0; i_ < 32; ++i_) (scr)[((koff) + 2 * i_ + ((lane) >> 5)) * 33 + ((lane) & 31)] = (t)[i_]; } while (0)
__device__ __forceinline__ void cvt_finish(const float (&t)[32], const float* g, bf16* WT, int K, int drow, int k0, LAS float* scr, int lane) {
    const int c = lane & 7;
    f32x4 g0 = {1.f, 1.f, 1.f, 1.f}, g1 = g0;
    if (g) { g0 = *(const f32x4*)(g + k0 + 8 * c); g1 = *(const f32x4*)(g + k0 + 8 * c + 4); }
    CVT_LDSW32(t, scr, 0, lane);
    LDS_WAIT(); asm volatile("" ::: "memory");
#pragma unroll
    for (int j = 0; j < 4; ++j) { const int n = (lane >> 3) + 8 * j; const LAS float* s = scr + (8 * c) * 33 + n;
        v4u o; o.x = pg8::cvt_pk_bf16(s[0 * 33] * g0[0], s[1 * 33] * g0[1]); o.y = pg8::cvt_pk_bf16(s[2 * 33] * g0[2], s[3 * 33] * g0[3]);
        o.z = pg8::cvt_pk_bf16(s[4 * 33] * g1[0], s[5 * 33] * g1[1]); o.w = pg8::cvt_pk_bf16(s[6 * 33] * g1[2], s[7 * 33] * g1[3]);
        __builtin_nontemporal_store(o, (GAS v4u*)(WT + (size_t)(drow + n) * K + k0 + 8 * c)); }
    LDS_WAIT(); asm volatile("" ::: "memory");
}
template <int MODE>
__device__ __forceinline__ const float* cvt_src(const float* W, const float* W2, int ldw, int nblk, int it, int lane, int& drow, int& k0) {
    const int kb = it / nblk, nb = it - kb * nblk; drow = nb * 32; k0 = kb * 64;
    const float* src = W; int scol = drow;
    if (MODE == 1) { src = ((drow >> 7) & 1) ? W2 : W; scol = (drow >> 8) * 128 + (drow & 127); }
    if (MODE == 2) { if (drow < 2 * DM) scol = (((drow >> 7) & 1) ? 2 * DM : DM) + (drow >> 8) * 128 + (drow & 127); else scol = drow - 2 * DM; }
    return src + (size_t)(k0 + (lane >> 5)) * ldw + scol + (lane & 31);
}
template <int MODE>
__device__ __forceinline__ void cvt_matrix(Frame& F, const float* W, const float* W2, int ldw, const float* g, bf16* WT, int K, int ndst) {
    LAS float* scr = (LAS float*)(F.lds + F.wave * 16896);
    const int gw = F.bid * NWAVES + F.wave, NGW = F.G * NWAVES, lane = F.lane;
    const int nblk = ndst / 32, nitems = nblk * (K / 64);
    float ta[32], tb[32]; int da, ka, db, kb;
    int it = gw;
    if (it < nitems) { const float* wp = cvt_src<MODE>(W, W2, ldw, nblk, it, lane, da, ka); CVT_LOAD32(ta, wp, ldw, 0); }
    while (it < nitems) {
        const int it1 = it + NGW;
        if (it1 < nitems) { const float* wp = cvt_src<MODE>(W, W2, ldw, nblk, it1, lane, db, kb); CVT_LOAD32(tb, wp, ldw, 0); }
        __builtin_amdgcn_sched_barrier(0);
        cvt_finish(ta, g, WT, K, da, ka, scr, lane);
        if (it1 >= nitems) break;
        it = it1 + NGW;
        if (it < nitems) { const float* wp = cvt_src<MODE>(W, W2, ldw, nblk, it, lane, da, ka); CVT_LOAD32(ta, wp, ldw, 0); }
        __builtin_amdgcn_sched_barrier(0);
        cvt_finish(tb, g, WT, K, db, kb, scr, lane);
    }
}
__device__ __forceinline__ void cvt_finish8(const float* g, float scale, unsigned char* WT, int K, int drow, int k0, LAS float* scr, int lane) {
    const int c = lane & 7;
    f32x4 gv[4];
#pragma unroll
    for (int q = 0; q < 4; ++q) gv[q] = g ? *(const f32x4*)(g + k0 + 16 * c + 4 * q) * scale : (f32x4){scale, scale, scale, scale};
    LDS_WAIT(); asm volatile("" ::: "memory");
#pragma unroll
    for (int j = 0; j < 4; ++j) { const int n = (lane >> 3) + 8 * j; const LAS float* s = scr + (16 * c) * 33 + n;
        v4u o;
#pragma unroll
        for (int q = 0; q < 4; ++q) o[q] = pg8::pack_fp8x4((f32x4){s[(4 * q + 0) * 33], s[(4 * q + 1) * 33], s[(4 * q + 2) * 33], s[(4 * q + 3) * 33]} * gv[q]);
        __builtin_nontemporal_store(o, (GAS v4u*)(WT + (size_t)(drow + n) * K + k0 + 16 * c)); }
    LDS_WAIT(); asm volatile("" ::: "memory");
}
__device__ __forceinline__ void cvt_matrix8(Frame& F, const float* W, int ldw, const float* g, float scale, unsigned char* WT, int K, int ndst) {
    LAS float* scr = (LAS float*)(F.lds + F.wave * 16896);
    const int gw = F.bid * NWAVES + F.wave, NGW = F.G * NWAVES, lane = F.lane;
    const int nblk = ndst / 32, nitems = nblk * (K / 128);
    float ta[32], tb[32];
    int it = gw;
    if (it < nitems) { const int kb = it / nblk, nb = it - kb * nblk; const float* wp = W + (size_t)(kb * 128 + (lane >> 5)) * ldw + nb * 32 + (lane & 31); CVT_LOAD32(ta, wp, ldw, 0); }
    for (; it < nitems; it += NGW) {
        const int kb = it / nblk, nb = it - kb * nblk; const float* wp = W + (size_t)(kb * 128 + (lane >> 5)) * ldw + nb * 32 + (lane & 31);
        CVT_LOAD32(tb, wp, ldw, 64);
        __builtin_amdgcn_sched_barrier(0);
        CVT_LDSW32(ta, scr, 0, lane);
        const int itn = it + NGW;
        if (itn < nitems) { const int kbn = itn / nblk, nbn = itn - kbn * nblk; const float* wpn = W + (size_t)(kbn * 128 + (lane >> 5)) * ldw + nbn * 32 + (lane & 31); CVT_LOAD32(ta, wpn, ldw, 0); }
        __builtin_amdgcn_sched_barrier(0);
        CVT_LDSW32(tb, scr, 64, lane);
        cvt_finish8(g, scale, WT, K, nb * 32, kb * 128, scr, lane);
    }
}

template <int MODE>
__device__ __forceinline__ void cvt_one(const float* W, const float* W2, int ldw, const float* g, bf16* WT, int K, int ndst, int it, LAS float* scr, int lane) {
    int drow, k0; const float* wp = cvt_src<MODE>(W, W2, ldw, ndst / 32, it, lane, drow, k0);
    float t[32]; CVT_LOAD32(t, wp, ldw, 0);
    cvt_finish(t, g, WT, K, drow, k0, scr, lane);
}
__device__ __forceinline__ void cvt_one8(const float* W, int ldw, const float* g, float scale, unsigned char* WT, int K, int ndst, int it, LAS float* scr, int lane) {
    const int nblk = ndst / 32, kb = it / nblk, nb = it - kb * nblk; const float* wp = W + (size_t)(kb * 128 + (lane >> 5)) * ldw + nb * 32 + (lane & 31);
    float ta[32], tb[32]; CVT_LOAD32(ta, wp, ldw, 0); CVT_LOAD32(tb, wp, ldw, 64);
    CVT_LDSW32(ta, scr, 0, lane); CVT_LDSW32(tb, scr, 64, lane);
    cvt_finish8(g, scale, WT, K, nb * 32, kb * 128, scr, lane);
}
constexpr int BG_N0 = (2 * DFF / 32) * (DM / 64), BG_N1 = (DM / 32) * (DFF / 128), BG_N2 = (NQKV / 32) * (DM / 128), BG_N3 = (2 * NKV * HD / 32) * (DM / 64), BG_N4 = (DM / 32) * (DM / 128);
constexpr int BG_L0 = (DM / 32) * (DFF / 64), BG_L1 = BG_L0 + (3 * DM / 32) * (DM / 64), BG_L2 = BG_L1 + (DM / 32) * (DM / 64), BG_L3 = BG_L2 + BG_N0, BG_L4 = BG_L3 + BG_N1;
constexpr int BG_B1 = BG_L4 + BG_N0, BG_B2 = BG_B1 + BG_N1, BG_B3 = BG_B2 + BG_N2, BG_B4 = BG_B3 + BG_N3, BG_B5 = BG_B4 + BG_N4, BG_B6 = BG_B5 + BG_N0, BG_TOTAL = BG_B6 + BG_N1;
constexpr int BG_END_A = BG_B5;
constexpr size_t BG_CTL_OFF = 1536 * 1024;
constexpr int BG_CH = 2;
__device__ __forceinline__ void bg_item(Frame& F, const float* const* in, unsigned char* ws, int it) {
    LAS float* scr = (LAS float*)(F.lds + F.wave * 16896);
    const size_t LW = (size_t)DM * DFF;
    if (it < BG_L0) cvt_one<0>(in[5], nullptr, DM, nullptr, (bf16*)(ws + WS_WD), DFF, DM, it, scr, F.lane);
    else if (it < BG_L1) cvt_one<2>(in[11], nullptr, 3 * DM, in[10], (bf16*)(ws + WS_WCI), DM, 3 * DM, it - BG_L0, scr, F.lane);
    else if (it < BG_L2) cvt_one<0>(in[14], nullptr, DM, nullptr, (bf16*)(ws + WS_WCO), DM, DM, it - BG_L1, scr, F.lane);
    else if (it < BG_L3) cvt_one<1>(in[7], in[8], DFF, in[6], (bf16*)(ws + WS_WGU) + 1 * (size_t)2 * DFF * DM, DM, 2 * DFF, it - BG_L2, scr, F.lane);
    else if (it < BG_L4) cvt_one8(in[9], DM, nullptr, pg8::FP8_W_SCALE, ws + WS_WD8 + 1 * SZ_WD8, DFF, DM, it - BG_L3, scr, F.lane);
    else if (it < BG_B1) cvt_one<1>(in[3] + LW, in[4] + LW, DFF, in[2] + DM, (bf16*)(ws + WS_WGU) + 2 * (size_t)2 * DFF * DM, DM, 2 * DFF, it - BG_L4, scr, F.lane);
    else if (it < BG_B2) cvt_one8(in[5] + LW, DM, nullptr, pg8::FP8_W_SCALE, ws + WS_WD8 + 2 * SZ_WD8, DFF, DM, it - BG_B1, scr, F.lane);
    else if (it < BG_B3) cvt_one8(in[16], NQKV, in[15], pg8::FP8_W_SCALE, ws + WS_WQKV8, DM, NQKV, it - BG_B2, scr, F.lane);
    else if (it < BG_B4) cvt_one<0>(in[16] + NHEAD * HD, nullptr, NQKV, in[15], (bf16*)(ws + WS_WQKV) + (size_t)NHEAD * HD * DM, DM, 2 * NKV * HD, it - BG_B3, scr, F.lane);
    else if (it < BG_B5) cvt_one8(in[19], DM, nullptr, pg8::FP8_W_SCALE, ws + WS_WO8, DM, DM, it - BG_B4, scr, F.lane);
    else if (it < BG_B6) cvt_one<1>(in[7] + LW, in[8] + LW, DFF, in[6] + DM, (bf16*)(ws + WS_WGU) + 3 * (size_t)2 * DFF * DM, DM, 2 * DFF, it - BG_B5, scr, F.lane);
    else cvt_one8(in[9] + LW, DM, nullptr, pg8::FP8_W_SCALE, ws + WS_WD8 + 3 * SZ_WD8, DFF, DM, it - BG_B6, scr, F.lane);
}
__device__ __forceinline__ void bg_drain(Frame& F, const float* const* in, unsigned char* ws, volatile LAS unsigned* MISC, int k, int need) {
    unsigned* ctl = (unsigned*)(ws + BG_CTL_OFF);
    __syncthreads();
    if (F.tid == 0) (void)__hip_atomic_fetch_add(ctl + 64 * (k + 1), 1u, __ATOMIC_RELAXED, __HIP_MEMORY_SCOPE_AGENT);
    for (;;) {
        if (F.tid == 0) {
            const int c = (int)__hip_atomic_load(ctl, __ATOMIC_RELAXED, __HIP_MEMORY_SCOPE_AGENT);
            const int d = (int)__hip_atomic_load(ctl + 64 * (k + 1), __ATOMIC_RELAXED, __HIP_MEMORY_SCOPE_AGENT);
            const bool go = c < BG_TOTAL && (c < need || d < F.G);
            MISC[20] = go ? 1u : 0u;
            if (go) MISC[21] = __hip_atomic_fetch_add(ctl, (unsigned)(NWAVES * BG_CH), __ATOMIC_RELAXED, __HIP_MEMORY_SCOPE_AGENT);
        }
        __syncthreads();
        const unsigned go = MISC[20]; const int base = (int)MISC[21];
        __syncthreads();
        if (!go) break;
#pragma unroll 1
        for (int i = 0; i < BG_CH; ++i) { const int it = base + F.wave * BG_CH + i; if (it < BG_TOTAL) bg_item(F, in, ws, it); }
    }
}

typedef float f32x16 __attribute__((ext_vector_type(16)));
template <int NT, class Epi>
__device__ __forceinline__ void skinny_phase(Frame& F, const bf16* A, const bf16* Bt, int K, int n_items, const Epi& E) {
    const int r32 = F.lane & 31, hi = F.lane >> 5, kc = K / 8, k0 = F.wave * kc;
    LAS float* P = (LAS float*)F.lds;
    for (int item = F.bid; item < n_items; item += F.G) {
        f32x16 acc[NT];
        const bf16* bp[NT];
        const bf16* ap = A + (size_t)r32 * K + k0 + hi * 16;
#pragma unroll
        for (int t = 0; t < NT; ++t) { acc[t] = f32x16{}; bp[t] = Bt + (size_t)(E.tile_row(item, t) + r32) * K + k0 + hi * 16; }
        constexpr int U = (NT == 1) ? 4 : 2;
        int kk = 0;
        for (; kk + 32 * U <= kc; kk += 32 * U) {
            bf16x8 a[2 * U], b[NT][2 * U];
#pragma unroll
            for (int u = 0; u < 2 * U; ++u) a[u] = *(const bf16x8*)(ap + kk + hi * (16 * U - 16) + 8 * u);
#pragma unroll
            for (int t = 0; t < NT; ++t)
#pragma unroll
                for (int u = 0; u < 2 * U; ++u) b[t][u] = *(const bf16x8*)(bp[t] + kk + hi * (16 * U - 16) + 8 * u);
            __builtin_amdgcn_sched_barrier(0);
#pragma unroll
            for (int t = 0; t < NT; ++t)
#pragma unroll
                for (int u = 0; u < 2 * U; ++u) acc[t] = __builtin_amdgcn_mfma_f32_32x32x16_bf16(a[u], b[t][u], acc[t], 0, 0, 0);
            __builtin_amdgcn_sched_barrier(0);
        }
        for (; kk < kc; kk += 32) {
            const bf16x8 a0 = *(const bf16x8*)(ap + kk), a1 = *(const bf16x8*)(ap + kk + 8);
#pragma unroll
            for (int t = 0; t < NT; ++t) {
                const bf16x8 b0 = *(const bf16x8*)(bp[t] + kk), b1 = *(const bf16x8*)(bp[t] + kk + 8);
                acc[t] = __builtin_amdgcn_mfma_f32_32x32x16_bf16(a0, b0, acc[t], 0, 0, 0);
                acc[t] = __builtin_amdgcn_mfma_f32_32x32x16_bf16(a1, b1, acc[t], 0, 0, 0);
            }
        }
#pragma unroll
        for (int t = 0; t < NT; ++t)
#pragma unroll
            for (int r = 0; r < 16; ++r) P[((F.wave * NT + t) * 32 + att::crow(r, hi)) * 32 + r32] = acc[t][r];
        __syncthreads();
#pragma unroll
        for (int h = 0; h < 2; ++h) {
            const int e = F.tid + h * 512; float v[NT];
#pragma unroll
            for (int t = 0; t < NT; ++t) { float s = 0.f;
#pragma unroll
                for (int w = 0; w < NWAVES; ++w) s += P[(w * NT + t) * 1024 + e];
                v[t] = s; }
            E.apply(item, e >> 5, e & 31, v);
        }
        __syncthreads();
    }
}
template <class Epi>
__device__ __forceinline__ void skinny_phase8(Frame& F, const unsigned char* A, const unsigned char* Bt, int K, int n_items, const Epi& E) {
    typedef int i32x8 __attribute__((ext_vector_type(8))); typedef int i32x4 __attribute__((ext_vector_type(4)));
    const int r32 = F.lane & 31, hi = F.lane >> 5, nst = K / 64, base = nst / 8, rem = nst - base * 8;
    const int st0 = F.wave * base + (F.wave < rem ? F.wave : rem), nmy = base + (F.wave < rem ? 1 : 0);
    LAS float* P = (LAS float*)F.lds;
    for (int item = F.bid; item < n_items; item += F.G) {
        f32x16 acc = f32x16{};
        const unsigned char* ap = A + (size_t)r32 * K + (size_t)st0 * 64 + hi * 32;
        const unsigned char* bp = Bt + (size_t)(E.tile_row(item, 0) + r32) * K + (size_t)st0 * 64 + hi * 32;
        int s = 0;
        for (; s + 4 <= nmy; s += 4) {
            i32x4 a[8], b[8];
#pragma unroll
            for (int u = 0; u < 4; ++u) { a[2 * u] = *(const i32x4*)(ap + (s + u) * 64); a[2 * u + 1] = *(const i32x4*)(ap + (s + u) * 64 + 16); b[2 * u] = *(const i32x4*)(bp + (s + u) * 64); b[2 * u + 1] = *(const i32x4*)(bp + (s + u) * 64 + 16); }
            __builtin_amdgcn_sched_barrier(0);
#pragma unroll
            for (int u = 0; u < 4; ++u) asm volatile("v_mfma_f32_32x32x64_f8f6f4 %0, %1, %2, %0" : "+v"(acc) : "v"((i32x8){a[2*u][0], a[2*u][1], a[2*u][2], a[2*u][3], a[2*u+1][0], a[2*u+1][1], a[2*u+1][2], a[2*u+1][3]}), "v"((i32x8){b[2*u][0], b[2*u][1], b[2*u][2], b[2*u][3], b[2*u+1][0], b[2*u+1][1], b[2*u+1][2], b[2*u+1][3]}));
            __builtin_amdgcn_sched_barrier(0);
        }
        for (; s < nmy; ++s) {
            const i32x4 a0 = *(const i32x4*)(ap + s * 64), a1 = *(const i32x4*)(ap + s * 64 + 16), b0 = *(const i32x4*)(bp + s * 64), b1 = *(const i32x4*)(bp + s * 64 + 16);
            asm volatile("v_mfma_f32_32x32x64_f8f6f4 %0, %1, %2, %0" : "+v"(acc) : "v"((i32x8){a0[0], a0[1], a0[2], a0[3], a1[0], a1[1], a1[2], a1[3]}), "v"((i32x8){b0[0], b0[1], b0[2], b0[3], b1[0], b1[1], b1[2], b1[3]}));
        }
        asm volatile("s_nop 15\n\ts_nop 15\n\ts_nop 7" : "+v"(acc));
#pragma unroll
        for (int r = 0; r < 16; ++r) P[(F.wave * 32 + att::crow(r, hi)) * 32 + r32] = acc[r];
        __syncthreads();
#pragma unroll
        for (int h = 0; h < 2; ++h) {
            const int e = F.tid + h * 512; float v[1]; float sm = 0.f;
#pragma unroll
            for (int w = 0; w < NWAVES; ++w) sm += P[w * 1024 + e];
            v[0] = sm;
            E.apply(item, e >> 5, e & 31, v);
        }
        __syncthreads();
    }
}
struct SkResid {
    const float* hin; float* h; bf16* hb; rss_t* rss_out; float scale;
    __device__ __forceinline__ int tile_row(int item, int) const { return item * 32; }
    __device__ __forceinline__ void apply(int item, int row, int col, const float (&v)[1]) const {
        const size_t o = (size_t)(MREAL + row) * DM + item * 32 + col;
        const float x = hin[o] + scale * v[0];
        h[o] = x; hb[o] = (bf16)f2bf(x);
        float ss = x * x;
#pragma unroll
        for (int d = 1; d < 32; d <<= 1) ss += __shfl_xor(ss, d);
        if (col == 0) rss_add(rss_out + MREAL + row, ss);
    }
};
struct SkConvIn {
    bf16* bbuf; bf16* ubuf; const rss_t* rss;
    __device__ __forceinline__ int tile_row(int item, int t) const { const int ch = item * 32; return t == 0 ? 2 * DM + ch : (ch >> 7) * 256 + (t == 2 ? 128 : 0) + (ch & 127); }
    __device__ __forceinline__ void apply(int item, int row, int col, const float (&v)[3]) const {
        const float rs = rstd_from_ss(rss[MREAL + row]); const size_t o = (size_t)(MREAL + row) * DM + item * 32 + col;
        bbuf[o] = (bf16)f2bf(v[0] * rs); ubuf[o] = (bf16)f2bf((v[1] * rs) * (v[2] * rs));
    }
};
struct SkKV {
    bf16* k; bf16* v; const rss_t* rss;
    __device__ __forceinline__ int tile_row(int item, int) const { return item * 32; }
    __device__ __forceinline__ void apply(int item, int row, int col, const float (&x)[1]) const {
        const float rs = rstd_from_ss(rss[MREAL + row]); const int kvr = (row >> 4) * KVROWS + (row & 15);
        bf16* dst = item < 32 ? k : v; const int c = (item & 31) * 32 + col;
        dst[(size_t)kvr * (NKV * HD) + c] = (bf16)f2bf(x[0] * rs);
    }
};

__device__ __forceinline__ void rows_init(Frame& F, const float* x, const float* meta, float* h, bf16* hb, rss_t* rss0) {
    const int gw = F.bid * NWAVES + F.wave, NGW = F.G * NWAVES;
    for (int r = gw; r < MVALID; r += NGW) {
        const float* src = r < MREAL ? x + (size_t)r * DM : meta + (size_t)((r - MREAL) & (NMETA - 1)) * DM;
        float ss = 0.f;
#pragma unroll
        for (int j = 0; j < 16; ++j) {
            const f32x4 v = *(const GAS f32x4*)(src + (size_t)(64 * j + F.lane) * 4);
            ss += (v.x * v.x + v.y * v.y) + (v.z * v.z + v.w * v.w);
            const unsigned long long pk = (unsigned long long)pg8::cvt_pk_bf16(v.x, v.y) | ((unsigned long long)pg8::cvt_pk_bf16(v.z, v.w) << 32);
            *(GAS unsigned long long*)(hb + (size_t)r * DM + (size_t)(64 * j + F.lane) * 4) = pk;
            if (r >= MREAL) *(GAS f32x4*)(h + (size_t)r * DM + (size_t)(64 * j + F.lane) * 4) = v;
        }
        ss = wave_sum(ss);
        if (F.lane == 0) rss0[r] = rss_fix(ss);
    }
}
__device__ __forceinline__ void seq_neighbours(int r, int& prev, int& next) {
    if (r < MREAL) { const int b = r >> 13, t = r & (SEQ - 1); prev = t > 0 ? r - 1 : MREAL + b * NMETA + (NMETA - 1); next = t < SEQ - 1 ? r + 1 : -1; }
    else { const int b = (r - MREAL) >> 4, j = (r - MREAL) & 15; prev = j > 0 ? r - 1 : -1; next = j < NMETA - 1 ? r + 1 : b * SEQ; }
}
__device__ __forceinline__ void conv_pass(Frame& F, const bf16* bbuf, const bf16* ubuf, const float* cw, const float* cb, bf16* cv) {
    const int gt = F.bid * (NWAVES * 64) + F.tid, NGT = F.G * NWAVES * 64;
    for (int it = gt; it < (MVALID / 8) * (DM / 8); it += NGT) {
        const int r0 = (it >> 9) * 8, c = (it & 511) * 8; int prev, next, dummy; seq_neighbours(r0, prev, dummy); seq_neighbours(r0 + 7, dummy, next);
        const bf16x8 zero = {0, 0, 0, 0, 0, 0, 0, 0};
        bf16x8 uu[10], bv[8];
        uu[0] = prev >= 0 ? *(const GAS bf16x8*)(ubuf + (size_t)prev * DM + c) : zero;
#pragma unroll
        for (int k = 0; k < 8; ++k) { uu[k + 1] = *(const GAS bf16x8*)(ubuf + (size_t)(r0 + k) * DM + c); bv[k] = *(const GAS bf16x8*)(bbuf + (size_t)(r0 + k) * DM + c); }
        uu[9] = next >= 0 ? *(const GAS bf16x8*)(ubuf + (size_t)next * DM + c) : zero;
        float w0[8], w1[8], w2[8], bb[8];
#pragma unroll
        for (int q = 0; q < 2; ++q) {
            const f32x4 a0 = *(const GAS f32x4*)(cw + c + 4 * q), a1 = *(const GAS f32x4*)(cw + DM + c + 4 * q), a2 = *(const GAS f32x4*)(cw + 2 * DM + c + 4 * q), a3 = *(const GAS f32x4*)(cb + c + 4 * q);
#pragma unroll
            for (int j = 0; j < 4; ++j) { w0[4 * q + j] = a0[j]; w1[4 * q + j] = a1[j]; w2[4 * q + j] = a2[j]; bb[4 * q + j] = a3[j]; }
        }
#pragma unroll
        for (int k = 0; k < 8; ++k) {
            float o[8];
#pragma unroll
            for (int e = 0; e < 8; ++e)
                o[e] = bf2f((unsigned short)bv[k][e]) * (w0[e] * bf2f((unsigned short)uu[k][e]) + w1[e] * bf2f((unsigned short)uu[k + 1][e]) + w2[e] * bf2f((unsigned short)uu[k + 2][e]) + bb[e]);
            v4u w; w.x = pg8::cvt_pk_bf16(o[0], o[1]); w.y = pg8::cvt_pk_bf16(o[2], o[3]); w.z = pg8::cvt_pk_bf16(o[4], o[5]); w.w = pg8::cvt_pk_bf16(o[6], o[7]);
            *(GAS v4u*)(cv + (size_t)(r0 + k) * DM + c) = w;
        }
    }
}
__device__ __forceinline__ void rope_head(bf16* p, const float* gain, float rowpos, float colpos, int i) {
    const float x0 = bf2f(p[i]), x1 = bf2f(p[32 + i]), x2 = bf2f(p[64 + i]), x3 = bf2f(p[96 + i]);
    float ss = (x0 * x0 + x1 * x1) + (x2 * x2 + x3 * x3);
#pragma unroll
    for (int d = 1; d < 32; d <<= 1) ss += __shfl_xor(ss, d);
    const float rs = __builtin_amdgcn_rsqf(ss * (1.0f / (float)HD) + RMS_EPS);
    const float y0 = x0 * rs * gain[i], y1 = x1 * rs * gain[32 + i], y2 = x2 * rs * gain[64 + i], y3 = x3 * rs * gain[96 + i];
    const float inv_freq = __builtin_amdgcn_exp2f(-(float)i * 0.41524101186092029f);
    const float ar = rowpos * inv_freq * 0.15915494309189535f, ac = colpos * inv_freq * 0.15915494309189535f;
    const float cr = __builtin_amdgcn_cosf(ar), sr = __builtin_amdgcn_sinf(ar), cc = __builtin_amdgcn_cosf(ac), sc = __builtin_amdgcn_sinf(ac);
    p[i] = (bf16)f2bf(y0 * cr - y1 * sr); p[32 + i] = (bf16)f2bf(y1 * cr + y0 * sr);
    p[64 + i] = (bf16)f2bf(y2 * cc - y3 * sc); p[96 + i] = (bf16)f2bf(y3 * cc + y2 * sc);
}
__device__ __forceinline__ void k_prep_pass(Frame& F, bf16* K, const float* kg) {
    const int ghw = (F.bid * NWAVES + F.wave) * 2 + (F.lane >> 5), NGHW = F.G * NWAVES * 2, i = F.lane & 31;
    constexpr int NK = NB * (NMETA + SEQ) * NKV;
    static_assert(NK % 2 == 0, "both half-waves of a wave leave the loop together");
    for (int j = ghw; j < NK; j += NGHW) {
        const int key = j >> 3, g = j & 7, b = key / (NMETA + SEQ), p = key - b * (NMETA + SEQ);
        const int kvr = b * KVROWS + (p < NMETA ? p : 64 + (p - NMETA));
        const float rowpos = p < NMETA ? -1.f : (float)((p - NMETA) >> 6), colpos = p < NMETA ? (float)p : (float)((p - NMETA) & 63);
        rope_head(K + (size_t)kvr * (NKV * HD) + g * HD, kg, rowpos, colpos, i);
    }
}
template <bool KEEP16>
__device__ __forceinline__ void kv_prep8_pass(Frame& F, bf16* K, const bf16* V, const float* kg, unsigned char* K8, unsigned char* VT8) {
    {   const int ghw = (F.bid * NWAVES + F.wave) * 2 + (F.lane >> 5), NGHW = F.G * NWAVES * 2, i = F.lane & 31;
        constexpr int NK = NB * (NMETA + SEQ) * NKV;
        for (int j = ghw; j < NK; j += NGHW) {
            const int key = j >> 3, g = j & 7, b = key / (NMETA + SEQ), p = key - b * (NMETA + SEQ);
            const int kvr = b * KVROWS + (p < NMETA ? p : 64 + (p - NMETA));
            const float rowpos = p < NMETA ? -1.f : (float)((p - NMETA) >> 6), colpos = p < NMETA ? (float)p : (float)((p - NMETA) & 63);
            bf16* kp = K + (size_t)kvr * (NKV * HD) + g * HD; unsigned char* k8 = K8 + (size_t)kvr * (NKV * HD) + g * HD;
            const float x0 = bf2f(kp[i]), x1 = bf2f(kp[32 + i]), x2 = bf2f(kp[64 + i]), x3 = bf2f(kp[96 + i]);
            float ss = (x0 * x0 + x1 * x1) + (x2 * x2 + x3 * x3);
#pragma unroll
            for (int d = 1; d < 32; d <<= 1) ss += __shfl_xor(ss, d);
            const float rs = __builtin_amdgcn_rsqf(ss * (1.0f / (float)HD) + RMS_EPS);
            const float y0 = x0 * rs * kg[i], y1 = x1 * rs * kg[32 + i], y2 = x2 * rs * kg[64 + i], y3 = x3 * rs * kg[96 + i];
            const float inv_freq = __builtin_amdgcn_exp2f(-(float)i * 0.41524101186092029f);
            const float ar = rowpos * inv_freq * 0.15915494309189535f, ac = colpos * inv_freq * 0.15915494309189535f;
            const float cr = __builtin_amdgcn_cosf(ar), sr = __builtin_amdgcn_sinf(ar), cc = __builtin_amdgcn_cosf(ac), sc = __builtin_amdgcn_sinf(ac);
            const float o0 = y0 * cr - y1 * sr, o1 = y1 * cr + y0 * sr, o2 = y2 * cc - y3 * sc, o3 = y3 * cc + y2 * sc;
            if (KEEP16) { kp[i] = (bf16)f2bf(o0); kp[32 + i] = (bf16)f2bf(o1); kp[64 + i] = (bf16)f2bf(o2); kp[96 + i] = (bf16)f2bf(o3); }
            const float s8 = att8::FP8_KQ_SCALE;
            k8[att8::k8_pos(i)] = (unsigned char)(att8::pk4(att8::sat8(o0 * s8), 0.f, 0.f, 0.f) & 0xff); k8[att8::k8_pos(32 + i)] = (unsigned char)(att8::pk4(att8::sat8(o1 * s8), 0.f, 0.f, 0.f) & 0xff);
            k8[att8::k8_pos(64 + i)] = (unsigned char)(att8::pk4(att8::sat8(o2 * s8), 0.f, 0.f, 0.f) & 0xff); k8[att8::k8_pos(96 + i)] = (unsigned char)(att8::pk4(att8::sat8(o3 * s8), 0.f, 0.f, 0.f) & 0xff);
        }
    }
    {   const int gw = F.bid * NWAVES + F.wave, NGW = F.G * NWAVES; constexpr int NTILE = KVROWS / 64, NITEM = NB * NKV * NTILE * 2;
        for (int it = gw; it < NITEM; it += NGW) {
            const int dh = it & 1, tile = (it >> 1) % NTILE, bk = (it >> 1) / NTILE, b = bk >> 3, g = bk & 7, d = dh * 64 + F.lane;
            const bf16* vp = V + (size_t)(b * KVROWS + tile * 64) * (NKV * HD) + g * HD + d;
            unsigned char* op = VT8 + ((size_t)(bk * NTILE + tile) * 128 + d) * 64;
#pragma unroll
            for (int q = 0; q < 4; ++q) { v4u w;
#pragma unroll
                for (int c = 0; c < 4; ++c) { float x[4];
#pragma unroll
                    for (int e = 0; e < 4; ++e) { const int key = att8::v8_key(16 * q + 4 * c + e); x[e] = (tile == 0 && key >= NMETA) ? 0.f : att8::sat8(bf2f(vp[(size_t)key * (NKV * HD)]) * att8::FP8_V_SCALE); }
                    w[c] = att8::pk4(x[0], x[1], x[2], x[3]); }
                *(GAS v4u*)(op + 16 * q) = w; }
        }
    }
}
__device__ __forceinline__ void final_norm_pass(Frame& F, const float* h, const rss_t* rss, const float* g, float* out) {
    const int gw = F.bid * NWAVES + F.wave, NGW = F.G * NWAVES;
    for (int r = gw; r < MREAL; r += NGW) {
        const float rs = rstd_from_ss(rss[r]);
#pragma unroll
        for (int j = 0; j < 16; ++j) { const size_t o = (size_t)(64 * j + F.lane) * 4;
            const f32x4 v = *(const GAS f32x4*)(h + (size_t)r * DM + o), gv = *(const GAS f32x4*)(g + o);
            *(GAS f32x4*)(out + (size_t)r * DM + o) = v * rs * gv; }
    }
}

#ifndef MK_ONE_LAUNCH
#define MK_ONE_LAUNCH 1
#endif
#ifndef FP8_DOWN_MASK
#define FP8_DOWN_MASK 0xE
#endif
#ifndef FP8_QKV
#define FP8_QKV 1
#endif
#ifndef FP8_ATTN
#define FP8_ATTN 1
#endif
#ifndef FP8_WO
#define FP8_WO 1
#endif
#ifndef BG_DEFER
#define BG_DEFER 1
#endif
constexpr int N_PHASES = 17;
struct Args { const float* in[21]; float* out; unsigned char* ws; int ph_lo, ph_hi; };
static_assert(sizeof(Args) == 192, "Args has no padding bytes");

__global__ void __launch_bounds__(NWAVES * 64, 2) fwd_kernel(Args args) {
    extern __shared__ __attribute__((aligned(16))) unsigned char lds_raw[];
    Frame F;
    F.lds = (LAS unsigned char*)lds_raw;
    F.tid = threadIdx.x; F.lane = F.tid & 63; F.wave = __builtin_amdgcn_readfirstlane(F.tid >> 6);
    F.G = gridDim.x; F.bid = blockIdx.x;
    volatile LAS unsigned* MISC = (volatile LAS unsigned*)(F.lds + MISC_OFF);
    unsigned char* ws = args.ws;
    gu32* ctl = (gu32*)ws;
    for (int u = F.tid; u < (LDS_BYTES - 139264) / 4; u += NWAVES * 64) ((LAS unsigned*)(F.lds + 139264))[u] = 0u;
    __syncthreads();
    XcdBarrier bar; bar.bar = (unsigned*)(ctl + CW_BAR); bar.x = 0; bar.st = nullptr;
    if (MK_ONE_LAUNCH) bar = xcd_barrier_post((unsigned*)(ctl + CW_BAR), MISC + 8, F.tid == 0);
    const int lo = args.ph_lo, hi = args.ph_hi;
#define REFRAME_(F) ((F).lane = att::lane_id_asm(), (F).tid = (F).wave * 64 + (F).lane)
#define IN(k) (lo <= (k) && (k) < hi && (REFRAME_(F), true))
#define SEAM(k) do { if (MK_ONE_LAUNCH && (lo <= (k) + 1 && (k) + 1 < hi)) xcd_barrier(bar, (REFRAME_(F), F.tid == 0)); } while (0)
#define PH_BEGIN(k) if (IN(k)) {
#define BG_NEED(k) ((k) >= 14 ? BG_TOTAL : (k) == 13 ? BG_B6 : (k) == 12 ? BG_B5 : ((k) == 11 || (k) == 10 || (k) == 9) ? BG_B4 : (k) == 8 ? BG_B2 : (k) == 7 ? BG_B1 : (k) == 6 ? BG_L4 : (k) == 5 ? BG_L3 : ((k) == 4 || (k) == 3) ? BG_L2 : (k) == 2 ? BG_L1 : (k) == 1 ? BG_L0 : 0)
#define BG_SITE(k) ((k) <= 10 || (k) == 12 || (k) == 13 || (k) == 14)
#define PH_END(k) if (BG_DEFER && MK_ONE_LAUNCH && BG_SITE(k)) { REFRAME_(F); bg_drain(F, args.in, ws, MISC, (k), BG_NEED(k)); } SEAM(k); }

    const float* x = args.in[0]; const float* meta = args.in[1];
    const float* conv_norm = args.in[10]; const float* conv_w_in = args.in[11]; const float* conv_w = args.in[12]; const float* conv_b = args.in[13]; const float* conv_w_out = args.in[14];
    const float* attn_norm = args.in[15]; const float* attn_w_qkv = args.in[16]; const float* q_gain = args.in[17]; const float* k_gain = args.in[18]; const float* attn_w_o = args.in[19];
    const float* final_g = args.in[20];
    bf16* WGU = (bf16*)(ws + WS_WGU); bf16* WD = (bf16*)(ws + WS_WD); bf16* WCI = (bf16*)(ws + WS_WCI); bf16* WCO = (bf16*)(ws + WS_WCO); bf16* WQKV = (bf16*)(ws + WS_WQKV); bf16* WO = (bf16*)(ws + WS_WO);
    float* H = (float*)(ws + WS_H); bf16* HB = (bf16*)(ws + WS_HB); bf16* ACT = (bf16*)(ws + WS_ACT); bf16* BB = (bf16*)(ws + WS_BB); bf16* UB = (bf16*)(ws + WS_UB);
    bf16* QB = (bf16*)(ws + WS_Q); bf16* KB = (bf16*)(ws + WS_K); bf16* VB = (bf16*)(ws + WS_V); bf16* AUX = (bf16*)(ws + WS_AUX);
    rss_t* RSS = (rss_t*)(ws + RSS_OFF);
#define RSSK(k) (RSS + (size_t)(k) * MPAD)
    constexpr size_t NWGU = (size_t)2 * DFF * DM, NWD = (size_t)DM * DFF;
#define D8(f) (((FP8_DOWN_MASK >> (f)) & 1) != 0)
    unsigned char* HB8 = ws + WS_HB8; unsigned char* K8 = ws + WS_K8; unsigned char* VT8 = ws + WS_VT8;

    PH_BEGIN(0)
        cvt_matrix<1>(F, args.in[3] + (size_t)0 * DM * DFF, args.in[4] + (size_t)0 * DM * DFF, DFF, args.in[2] + 0 * DM, WGU + 0 * NWGU, DM, 2 * DFF);
        if (D8(0)) cvt_matrix8(F, args.in[5] + (size_t)0 * DFF * DM, DM, nullptr, pg8::FP8_W_SCALE, ws + WS_WD8 + 0 * SZ_WD8, DFF, DM);
        if (!BG_DEFER && (!D8(0))) cvt_matrix<0>(F, args.in[5] + (size_t)0 * DFF * DM, nullptr, DM, nullptr, WD + 0 * NWD, DFF, DM);
        if (!BG_DEFER) { cvt_matrix<1>(F, args.in[7] + (size_t)0 * DM * DFF, args.in[8] + (size_t)0 * DM * DFF, DFF, args.in[6] + 0 * DM, WGU + 1 * NWGU, DM, 2 * DFF); }
        if (!BG_DEFER && (D8(1))) cvt_matrix8(F, args.in[9] + (size_t)0 * DFF * DM, DM, nullptr, pg8::FP8_W_SCALE, ws + WS_WD8 + 1 * SZ_WD8, DFF, DM);
        if (!D8(1)) cvt_matrix<0>(F, args.in[9] + (size_t)0 * DFF * DM, nullptr, DM, nullptr, WD + 1 * NWD, DFF, DM);
        if (!BG_DEFER) cvt_matrix<1>(F, args.in[3] + (size_t)1 * DM * DFF, args.in[4] + (size_t)1 * DM * DFF, DFF, args.in[2] + 1 * DM, WGU + 2 * NWGU, DM, 2 * DFF);
        if (D8(2) && !BG_DEFER) cvt_matrix8(F, args.in[5] + (size_t)1 * DFF * DM, DM, nullptr, pg8::FP8_W_SCALE, ws + WS_WD8 + 2 * SZ_WD8, DFF, DM);
        if (!D8(2)) cvt_matrix<0>(F, args.in[5] + (size_t)1 * DFF * DM, nullptr, DM, nullptr, WD + 2 * NWD, DFF, DM);
        if (!BG_DEFER) cvt_matrix<1>(F, args.in[7] + (size_t)1 * DM * DFF, args.in[8] + (size_t)1 * DM * DFF, DFF, args.in[6] + 1 * DM, WGU + 3 * NWGU, DM, 2 * DFF);
        if (D8(3) && !BG_DEFER) cvt_matrix8(F, args.in[9] + (size_t)1 * DFF * DM, DM, nullptr, pg8::FP8_W_SCALE, ws + WS_WD8 + 3 * SZ_WD8, DFF, DM);
        if (!D8(3)) cvt_matrix<0>(F, args.in[9] + (size_t)1 * DFF * DM, nullptr, DM, nullptr, WD + 3 * NWD, DFF, DM);
        if (!BG_DEFER) { cvt_matrix<2>(F, conv_w_in, nullptr, 3 * DM, conv_norm, WCI, DM, 3 * DM); }
        if (!BG_DEFER) { cvt_matrix<0>(F, conv_w_out, nullptr, DM, nullptr, WCO, DM, DM); }
        if (BG_DEFER) { static_assert(!BG_DEFER || (D8(1) && D8(2) && D8(3) && !D8(0) && FP8_QKV && FP8_WO), "the background queue is written for this configuration"); }
        else if (FP8_QKV) {
            cvt_matrix8(F, attn_w_qkv, NQKV, attn_norm, pg8::FP8_W_SCALE, ws + WS_WQKV8, DM, NQKV);
            cvt_matrix<0>(F, attn_w_qkv + NHEAD * HD, nullptr, NQKV, attn_norm, WQKV + (size_t)NHEAD * HD * DM, DM, 2 * NKV * HD);
        } else cvt_matrix<0>(F, attn_w_qkv, nullptr, NQKV, attn_norm, WQKV, DM, NQKV);
        if (!BG_DEFER) { if (FP8_WO) cvt_matrix8(F, attn_w_o, DM, nullptr, pg8::FP8_W_SCALE, ws + WS_WO8, DM, DM); else cvt_matrix<0>(F, attn_w_o, nullptr, DM, nullptr, WO, DM, DM); }
        rows_init(F, x, meta, H, HB, RSSK(0));
    PH_END(0)

#define FFN_UP(ph, f, rows, rin) PH_BEGIN(ph) \
        pg8::Gemm g{HB, WGU + (size_t)(f) * NWGU, (rows), 2 * DFF, DM}; pg8::StaticOrder S; S.init((rows), 2 * DFF, F.G, F.bid); \
        pg8::EpiSwiGLU<D8(f)> E{ACT, RSSK(rin)}; \
        pg8::gemm_phase<pg8::EpiSwiGLU<D8(f)>, pg8::StaticOrder, true, true>(F.lds, g, S, E, F.wave); \
        PH_END(ph)
#define FFN_DOWN(ph, f, basep, hbp, hb8p, rout, with_meta) PH_BEGIN(ph) \
        pg8::Gemm g{ACT, D8(f) ? (const bf16*)(ws + WS_WD8 + (f) * SZ_WD8) : WD + (size_t)(f) * NWD, MREAL, DM, DFF}; pg8::StaticOrder S; S.init(MREAL, DM, F.G, F.bid); \
        pg8::EpiResid E{(basep), H, (hbp), (hb8p), RSSK(rout), D8(f) ? 0.5f / (pg8::FP8_ACT_SCALE * pg8::FP8_W_SCALE) : 0.5f}; \
        pg8::gemm_phase<pg8::EpiResid, pg8::StaticOrder, true, true, D8(f)>(F.lds, g, S, E, F.wave); \
        if (with_meta) { SkResid SE{H, H, HB, RSSK(rout), D8(f) ? 0.5f / (pg8::FP8_ACT_SCALE * pg8::FP8_W_SCALE) : 0.5f}; \
            if (D8(f)) skinny_phase8<SkResid>(F, (const unsigned char*)ACT + (size_t)MREAL * DFF, ws + WS_WD8 + (f) * SZ_WD8, DFF, DM / 32, SE); \
            else skinny_phase<1, SkResid>(F, ACT + (size_t)MREAL * DFF, WD + (size_t)(f) * NWD, DFF, DM / 32, SE); } \
        PH_END(ph)

    FFN_UP(1, 0, MPAD, 0)
    FFN_DOWN(2, 0, x, HB, (unsigned char*)nullptr, 1, true)
    PH_BEGIN(3)
        pg8::Gemm g{HB, WCI, MREAL, 3 * DM, DM}; pg8::StaticOrder S; S.init(MREAL, 3 * DM, F.G, F.bid);
        pg8::EpiConvIn E{BB, UB, RSSK(1)};
        pg8::gemm_phase<pg8::EpiConvIn, pg8::StaticOrder, true, true>(F.lds, g, S, E, F.wave);
        SkConvIn SE{BB, UB, RSSK(1)}; skinny_phase<3, SkConvIn>(F, HB + (size_t)MREAL * DM, WCI, DM, DM / 32, SE);
    PH_END(3)
    PH_BEGIN(4) conv_pass(F, BB, UB, conv_w, conv_b, AUX); PH_END(4)
    PH_BEGIN(5)
        pg8::Gemm g{AUX, WCO, MREAL, DM, DM}; pg8::StaticOrder S; S.init(MREAL, DM, F.G, F.bid);
        pg8::EpiResid E{H, H, HB, (unsigned char*)nullptr, RSSK(2), 1.0f};
        pg8::gemm_phase<pg8::EpiResid, pg8::StaticOrder, true, true>(F.lds, g, S, E, F.wave);
        SkResid SE{H, H, HB, RSSK(2), 1.0f}; skinny_phase<1, SkResid>(F, AUX + (size_t)MREAL * DM, WCO, DM, DM / 32, SE);
    PH_END(5)
    FFN_UP(6, 1, MPAD, 2)
    FFN_DOWN(7, 1, H, HB, (unsigned char*)nullptr, 3, true)
    FFN_UP(8, 2, MPAD, 3)
    FFN_DOWN(9, 2, H, HB, FP8_QKV ? HB8 : (unsigned char*)nullptr, 4, true)
    PH_BEGIN(10)
        pg8::Gemm g{FP8_QKV ? (const bf16*)HB8 : HB, FP8_QKV ? (const bf16*)(ws + WS_WQKV8) : WQKV, MREAL, NQKV, DM}; pg8::StaticOrder S; S.init(MREAL, NQKV, F.G, F.bid);
        pg8::EpiQKV E{QB, KB, VB, RSSK(4), FP8_QKV ? 1.0f / (pg8::FP8_H_SCALE * pg8::FP8_W_SCALE) : 1.0f};
        pg8::gemm_phase<pg8::EpiQKV, pg8::StaticOrder, true, true, FP8_QKV != 0>(F.lds, g, S, E, F.wave);
        SkKV SE{KB, VB, RSSK(4)}; skinny_phase<1, SkKV>(F, HB + (size_t)MREAL * DM, WQKV + (size_t)NHEAD * HD * DM, DM, 2 * NKV * HD / 32, SE);
        for (int i = F.bid * (NWAVES * 64) + F.tid; i < NB * 48 * (NKV * HD / 8); i += F.G * NWAVES * 64) {
            const int b = i / (48 * 128), r = (i / 128) % 48, c = (i & 127) * 8; const size_t o = (size_t)(b * KVROWS + NMETA + r) * (NKV * HD) + c;
            *(GAS v4u*)(KB + o) = (v4u){0u, 0u, 0u, 0u}; *(GAS v4u*)(VB + o) = (v4u){0u, 0u, 0u, 0u};
        }
    PH_END(10)
    PH_BEGIN(11) if (FP8_ATTN) kv_prep8_pass<false>(F, KB, VB, k_gain, K8, VT8); else k_prep_pass(F, KB, k_gain); PH_END(11)
    PH_BEGIN(12)
        constexpr int NUNITS = NB * NHEAD * (SEQ / 256);
        const bool xcd_deal = (F.G == 256);
        for (int i = 0;; ++i) {
            int un;
            if (xcd_deal) { if (i >= 8) break; un = (F.bid & 7) * 256 + i * 32 + (F.bid >> 3); } else { un = i * F.G + F.bid; if (un >= NUNITS) break; }
            const int grp = un >> 7, rem = un & 127, b = grp >> 3, kvh = grp & 7, hq = kvh * 4 + (rem >> 5), qb = rem & 31;
            const size_t qoff = (size_t)(b * SEQ + qb * 256) * DM + hq * HD, koff = (size_t)(b * KVROWS) * (NKV * HD) + kvh * HD;
            if (FP8_ATTN) att8::attn_unit8(QB + qoff, K8 + koff, VT8 + (size_t)grp * (KVROWS / 64) * 8192, (unsigned char*)AUX + qoff, (char*)lds_raw, F.lds, F.wave, q_gain, qb * 256);
            else att::attn_unit<FP8_WO != 0>(QB + qoff, KB + koff, VB + koff, FP8_WO ? (void*)((unsigned char*)AUX + qoff) : (void*)(AUX + qoff), (char*)lds_raw, F.wave, q_gain, qb * 256);
        }
    PH_END(12)
    PH_BEGIN(13)
        pg8::Gemm g{AUX, FP8_WO ? (const bf16*)(ws + WS_WO8) : WO, MREAL, DM, DM}; pg8::StaticOrder S; S.init(MREAL, DM, F.G, F.bid);
        pg8::EpiResid E{H, H, HB, (unsigned char*)nullptr, RSSK(5), FP8_WO ? 1.0f / (pg8::FP8_O_SCALE * pg8::FP8_W_SCALE) : 1.0f};
        pg8::gemm_phase<pg8::EpiResid, pg8::StaticOrder, true, true, FP8_WO != 0>(F.lds, g, S, E, F.wave);
    PH_END(13)
    FFN_UP(14, 3, MREAL, 5)
    FFN_DOWN(15, 3, H, (bf16*)nullptr, (unsigned char*)nullptr, 6, false)
    PH_BEGIN(16) final_norm_pass(F, H, RSSK(6), final_g, args.out); PH_END(16)
#undef IN
#undef SEAM
}

extern "C" void kernel_launch(void* const* d_in, const int* in_sizes, int n_in, void* d_out, int out_size, void* d_ws, size_t ws_size, hipStream_t stream) {
    static int grid = 0;
    if (grid == 0) {
        if (n_in != 21 || in_sizes[0] != MREAL * DM || out_size != MREAL * DM || ws_size < WS_END) {
            fprintf(stderr, "kernel_launch: built for 21 inputs, x/out of %d floats, >= %zu bytes of workspace; got n_in %d, in0 %d, out %d, ws %zu; nothing launched\n", MREAL * DM, (size_t)WS_END, n_in, n_in > 0 ? in_sizes[0] : -1, out_size, ws_size);
            grid = -1; return; }
        int dev = 0, cus = 0, per_cu = 0;
        if (hipGetDevice(&dev) != hipSuccess || hipDeviceGetAttribute(&cus, hipDeviceAttributeMultiprocessorCount, dev) != hipSuccess) { fprintf(stderr, "kernel_launch: device query failed\n"); grid = -1; return; }
        if (hipFuncSetAttribute((const void*)fwd_kernel, hipFuncAttributeMaxDynamicSharedMemorySize, LDS_BYTES) != hipSuccess) { fprintf(stderr, "kernel_launch: hipFuncSetAttribute failed\n"); grid = -1; return; }
        if (hipOccupancyMaxActiveBlocksPerMultiprocessor(&per_cu, (const void*)fwd_kernel, NWAVES * 64, LDS_BYTES) != hipSuccess || per_cu < 1)
            fprintf(stderr, "kernel_launch: note: occupancy query reports %d workgroups per CU\n", per_cu);
        (void)hipGetLastError();
        grid = cus;
    }
    if (grid < 0) return;
    if (hipMemsetAsync(d_ws, 0, CTL_ZERO_BYTES, stream) != hipSuccess) { fprintf(stderr, "kernel_launch: hipMemsetAsync failed\n"); return; }
    Args a{};
    for (int i = 0; i < 21; ++i) a.in[i] = (const float*)d_in[i];
    a.out = (float*)d_out; a.ws = (unsigned char*)d_ws;
#if MK_ONE_LAUNCH
    a.ph_lo = 0; a.ph_hi = N_PHASES;
    hipLaunchKernelGGL(fwd_kernel, dim3(grid), dim3(NWAVES * 64), LDS_BYTES, stream, a);
#else
    for (int p = 0; p < N_PHASES; ++p) { a.ph_lo = p; a.ph_hi = p + 1; hipLaunchKernelGGL(fwd_kernel, dim3(grid), dim3(NWAVES * 64), LDS_BYTES, stream, a); }
#endif
    const hipError_t le = hipPeekAtLastError();
    if (le != hipSuccess) fprintf(stderr, "kernel_launch: launch failed: %s\n", hipGetErrorName(le));
}
```

```cpp
#include <hip/hip_runtime.h>
#include <hip/hip_bf16.h>
#include <cstdio>
#include <cstdint>

constexpr int DM = 4096, DFF = 11008, SEQ = 8192, NB = 2, NMETA = 16, NHEAD = 32, NKV = 8, HD = 128;
constexpr int MREAL = NB * SEQ;
constexpr int MVALID = MREAL + NB * NMETA;
constexpr int MPAD = 16640;
constexpr int KVROWS = 64 + SEQ;
constexpr int NQKV = (NHEAD + 2 * NKV) * HD;
constexpr float RMS_EPS = 1e-6f;

typedef unsigned long long rss_t;
constexpr float RSS_FX = 16777216.0f;
__device__ __forceinline__ rss_t rss_fix(float ss) { return (rss_t)(ss * RSS_FX + 0.5f); }
__device__ __forceinline__ void rss_add(rss_t* p, float ss) { (void)__hip_atomic_fetch_add(p, rss_fix(ss), __ATOMIC_RELAXED, __HIP_MEMORY_SCOPE_AGENT); }
__device__ __forceinline__ float rstd_from_ss(rss_t v) { return __builtin_amdgcn_rsqf((float)v * (1.0f / (RSS_FX * (float)DM)) + RMS_EPS); }
__device__ __forceinline__ float silu_f(float x) { return x * __builtin_amdgcn_rcpf(1.0f + __builtin_amdgcn_exp2f(-1.4426950408889634f * x)); }
__device__ __forceinline__ int kv_row_of_real(int row) { return (row >> 13) * KVROWS + 64 + (row & (SEQ - 1)); }

namespace pg8 {
#define PG8_LAS __attribute__((address_space(3)))
typedef unsigned short bf16_t;
typedef short bf16x8 __attribute__((ext_vector_type(8)));
typedef float f32x4 __attribute__((ext_vector_type(4)));
typedef unsigned u32x4 __attribute__((ext_vector_type(4)));
constexpr int BM = 256, BK = 64, HALF = 128, HTB = HALF * BK * 2  , STAGE_BYTES = 8 * HTB, NXCD = 8, WGM = 8;

__host__ __device__ __forceinline__ int lds_byte(int r, int c) { const int st = (r >> 4) * 2 + (c >> 5), rr = r & 15, cc = c & 31, ob = rr * 64 + cc * 2; return st * 1024 + (ob ^ (((ob >> 9) & 1) << 5)); }
__host__ __device__ __forceinline__ void stage_rc(int b, int& R, int& C) { const int st = b / 1024, sb = b % 1024, swz = sb ^ (((sb >> 9) & 1) << 5); R = (st >> 1) * 16 + swz / 64; C = (st & 1) * 32 + (swz % 64) / 2; }
__host__ __device__ __forceinline__ int perm32(int rho) { const int n = rho >> 4, i = rho & 15; return 8 * (i >> 2) + 4 * n + (i & 3); }

struct Unit { int pm, pn; };
struct Gemm { const bf16_t* A; const bf16_t* Bt; int M, N, K; };

struct StaticOrder {
    int nM, nN, nwg, G, c;
    __host__ __device__ void init(int M, int N, int G_, int c_) { nM = M / BM; nN = N / BM; nwg = nM * nN; G = G_; c = c_; }
    __host__ __device__ bool next(int i, Unit& u) const {
        const long L = (long)i * G + c; if (L >= nwg) return false;
        int wgid = (int)L; { const int q = nwg / NXCD, r = nwg % NXCD, xcd = wgid % NXCD, off = wgid / NXCD; wgid = (xcd < r ? xcd * (q + 1) : r * (q + 1) + (xcd - r) * q) + off; }
        const int nig = WGM * nN, gid = wgid / nig, fm = gid * WGM, gsz = (nM - fm) < WGM ? (nM - fm) : WGM;
        u.pm = fm + ((wgid % nig) % gsz); u.pn = (wgid % nig) / gsz; return true;
    }
    __device__ __forceinline__ void a_ready(const Unit&) const {}
    __device__ __forceinline__ void done(const Unit&) const {}
};

__device__ __forceinline__ unsigned cvt_pk_bf16(float lo, float hi) { unsigned r; asm volatile("v_cvt_pk_bf16_f32 %0, %1, %2" : "=v"(r) : "v"(lo), "v"(hi)); return r; }

__device__ __forceinline__ u32x4 pack8(const f32x4 a, const f32x4 b) { u32x4 w; w.x = cvt_pk_bf16(a[0], a[1]); w.y = cvt_pk_bf16(a[2], a[3]); w.z = cvt_pk_bf16(b[0], b[1]); w.w = cvt_pk_bf16(b[2], b[3]); return w; }

typedef int i32x8 __attribute__((ext_vector_type(8)));
__device__ __forceinline__ i32x8 cat8(const bf16x8 a, const bf16x8 b) { typedef int i32x4 __attribute__((ext_vector_type(4))); const i32x4 x = __builtin_bit_cast(i32x4, a), y = __builtin_bit_cast(i32x4, b); return (i32x8){x[0], x[1], x[2], x[3], y[0], y[1], y[2], y[3]}; }
__device__ __forceinline__ unsigned pack_fp8x4(const f32x4 v) {
    int w = 0;
    w = __builtin_amdgcn_cvt_pk_fp8_f32(__builtin_amdgcn_fmed3f(v[0], -448.f, 448.f), __builtin_amdgcn_fmed3f(v[1], -448.f, 448.f), w, false);
    w = __builtin_amdgcn_cvt_pk_fp8_f32(__builtin_amdgcn_fmed3f(v[2], -448.f, 448.f), __builtin_amdgcn_fmed3f(v[3], -448.f, 448.f), w, true);
    return (unsigned)w;
}
constexpr float FP8_ACT_SCALE = 4.f, FP8_W_SCALE = 64.f, FP8_H_SCALE = 8.f, FP8_O_SCALE = 16.f;

template <bool OUT8> struct EpiSwiGLU {
    static constexpr bool PERM = true, AFTER_DRAIN = false;
    bf16_t* act; const rss_t* rss;
    __device__ __forceinline__ void operator()(const f32x4 (&acc)[2][2][4][2], const Unit& u, int wr, int wc, int fr, int fq) const {
        const int row0 = u.pm * BM + wr * 64 + fr, col0 = u.pn * 128 + wc * 32 + 8 * fq;
        rss_t rv[2][4];
#pragma unroll
        for (int ai = 0; ai < 2; ++ai)
#pragma unroll
            for (int m = 0; m < 4; ++m) rv[ai][m] = rss[row0 + ai * HALF + m * 16];
#pragma unroll
        for (int ai = 0; ai < 2; ++ai)
#pragma unroll
            for (int m = 0; m < 4; ++m) {
                const int row = row0 + ai * HALF + m * 16;
                const float rs = rstd_from_ss(rv[ai][m]);
                f32x4 o[2];
#pragma unroll
                for (int n = 0; n < 2; ++n)
#pragma unroll
                    for (int j = 0; j < 4; ++j) o[n][j] = silu_f(acc[ai][0][m][n][j] * rs) * (acc[ai][1][m][n][j] * rs);
                if constexpr (OUT8) { typedef unsigned u32x2 __attribute__((ext_vector_type(2))); *(u32x2*)((unsigned char*)act + (size_t)row * DFF + col0) = (u32x2){pack_fp8x4(o[0] * FP8_ACT_SCALE), pack_fp8x4(o[1] * FP8_ACT_SCALE)}; }
                else *(u32x4*)(act + (size_t)row * DFF + col0) = pack8(o[0], o[1]);
            }
    }
};

struct EpiResid {
    static constexpr bool PERM = true, AFTER_DRAIN = false;
    const float* base; float* out; bf16_t* hb; unsigned char* hb8; rss_t* rss_out; float scale;
    __device__ __forceinline__ void operator()(const f32x4 (&acc)[2][2][4][2], const Unit& u, int wr, int wc, int fr, int fq) const {
        const int lane = fq * 16 + fr;
        const int row0 = u.pm * BM + wr * 64 + fr, colb = u.pn * BM + wc * 32 + 8 * fq;
        f32x4 bv[4][2][2];
#define RESID_LOADM(ai, m) _Pragma("unroll") for (int bj = 0; bj < 2; ++bj) { const size_t o = (size_t)(row0 + (ai) * HALF + (m) * 16) * DM + colb + bj * HALF; \
            bv[m][bj][0] = *(const f32x4*)(base + o); bv[m][bj][1] = *(const f32x4*)(base + o + 4); }
#define RESID_ROWM(ai, m, sel) do { const size_t ro = (size_t)(row0 + (ai) * HALF + (m) * 16) * DM + colb; float ss = 0.f; \
            _Pragma("unroll") for (int bj = 0; bj < 2; ++bj) { const size_t o = ro + bj * HALF; \
                const f32x4 v0 = bv[m][bj][0] + acc[ai][bj][m][0] * scale, v1 = bv[m][bj][1] + acc[ai][bj][m][1] * scale; \
                *(f32x4*)(out + o) = v0; *(f32x4*)(out + o + 4) = v1; \
                if (hb) *(u32x4*)(hb + o) = pack8(v0, v1); \
                if (hb8) { typedef unsigned u32x2 __attribute__((ext_vector_type(2))); *(u32x2*)(hb8 + o) = (u32x2){pack_fp8x4(v0 * FP8_H_SCALE), pack_fp8x4(v1 * FP8_H_SCALE)}; } \
                ss += (v0[0] * v0[0] + v0[1] * v0[1]) + (v0[2] * v0[2] + v0[3] * v0[3]) + (v1[0] * v1[0] + v1[1] * v1[1]) + (v1[2] * v1[2] + v1[3] * v1[3]); } \
            ss += __shfl_xor(ss, 16); ss += __shfl_xor(ss, 32); sel = (fq == (m)) ? ss : sel; } while (0)
        float sel0 = 0.f, sel1 = 0.f;
#pragma unroll
        for (int m = 0; m < 4; ++m) RESID_LOADM(0, m)
#pragma unroll
        for (int m = 0; m < 4; ++m) { RESID_ROWM(0, m, sel0); asm volatile("" ::: "memory"); RESID_LOADM(1, m) asm volatile("" ::: "memory"); }
        rss_add(rss_out + u.pm * BM + 0 * HALF + wr * 64 + lane, sel0);
#pragma unroll
        for (int m = 0; m < 4; ++m) RESID_ROWM(1, m, sel1);
        rss_add(rss_out + u.pm * BM + 1 * HALF + wr * 64 + lane, sel1);
#undef RESID_LOADM
#undef RESID_ROWM
    }
};

struct EpiConvIn {
    static constexpr bool PERM = true, AFTER_DRAIN = false;
    bf16_t* bbuf; bf16_t* ubuf; const rss_t* rss;
    __device__ __forceinline__ void operator()(const f32x4 (&acc)[2][2][4][2], const Unit& u, int wr, int wc, int fr, int fq) const {
        const int row0 = u.pm * BM + wr * 64 + fr;
        rss_t rv[2][4];
#pragma unroll
        for (int ai = 0; ai < 2; ++ai)
#pragma unroll
            for (int m = 0; m < 4; ++m) rv[ai][m] = rss[row0 + ai * HALF + m * 16];
        if (u.pn < 32) {
            const int col0 = u.pn * 128 + wc * 32 + 8 * fq;
#pragma unroll
            for (int ai = 0; ai < 2; ++ai)
#pragma unroll
                for (int m = 0; m < 4; ++m) {
                    const int row = row0 + ai * HALF + m * 16;
                    const float rs = rstd_from_ss(rv[ai][m]);
                    f32x4 o[2];
#pragma unroll
                    for (int n = 0; n < 2; ++n) o[n] = (acc[ai][0][m][n] * rs) * (acc[ai][1][m][n] * rs);
                    *(u32x4*)(ubuf + (size_t)row * DM + col0) = pack8(o[0], o[1]);
                }
        } else {
            const int colb = (u.pn - 32) * BM + wc * 32 + 8 * fq;
#pragma unroll
            for (int ai = 0; ai < 2; ++ai)
#pragma unroll
                for (int m = 0; m < 4; ++m) {
                    const int row = row0 + ai * HALF + m * 16;
                    const float rs = rstd_from_ss(rv[ai][m]);
#pragma unroll
                    for (int bj = 0; bj < 2; ++bj) *(u32x4*)(bbuf + (size_t)row * DM + colb + bj * HALF) = pack8(acc[ai][bj][m][0] * rs, acc[ai][bj][m][1] * rs);
                }
        }
    }
};

struct EpiQKV {
    static constexpr bool PERM = true, AFTER_DRAIN = false;
    bf16_t* q; bf16_t* k; bf16_t* v; const rss_t* rss; float cs;
    __device__ __forceinline__ void operator()(const f32x4 (&acc)[2][2][4][2], const Unit& u, int wr, int wc, int fr, int fq) const {
        const int row0 = u.pm * BM + wr * 64 + fr;
        bf16_t* dst; int ld, colb; const bool isq = u.pn < 16;
        if (isq) { dst = q; ld = DM; colb = u.pn * BM; } else if (u.pn < 20) { dst = k; ld = NKV * HD; colb = (u.pn - 16) * BM; } else { dst = v; ld = NKV * HD; colb = (u.pn - 20) * BM; }
        colb += wc * 32 + 8 * fq;
        rss_t rv[2][4];
#pragma unroll
        for (int ai = 0; ai < 2; ++ai)
#pragma unroll
            for (int m = 0; m < 4; ++m) rv[ai][m] = rss[row0 + ai * HALF + m * 16];
#pragma unroll
        for (int ai = 0; ai < 2; ++ai)
#pragma unroll
            for (int m = 0; m < 4; ++m) {
                const int row = row0 + ai * HALF + m * 16;
                const float rs = rstd_from_ss(rv[ai][m]) * cs;
                const int drow = isq ? row : kv_row_of_real(row);
#pragma unroll
                for (int bj = 0; bj < 2; ++bj) *(u32x4*)(dst + (size_t)drow * ld + colb + bj * HALF) = pack8(acc[ai][bj][m][0] * rs, acc[ai][bj][m][1] * rs);
            }
    }
};

template <class Epi, class Sched, bool ALIGN_EPI = false, bool SP2 = false, bool FP8 = false>
__device__ __forceinline__ void gemm_phase(PG8_LAS unsigned char* lds, const Gemm g, const Sched& S, const Epi& E, const int wid) {
    int lane; asm volatile("v_mbcnt_lo_u32_b32 %0, -1, 0\n\tv_mbcnt_hi_u32_b32 %0, -1, %0" : "=v"(lane));
    const int tid = wid * 64 + lane, wr = wid >> 2, wc = wid & 3, fr = lane & 15, fq = lane >> 4;
    const int KB = FP8 ? g.K : 2 * g.K, nt = KB / (BK * 2);
    unsigned voffA[2], voffB[2];
#pragma unroll
    for (int i = 0; i < 2; ++i) { int R, C; stage_rc(tid * 16 + i * 8192, R, C); const int Rb = Epi::PERM ? ((R & ~31) + perm32(R & 31)) : R;
        voffA[i] = (unsigned)(R * KB + C * 2); voffB[i] = (unsigned)(Rb * KB + C * 2); }
    const size_t kstep = (size_t)(BK * 2);
    const size_t hstep = (size_t)HALF * KB;
    const size_t tstep = 2 * hstep;
    const unsigned ldsw = (unsigned)wid * 1024u;
    const int aoff = lds_byte(wr * 64 + fr, fq * 8), boff = lds_byte(wc * 32 + fr, fq * 8);
#define PG8_SA(b, h) (((b) * 2 + (h)) * HTB)
#define PG8_SB(b, h) ((4 + (b) * 2 + (h)) * HTB)
#define PG8_STAGE(bufoff, gbase, voff) do { _Pragma("unroll") for (int _i = 0; _i < 2; ++_i) \
        __builtin_amdgcn_global_load_lds((const unsigned*)((const char*)(gbase) + (voff)[_i]), (PG8_LAS unsigned*)(lds + (bufoff) + ldsw + _i * 8192), 16, 0, 0); } while (0)
#define PG8_LDA(dst, b, h) do { _Pragma("unroll") for (int m = 0; m < 4; ++m) _Pragma("unroll") for (int k = 0; k < 2; ++k) dst[m][k] = *(const PG8_LAS bf16x8*)(lds + PG8_SA(b, h) + aoff + m * 2048 + k * 1024); } while (0)
#define PG8_LDB(dst, b, h) do { _Pragma("unroll") for (int n = 0; n < 2; ++n) _Pragma("unroll") for (int k = 0; k < 2; ++k) dst[n][k] = *(const PG8_LAS bf16x8*)(lds + PG8_SB(b, h) + boff + n * 2048 + k * 1024); } while (0)
#define PG8_MMA(ai, bj, At, Bt) do { __builtin_amdgcn_s_setprio(1); if constexpr (FP8) { _Pragma("unroll") for (int m = 0; m < 4; ++m) _Pragma("unroll") for (int n = 0; n < 2; ++n) \
        asm volatile("v_mfma_f32_16x16x128_f8f6f4 %0, %1, %2, %0" : "+v"(acc[ai][bj][m][n]) : "v"(cat8(Bt[n][0], Bt[n][1])), "v"(cat8(At[m][0], At[m][1]))); } \
        else { _Pragma("unroll") for (int m = 0; m < 4; ++m) _Pragma("unroll") for (int n = 0; n < 2; ++n) _Pragma("unroll") for (int k = 0; k < 2; ++k) \
        acc[ai][bj][m][n] = __builtin_amdgcn_mfma_f32_16x16x32_bf16(Bt[n][k], At[m][k], acc[ai][bj][m][n], 0, 0, 0); } __builtin_amdgcn_s_setprio(0); } while (0)
#define PG8_WAIT_V(n) asm volatile("s_waitcnt vmcnt(" #n ")" ::: "memory")
#define PG8_WAIT_L(n) asm volatile("s_waitcnt lgkmcnt(" #n ")" ::: "memory")
#define PG8_BAR __builtin_amdgcn_s_barrier()
#define PG8_SCHED __builtin_amdgcn_sched_barrier(0)
    Unit cur, nxt; int ui = 0;
    if (!S.next(0, cur)) return;
    f32x4 acc[2][2][4][2];
#pragma unroll
    for (int a = 0; a < 2; ++a)
#pragma unroll
        for (int b = 0; b < 2; ++b)
#pragma unroll
            for (int m = 0; m < 4; ++m)
#pragma unroll
                for (int n = 0; n < 2; ++n) acc[a][b][m][n] = (f32x4){0.f, 0.f, 0.f, 0.f};
    bf16x8 At[4][2], B0[2][2], B1[2][2];
    const char* cA = (const char*)g.A + (size_t)cur.pm * tstep; const char* cB = (const char*)g.Bt + (size_t)cur.pn * tstep;
    S.a_ready(cur);
    if constexpr (SP2) {
        PG8_STAGE(PG8_SB(0, 0), cB, voffB); PG8_STAGE(PG8_SB(0, 1), cB + hstep, voffB); PG8_STAGE(PG8_SA(0, 0), cA, voffA); PG8_STAGE(PG8_SA(0, 1), cA + hstep, voffA);
        if (wr == 1) PG8_BAR;
        PG8_WAIT_V(2); PG8_BAR;
        PG8_STAGE(PG8_SB(1, 0), cB + kstep, voffB); PG8_STAGE(PG8_SA(1, 0), cA + kstep, voffA); PG8_STAGE(PG8_SB(1, 1), cB + hstep + kstep, voffB);
        PG8_WAIT_V(6); PG8_BAR;
    } else {
        PG8_STAGE(PG8_SB(0, 0), cB, voffB); PG8_STAGE(PG8_SA(0, 0), cA, voffA); PG8_STAGE(PG8_SB(0, 1), cB + hstep, voffB); PG8_STAGE(PG8_SA(0, 1), cA + hstep, voffA);
        if (wr == 1) PG8_BAR;
        PG8_WAIT_V(4); PG8_BAR;
        PG8_STAGE(PG8_SB(1, 0), cB + kstep, voffB); PG8_STAGE(PG8_SA(1, 0), cA + kstep, voffA); PG8_STAGE(PG8_SB(1, 1), cB + hstep + kstep, voffB);
        PG8_WAIT_V(6); PG8_BAR;
    }
    for (;;) {
        const bool has_next = S.next(ui + 1, nxt);
        const char* nA = has_next ? (const char*)g.A + (size_t)nxt.pm * tstep : cA; const char* nB = has_next ? (const char*)g.Bt + (size_t)nxt.pn * tstep : cB;
        for (int t = 0; t < nt; t += 2) {
            const bool last = (t == nt - 2);
            const char* a1 = cA + (size_t)(t + 1) * kstep;
            const char* a2 = last ? nA : cA + (size_t)(t + 2) * kstep; const char* b2 = last ? nB : cB + (size_t)(t + 2) * kstep;
            const char* a3 = a2 + kstep; const char* b3 = b2 + kstep;
            if (last && has_next) S.a_ready(nxt);
            if constexpr (SP2) {
            PG8_LDB(B0, 0, 0); PG8_LDB(B1, 0, 1); PG8_SCHED; PG8_LDA(At, 0, 0); PG8_STAGE(PG8_SA(1, 1), a1 + hstep, voffA);
            PG8_WAIT_V(8); PG8_WAIT_L(0); PG8_BAR; PG8_MMA(0, 0, At, B0); PG8_MMA(0, 1, At, B1); PG8_BAR; PG8_SCHED;
            PG8_LDA(At, 0, 1); PG8_STAGE(PG8_SB(0, 0), b2, voffB); PG8_STAGE(PG8_SB(0, 1), b2 + hstep, voffB); PG8_STAGE(PG8_SA(0, 0), a2, voffA);
            PG8_WAIT_V(8); PG8_WAIT_L(0); PG8_BAR; PG8_MMA(1, 0, At, B0); PG8_MMA(1, 1, At, B1); PG8_BAR; PG8_SCHED;
            PG8_LDB(B0, 1, 0); PG8_LDB(B1, 1, 1); PG8_SCHED; PG8_LDA(At, 1, 0); PG8_STAGE(PG8_SA(0, 1), a2 + hstep, voffA);
            PG8_WAIT_V(8); PG8_WAIT_L(0); PG8_BAR; PG8_MMA(0, 0, At, B0); PG8_MMA(0, 1, At, B1); PG8_BAR; PG8_SCHED;
            PG8_LDA(At, 1, 1); PG8_STAGE(PG8_SB(1, 0), b3, voffB); PG8_STAGE(PG8_SB(1, 1), b3 + hstep, voffB); PG8_STAGE(PG8_SA(1, 0), a3, voffA);
            PG8_WAIT_V(8); PG8_WAIT_L(0); PG8_BAR; PG8_MMA(1, 0, At, B0); PG8_MMA(1, 1, At, B1); PG8_BAR; PG8_SCHED;
            } else {
            PG8_LDB(B0, 0, 0); PG8_SCHED; PG8_LDA(At, 0, 0); PG8_STAGE(PG8_SA(1, 1), a1 + hstep, voffA);
            PG8_WAIT_L(8); PG8_BAR; PG8_WAIT_L(0); PG8_MMA(0, 0, At, B0); PG8_BAR; PG8_SCHED;
            PG8_LDB(B1, 0, 1); PG8_STAGE(PG8_SB(0, 0), b2, voffB);
            PG8_BAR; PG8_WAIT_L(0); PG8_MMA(0, 1, At, B1); PG8_BAR;
            PG8_LDA(At, 0, 1); PG8_STAGE(PG8_SA(0, 0), a2, voffA);
            PG8_BAR; PG8_WAIT_L(0); PG8_MMA(1, 0, At, B0); PG8_BAR; PG8_SCHED;
            PG8_STAGE(PG8_SB(0, 1), b2 + hstep, voffB);
            PG8_WAIT_V(6); PG8_BAR; PG8_MMA(1, 1, At, B1); PG8_BAR;
            PG8_LDB(B0, 1, 0); PG8_SCHED; PG8_LDA(At, 1, 0); PG8_STAGE(PG8_SA(0, 1), a2 + hstep, voffA);
            PG8_WAIT_L(8); PG8_BAR; PG8_WAIT_L(0); PG8_MMA(0, 0, At, B0); PG8_BAR; PG8_SCHED;
            PG8_LDB(B1, 1, 1); PG8_STAGE(PG8_SB(1, 0), b3, voffB);
            PG8_BAR; PG8_WAIT_L(0); PG8_MMA(0, 1, At, B1); PG8_BAR;
            PG8_LDA(At, 1, 1); PG8_STAGE(PG8_SA(1, 0), a3, voffA);
            PG8_BAR; PG8_WAIT_L(0); PG8_MMA(1, 0, At, B0); PG8_BAR; PG8_SCHED;
            PG8_STAGE(PG8_SB(1, 1), b3 + hstep, voffB);
            PG8_WAIT_V(6); PG8_BAR; PG8_MMA(1, 1, At, B1); PG8_BAR;
            }
        }
        if constexpr (FP8) {
            asm volatile("s_nop 15\n\ts_nop 15" : "+v"(At[0][0]), "+v"(At[0][1]), "+v"(At[1][0]), "+v"(At[1][1]), "+v"(At[2][0]), "+v"(At[2][1]), "+v"(At[3][0]), "+v"(At[3][1]),
                         "+v"(B0[0][0]), "+v"(B0[0][1]), "+v"(B0[1][0]), "+v"(B0[1][1]), "+v"(B1[0][0]), "+v"(B1[0][1]), "+v"(B1[1][0]), "+v"(B1[1][1]) :: "memory");
        }
        if constexpr (ALIGN_EPI) { if (wr == 0) PG8_BAR; }
        if constexpr (FP8) {
            asm volatile("s_nop 15\n\ts_nop 15\n\ts_nop 7" : "+v"(acc[1][1][0][0]), "+v"(acc[1][1][0][1]), "+v"(acc[1][1][1][0]), "+v"(acc[1][1][1][1]), "+v"(acc[1][1][2][0]), "+v"(acc[1][1][2][1]), "+v"(acc[1][1][3][0]), "+v"(acc[1][1][3][1]) :: "memory");
            asm volatile("" : "+v"(acc[1][0][0][0]), "+v"(acc[1][0][0][1]), "+v"(acc[1][0][1][0]), "+v"(acc[1][0][1][1]), "+v"(acc[1][0][2][0]), "+v"(acc[1][0][2][1]), "+v"(acc[1][0][3][0]), "+v"(acc[1][0][3][1]));
        }
        if constexpr (!Epi::AFTER_DRAIN) { E(acc, cur, wr, wc, fr, fq); S.done(cur); }
        if (!has_next) break;
#pragma unroll
        for (int a = 0; a < 2; ++a)
#pragma unroll
            for (int b = 0; b < 2; ++b)
#pragma unroll
                for (int m = 0; m < 4; ++m)
#pragma unroll
                    for (int n = 0; n < 2; ++n) acc[a][b][m][n] = (f32x4){0.f, 0.f, 0.f, 0.f};
        cur = nxt; cA = nA; cB = nB; ++ui;
        if constexpr (ALIGN_EPI) { if (wr == 1) PG8_BAR; }
    }
    PG8_WAIT_V(0);
    if constexpr (!ALIGN_EPI) { if (wr == 0) PG8_BAR; }
    PG8_BAR;
    if constexpr (Epi::AFTER_DRAIN) { E.fused(acc, cur, wr, wc, fr, fq, lds, wid, lane); S.done(cur); }
#undef PG8_SA
#undef PG8_SB
#undef PG8_STAGE
#undef PG8_LDA
#undef PG8_LDB
#undef PG8_MMA
#undef PG8_WAIT_V
#undef PG8_WAIT_L
#undef PG8_BAR
#undef PG8_SCHED
}
}

namespace att {
typedef unsigned short bf16_t;
using bf16x8 = __attribute__((ext_vector_type(8))) short;
using s16x4  = __attribute__((ext_vector_type(4))) short;
using f32x16 = __attribute__((ext_vector_type(16))) float;
using u32x4  = __attribute__((ext_vector_type(4))) unsigned;
using f32x4  = __attribute__((ext_vector_type(4))) float;
constexpr int D = 128, NW = 8, QBLK = 32, KVBLK = 64;
constexpr float SCALE = 0.088388347648318440f;
constexpr float THR = 8.f;
constexpr int LDQ = NHEAD * HD, LDK = NKV * HD, LDO = NHEAD * HD;
constexpr int SHM_V = KVBLK * D * 2, SHM_K = KVBLK * D * 2, SHM_ATTN = 2 * SHM_V + 2 * SHM_K + NW * 64 * 4;
constexpr int NT = KVROWS / KVBLK;
static_assert(NT % 2 == 1 && NT >= 3, "the loop below is written for an odd tile count");
#define KSWZ(row, colB) ((row) * 256 + ((colB) ^ (((row) & 7) << 4)))
#define SBAR() __builtin_amdgcn_sched_barrier(0)
__device__ __forceinline__ int crow(int r, int hi) { return (r & 3) + 8 * (r >> 2) + 4 * hi; }
__device__ __forceinline__ unsigned cvtpk(float lo, float hi) { unsigned r; asm volatile("v_cvt_pk_bf16_f32 %0, %1, %2" : "=v"(r) : "v"(lo), "v"(hi)); return r; }

__device__ __forceinline__ void partialSM(f32x16& p0, f32x16& p1, float& m_reg, float& mn, float& alpha) {
  constexpr float C = SCALE * 1.4426950408889634f;
  float pmax = p0[0];
#pragma unroll
  for (int r = 1; r < 16; ++r) pmax = fmaxf(pmax, p0[r]);
#pragma unroll
  for (int r = 0; r < 16; ++r) pmax = fmaxf(pmax, p1[r]);
  { auto rr = __builtin_amdgcn_permlane32_swap(__float_as_uint(pmax), __float_as_uint(pmax), false, false);
    pmax = fmaxf(__uint_as_float(rr[0]), __uint_as_float(rr[1])); }
  if (__builtin_expect(__all(pmax - m_reg <= THR / SCALE), 1)) { mn = m_reg; alpha = 1.f; }
  else { mn = fmaxf(m_reg, pmax); alpha = __builtin_amdgcn_exp2f((m_reg - mn) * C); m_reg = mn; }
  float mnC = -mn * C;
#pragma unroll
  for (int r = 0; r < 16; ++r) p0[r] = fmaf(p0[r], C, mnC);
#pragma unroll
  for (int r = 0; r < 16; ++r) p1[r] = fmaf(p1[r], C, mnC);
#pragma unroll
  for (int r = 0; r < 16; ++r) p0[r] = __builtin_amdgcn_exp2f(p0[r]);
}
__device__ __forceinline__ void finishSM(f32x16& p0, f32x16& p1, float alpha, float& l_reg, bf16x8& pa0, bf16x8& pa1, bf16x8& pa2, bf16x8& pa3) {
#pragma unroll
  for (int r = 0; r < 16; ++r) p1[r] = __builtin_amdgcn_exp2f(p1[r]);
  float ps = 0;
#pragma unroll
  for (int r = 0; r < 16; ++r) ps += p0[r];
#pragma unroll
  for (int r = 0; r < 16; ++r) ps += p1[r];
  { auto rr = __builtin_amdgcn_permlane32_swap(__float_as_uint(ps), __float_as_uint(ps), false, false);
    ps = __uint_as_float(rr[0]) + __uint_as_float(rr[1]); }
  l_reg = l_reg * alpha + ps;
#define PK4(P, BASE, OUT) do { unsigned a0 = cvtpk(P[BASE + 0], P[BASE + 1]), a1 = cvtpk(P[BASE + 2], P[BASE + 3]);   \
    unsigned b0 = cvtpk(P[BASE + 4], P[BASE + 5]), b1 = cvtpk(P[BASE + 6], P[BASE + 7]);                              \
    auto r0 = __builtin_amdgcn_permlane32_swap(a0, b0, false, false); auto r1 = __builtin_amdgcn_permlane32_swap(a1, b1, false, false); \
    u32x4 w = {r0[0], r1[0], r0[1], r1[1]}; OUT = *reinterpret_cast<bf16x8*>(&w); } while (0)
  PK4(p0, 0, pa0); PK4(p0, 8, pa1); PK4(p1, 0, pa2); PK4(p1, 8, pa3);
#undef PK4
}
__device__ __forceinline__ void qkt(f32x16& p0, f32x16& p1, const bf16_t* Ks, const bf16x8* qr, int r32, int hi) {
  p0 = f32x16{}; p1 = f32x16{};
#pragma unroll
  for (int d0 = 0; d0 < 8; ++d0) { int cb = (d0 * 16 + hi * 8) * 2;
    bf16x8 b0 = *reinterpret_cast<const bf16x8*>((const char*)Ks + KSWZ(r32, cb));
    bf16x8 b1 = *reinterpret_cast<const bf16x8*>((const char*)Ks + KSWZ(32 + r32, cb));
    p0 = __builtin_amdgcn_mfma_f32_32x32x16_bf16(b0, qr[d0], p0, 0, 0, 0);
    p1 = __builtin_amdgcn_mfma_f32_32x32x16_bf16(b1, qr[d0], p1, 0, 0, 0); }
}
__device__ __forceinline__ int v_st(int k, int c) { const int kk = (k & ~0xC) | ((k & 4) << 1) | ((k & 8) >> 1); return ((kk >> 3) * 4 + (c >> 5)) * 512 + ((kk & 7) * 32 + (c & 31)) * 2; }
__device__ __forceinline__ int v_rd_base(int lane) { return ((lane & 3) << 3) | (((lane >> 2) & 3) << 6) | (((lane >> 4) & 1) << 5) | (((lane >> 5) & 1) << 8); }
constexpr int v_rd_off(int d0, int ks, int half) { return d0 * 512 + ks * 4096 + half * 2048; }
template <int OFF> __device__ __forceinline__ s16x4 tr_read(int vb) {
  s16x4 r; asm volatile("ds_read_b64_tr_b16 %0, %1 offset:%2" : "=&v"(r) : "v"(vb), "i"(OFF) : "memory"); return r;
}
template <int D0> __device__ __forceinline__ void pv_one(f32x16& od, int vb, bf16x8 pa0, bf16x8 pa1, bf16x8 pa2, bf16x8 pa3) {
  const s16x4 l0 = tr_read<v_rd_off(D0, 0, 0)>(vb), h0 = tr_read<v_rd_off(D0, 0, 1)>(vb), l1 = tr_read<v_rd_off(D0, 1, 0)>(vb), h1 = tr_read<v_rd_off(D0, 1, 1)>(vb);
  const s16x4 l2 = tr_read<v_rd_off(D0, 2, 0)>(vb), h2 = tr_read<v_rd_off(D0, 2, 1)>(vb), l3 = tr_read<v_rd_off(D0, 3, 0)>(vb), h3 = tr_read<v_rd_off(D0, 3, 1)>(vb);
  asm volatile("s_waitcnt lgkmcnt(0)" ::: "memory"); SBAR();
#define PK(L, H) (bf16x8){L[0], L[1], L[2], L[3], H[0], H[1], H[2], H[3]}
  od = __builtin_amdgcn_mfma_f32_32x32x16_bf16(pa0, PK(l0, h0), od, 0, 0, 0);
  od = __builtin_amdgcn_mfma_f32_32x32x16_bf16(pa1, PK(l1, h1), od, 0, 0, 0);
  od = __builtin_amdgcn_mfma_f32_32x32x16_bf16(pa2, PK(l2, h2), od, 0, 0, 0);
  od = __builtin_amdgcn_mfma_f32_32x32x16_bf16(pa3, PK(l3, h3), od, 0, 0, 0);
#undef PK
}
__device__ __forceinline__ void pv_d0(f32x16* o, int vb, bf16x8 pa0, bf16x8 pa1, bf16x8 pa2, bf16x8 pa3) {
  pv_one<0>(o[0], vb, pa0, pa1, pa2, pa3); pv_one<1>(o[1], vb, pa0, pa1, pa2, pa3); pv_one<2>(o[2], vb, pa0, pa1, pa2, pa3); pv_one<3>(o[3], vb, pa0, pa1, pa2, pa3);
}

__device__ __forceinline__ int lane_id_asm() { int l; asm volatile("v_mbcnt_lo_u32_b32 %0, -1, 0\n\tv_mbcnt_hi_u32_b32 %0, -1, %0" : "=v"(l)); return l; }
template <bool O8> __device__ __forceinline__ void attn_unit(const bf16_t* __restrict__ Qb, const bf16_t* __restrict__ Kh, const bf16_t* __restrict__ Vh, void* __restrict__ Ob, char* lds, const int wid, const float* __restrict__ qg, const int t0) {
  const int lane = lane_id_asm(), tid = wid * 64 + lane, r32 = lane & 31, hi = lane >> 5;
  bf16_t* V_lds = (bf16_t*)lds; bf16_t* K_lds = (bf16_t*)(lds + 2 * SHM_V);
  float* ws = (float*)(lds + 2 * SHM_V + 2 * SHM_K) + wid * 64; float* li_l = ws; float* al_l = ws + 32;
  float m_reg = -1e30f, l_reg = 0; f32x16 o[4] = {}; bf16x8 qr[8];
  __syncthreads();
  { const unsigned qoff = (unsigned)((wid * QBLK + r32) * LDQ + hi * 8) * 2u;
#pragma unroll
    for (int d0 = 0; d0 < 8; ++d0) qr[d0] = *reinterpret_cast<const bf16x8*>((const char*)Qb + qoff + d0 * 32); }
  { float xf[8][8]; float ss = 0.f;
#pragma unroll
    for (int d0 = 0; d0 < 8; ++d0)
#pragma unroll
      for (int k = 0; k < 8; ++k) { xf[d0][k] = __uint_as_float((unsigned)(unsigned short)qr[d0][k] << 16); ss += xf[d0][k] * xf[d0][k]; }
    { auto rr = __builtin_amdgcn_permlane32_swap(__float_as_uint(ss), __float_as_uint(ss), false, false); ss = __uint_as_float(rr[0]) + __uint_as_float(rr[1]); }
    const float rs = __builtin_amdgcn_rsqf(ss * (1.0f / (float)D) + RMS_EPS);
#pragma unroll
    for (int d0 = 0; d0 < 8; ++d0) { const f32x4 g0 = *(const f32x4*)(qg + 16 * d0 + 8 * hi), g1 = *(const f32x4*)(qg + 16 * d0 + 8 * hi + 4);
#pragma unroll
      for (int k = 0; k < 4; ++k) { xf[d0][k] *= rs * g0[k]; xf[d0][4 + k] *= rs * g1[k]; } }
    const int t = t0 + wid * QBLK + r32; const float pos[2] = {(float)(t >> 6), (float)(t & 63)};
#pragma unroll
    for (int ax = 0; ax < 2; ++ax)
#pragma unroll
      for (int dd = 0; dd < 2; ++dd)
#pragma unroll
        for (int k = 0; k < 8; ++k) {
          const float inv_freq = __builtin_amdgcn_exp2f(-(float)(16 * dd + 8 * hi + k) * 0.41524101186092029f);
          const float rev = pos[ax] * inv_freq * 0.15915494309189535f, c = __builtin_amdgcn_cosf(rev), s = __builtin_amdgcn_sinf(rev);
          const float y1 = xf[4 * ax + dd][k], y2 = xf[4 * ax + dd + 2][k];
          xf[4 * ax + dd][k] = y1 * c - y2 * s; xf[4 * ax + dd + 2][k] = y2 * c + y1 * s; }
#pragma unroll
    for (int d0 = 0; d0 < 8; ++d0) { u32x4 w = {cvtpk(xf[d0][0], xf[d0][1]), cvtpk(xf[d0][2], xf[d0][3]), cvtpk(xf[d0][4], xf[d0][5]), cvtpk(xf[d0][6], xf[d0][7])}; qr[d0] = *reinterpret_cast<bf16x8*>(&w); }
  }
  const int sr = tid >> 4, sc = (tid & 15) * 8, vst0 = v_st(sr, sc), vst1 = v_st(32 + sr, sc);
  const int vb0 = (int)(uintptr_t)V_lds + v_rd_base(lane);
  struct { bf16x8 vs0, vs1, ks0, ks1; } sr_[2];
#define LD8(p) (*reinterpret_cast<const bf16x8*>(p))
  const unsigned goff0 = (unsigned)(sr * LDK + sc) * 2u, goff1 = goff0 + 32u * LDK * 2u;
#define SLOAD(i, k0) do { const char* vt_ = (const char*)Vh + (size_t)(k0) * (LDK * 2); const char* kt_ = (const char*)Kh + (size_t)(k0) * (LDK * 2); \
    sr_[i].vs0 = LD8(vt_ + goff0); sr_[i].vs1 = LD8(vt_ + goff1); sr_[i].ks0 = LD8(kt_ + goff0); sr_[i].ks1 = LD8(kt_ + goff1); } while (0)
#define SWRITE(b, i) do { *(bf16x8*)((char*)V_lds + (b) * SHM_V + vst0) = sr_[i].vs0;          \
    *(bf16x8*)((char*)V_lds + (b) * SHM_V + vst1) = sr_[i].vs1; int kc = sc * 2;               \
    *(bf16x8*)((char*)K_lds + (b) * SHM_K + KSWZ(sr, kc)) = sr_[i].ks0;                       \
    *(bf16x8*)((char*)K_lds + (b) * SHM_K + KSWZ(32 + sr, kc)) = sr_[i].ks1; } while (0)
#define SWAIT() asm volatile("s_waitcnt vmcnt(4)" ::: "memory")
#define RESC(a) do { if (__any((a) < 1.f)) { if (hi == 0) al_l[r32] = (a); asm volatile("s_waitcnt lgkmcnt(0)" ::: "memory"); \
    _Pragma("unroll") for (int d = 0; d < 4; ++d) _Pragma("unroll") for (int r = 0; r < 16; ++r) o[d][r] *= al_l[crow(r, hi)]; } } while (0)
  f32x16 pA0, pA1, pB0, pB1; float mnA, mnB, alA, alB; bf16x8 pa0, pa1, pa2, pa3;
  constexpr int SE = 0, SO = 1;
  SLOAD(SE, 0); asm volatile("s_waitcnt vmcnt(0)" ::: "memory"); SWRITE(0, SE); __syncthreads();
  qkt(pA0, pA1, K_lds, qr, r32, hi);
#pragma unroll
  for (int r = 8; r < 16; ++r) pA0[r] = -INFINITY;
#pragma unroll
  for (int r = 0; r < 16; ++r) pA1[r] = -INFINITY;
  partialSM(pA0, pA1, m_reg, mnA, alA);
  SLOAD(SO, KVBLK); SLOAD(SE, 2 * KVBLK);
  SWAIT(); SWRITE(1, SO); __syncthreads();
  for (int j = 1; j + 1 < NT; j += 2) {
    SBAR(); qkt(pB0, pB1, (bf16_t*)((char*)K_lds + SHM_K), qr, r32, hi);
    finishSM(pA0, pA1, alA, l_reg, pa0, pa1, pa2, pa3); SBAR();
    if (j + 2 < NT) SLOAD(SO, (j + 2) * KVBLK); SBAR();
    pv_d0(o, vb0, pa0, pa1, pa2, pa3); partialSM(pB0, pB1, m_reg, mnB, alB);
    __syncthreads(); SWAIT(); SWRITE(0, SE);
    RESC(alB); __syncthreads();
    SBAR(); qkt(pA0, pA1, K_lds, qr, r32, hi);
    finishSM(pB0, pB1, alB, l_reg, pa0, pa1, pa2, pa3); SBAR();
    if (j + 3 < NT) SLOAD(SE, (j + 3) * KVBLK); SBAR();
    pv_d0(o, vb0 + (int)SHM_V, pa0, pa1, pa2, pa3); partialSM(pA0, pA1, m_reg, mnA, alA);
    __syncthreads(); SWAIT(); if (j + 2 < NT) SWRITE(1, SO);
    RESC(alA); __syncthreads();
  }
  finishSM(pA0, pA1, alA, l_reg, pa0, pa1, pa2, pa3); SBAR();
  pv_d0(o, vb0, pa0, pa1, pa2, pa3);
  if (hi == 0) li_l[r32] = l_reg; asm volatile("s_waitcnt lgkmcnt(0)" ::: "memory");
  float rli[16];
#pragma unroll
  for (int r = 0; r < 16; ++r) rli[r] = __builtin_amdgcn_rcpf(li_l[crow(r, hi)]);
  { const int l2 = lane_id_asm(), c32 = l2 & 31, h2 = l2 >> 5;
    if constexpr (O8) { unsigned char* Ow = (unsigned char*)Ob + (size_t)(wid * QBLK) * LDO;
#pragma unroll
      for (int r = 0; r < 16; ++r) { const unsigned ooff = (unsigned)(crow(r, h2) * LDO + c32);
#pragma unroll
        for (int d0 = 0; d0 < 4; ++d0) { const float v = __builtin_amdgcn_fmed3f(o[d0][r] * rli[r] * pg8::FP8_O_SCALE, -448.f, 448.f); Ow[ooff + d0 * 32] = (unsigned char)(__builtin_amdgcn_cvt_pk_fp8_f32(v, 0.f, 0, false) & 0xff); } } }
    else { char* Ow = (char*)Ob + (size_t)(wid * QBLK) * (LDO * 2);
#pragma unroll
      for (int r = 0; r < 16; ++r) { const unsigned ooff = (unsigned)(crow(r, h2) * LDO + c32) * 2u;
#pragma unroll
        for (int d0 = 0; d0 < 4; ++d0) *(bf16_t*)(Ow + ooff + d0 * 64) = (bf16_t)(cvtpk(o[d0][r] * rli[r], 0.f) & 0xffffu); } } }
#undef LD8
#undef SLOAD
#undef SWRITE
#undef SWAIT
#undef RESC
}
#undef KSWZ
}


namespace att8 {
using att::f32x16; using att::f32x4; using att::u32x4; using att::crow; using att::lane_id_asm;
typedef int i32x8 __attribute__((ext_vector_type(8)));
typedef int i32x4 __attribute__((ext_vector_type(4)));
constexpr int D = 128, NW = 8, QBLK = 32, KVBLK = 64, NT = att::NT;
constexpr float FP8_K_SCALE = 0.5f, FP8_Q_SCALE = att::SCALE * 1.4426950408889634f * 2.0f;
constexpr float FP8_KQ_SCALE = FP8_K_SCALE;
constexpr float FP8_V_SCALE = 16.f, FP8_P_LOG2 = 4.f, THR_LOG2 = 4.f;
constexpr int LDQ = NHEAD * HD, LDK8 = NKV * HD, LDO = NHEAD * HD;
constexpr int SHM_K = KVBLK * D, SHM_V = KVBLK * D, NSLOT = 4, SHM_ATTN8 = NSLOT * SHM_K + NSLOT * SHM_V + NW * 64 * 4;
#define SBAR8() __builtin_amdgcn_sched_barrier(0)
#define MFMA8(acc, a, b) asm volatile("v_mfma_f32_32x32x64_f8f6f4 %0, %1, %2, %0" : "+v"(acc) : "v"(a), "v"(b))
#define MFMA8N(dst, a, b, c) asm volatile("v_mfma_f32_32x32x64_f8f6f4 %0, %1, %2, %3" : "=&v"(dst) : "v"(a), "v"(b), "v"(c))
__device__ __forceinline__ i32x8 cat(const i32x4 x, const i32x4 y) { return (i32x8){x[0], x[1], x[2], x[3], y[0], y[1], y[2], y[3]}; }
__device__ __forceinline__ int k8_pos(int e) { const int d0 = e >> 4, hi = (e >> 3) & 1, k = e & 7; return (d0 >> 2) * 64 + hi * 32 + (d0 & 3) * 8 + k; }
__device__ __forceinline__ int v8_key(int j) { const int h = j >> 5, i = j & 31; return i < 16 ? crow(i, h) : 32 + crow(i - 16, h); }
__device__ __forceinline__ unsigned pk4(float a, float b, float c, float d) { int w = 0; w = __builtin_amdgcn_cvt_pk_fp8_f32(a, b, w, false); w = __builtin_amdgcn_cvt_pk_fp8_f32(c, d, w, true); return (unsigned)w; }
__device__ __forceinline__ unsigned pk4u(float a, float b, float c, float d) { int w; asm volatile("" : "=v"(w)); w = __builtin_amdgcn_cvt_pk_fp8_f32(a, b, w, false); w = __builtin_amdgcn_cvt_pk_fp8_f32(c, d, w, true); return (unsigned)w; }
__device__ __forceinline__ float sat8(float v) { return __builtin_amdgcn_fmed3f(v, -448.f, 448.f); }
__device__ __forceinline__ float max3f(float a, float b, float c) { float r; asm("v_max3_f32 %0, %1, %2, %3" : "=v"(r) : "v"(a), "v"(b), "v"(c)); return r; }

__device__ __forceinline__ void qkt8(f32x16& p0, f32x16& p1, const char* Ks, const i32x8 (&qf)[2], int r32, int hi) {
  p0 = f32x16{}; p1 = f32x16{};
#pragma unroll
  for (int s = 0; s < 2; ++s) {
    const int c0 = s * 4 + hi * 2;
#pragma unroll
    for (int hp = 0; hp < 2; ++hp) { const int key = hp * 32 + r32, swz = (key >> 1) & 7; const char* kr = Ks + key * 128;
      const i32x4 a0 = *reinterpret_cast<const i32x4*>(kr + ((c0 ^ swz) << 4)), a1 = *reinterpret_cast<const i32x4*>(kr + (((c0 + 1) ^ swz) << 4));
      if (hp == 0) MFMA8(p0, cat(a0, a1), qf[s]); else MFMA8(p1, cat(a0, a1), qf[s]); }
  }
}
__device__ __forceinline__ void pv8(f32x16* o, const char* Vs, const i32x8 pf, int r32, int hi) {
#pragma unroll
  for (int d0 = 0; d0 < 4; ++d0) { const int d = d0 * 32 + r32, swz = (d >> 2) & 3; const char* vr = Vs + d * 64;
    const i32x4 b0 = *reinterpret_cast<const i32x4*>(vr + (((hi * 2) ^ swz) << 4)), b1 = *reinterpret_cast<const i32x4*>(vr + (((hi * 2 + 1) ^ swz) << 4));
    MFMA8(o[d0], pf, cat(b0, b1)); }
}
__device__ __forceinline__ i32x8 kfrag8(const char* Ks, int hp, int s, int r32, int hi) { const int key = hp * 32 + r32, swz = (key >> 1) & 7, c0 = s * 4 + hi * 2; const char* kr = Ks + key * 128;
  return cat(*reinterpret_cast<const i32x4*>(kr + ((c0 ^ swz) << 4)), *reinterpret_cast<const i32x4*>(kr + (((c0 + 1) ^ swz) << 4))); }
__device__ __forceinline__ i32x8 vfrag8(const char* Vs, int d0, int r32, int hi) { const int d = d0 * 32 + r32, swz = (d >> 2) & 3; const char* vr = Vs + d * 64;
  return cat(*reinterpret_cast<const i32x4*>(vr + (((hi * 2) ^ swz) << 4)), *reinterpret_cast<const i32x4*>(vr + (((hi * 2 + 1) ^ swz) << 4))); }
#define MAXCH8(m_, p_) do { float b_; asm("v_max3_f32 %0, %2, %3, %4\n\tv_max3_f32 %1, %5, %6, %7\n\tv_max3_f32 %0, %0, %8, %9\n\tv_max3_f32 %1, %1, %10, %11\n\tv_max3_f32 %0, %0, %12, %13\n\tv_max3_f32 %1, %1, %14, %15\n\tv_max3_f32 %0, %0, %16, %17\n\tv_max_f32 %0, %0, %1" \
    : "=&v"(m_), "=&v"(b_) : "v"(p_[0]), "v"(p_[1]), "v"(p_[2]), "v"(p_[3]), "v"(p_[4]), "v"(p_[5]), "v"(p_[6]), "v"(p_[7]), "v"(p_[8]), "v"(p_[9]), "v"(p_[10]), "v"(p_[11]), "v"(p_[12]), "v"(p_[13]), "v"(p_[14]), "v"(p_[15])); } while (0)
#define STEP8(pC0, pC1, pP0, pP1, alC, KS, VS, JT) do { \
    const char* Kb_ = K_lds + (KS) * SHM_K; const char* Vb_ = V_lds + (VS) * SHM_V; \
    DMAK8((JT) + 2, ((KS) + 2) & 3); DMAV8((JT) + 1, ((VS) + 2) & 3); \
    i32x8 ka_ = kfrag8(Kb_, 0, 0, r32, hi), kb_ = kfrag8(Kb_, 1, 0, r32, hi), kc_ = kfrag8(Kb_, 0, 1, r32, hi); SBAR8();     \
    MFMA8N(pC0, ka_, qf[0], negm); \
    i32x8 kd_ = kfrag8(Kb_, 1, 1, r32, hi); _Pragma("unroll") for (int r_ = 0; r_ < 8; ++r_) pP1[r_] = __builtin_amdgcn_exp2f(pP1[r_]); SBAR8(); \
    MFMA8N(pC1, kb_, qf[0], negm); \
    i32x8 va_ = vfrag8(Vb_, 0, r32, hi); _Pragma("unroll") for (int r_ = 8; r_ < 16; ++r_) pP1[r_] = __builtin_amdgcn_exp2f(pP1[r_]); SBAR8(); \
    MFMA8(pC0, kc_, qf[1]); \
    i32x8 vb_ = vfrag8(Vb_, 1, r32, hi); _Pragma("unroll") for (int q_ = 0; q_ < 4; ++q_) { \
        pf[q_] = (int)pk4u(pP0[4 * q_], pP0[4 * q_ + 1], pP0[4 * q_ + 2], pP0[4 * q_ + 3]); pf[4 + q_] = (int)pk4u(pP1[4 * q_], pP1[4 * q_ + 1], pP1[4 * q_ + 2], pP1[4 * q_ + 3]); } SBAR8(); \
    MFMA8(pC1, kd_, qf[1]); \
    i32x8 vc_ = vfrag8(Vb_, 2, r32, hi); SBAR8(); \
    MFMA8(o[0], pf, va_); \
    i32x8 vd_ = vfrag8(Vb_, 3, r32, hi); float m0_; MAXCH8(m0_, pC0); SBAR8(); \
    MFMA8(o[1], pf, vb_); \
    float m1_; MAXCH8(m1_, pC1); float pmax_; asm("v_max_f32 %0, %1, %2" : "=v"(pmax_) : "v"(m0_), "v"(m1_)); \
    { auto rr_ = __builtin_amdgcn_permlane32_swap(__float_as_uint(pmax_), __float_as_uint(pmax_), false, false); asm("v_max_f32 %0, %1, %2" : "=v"(pmax_) : "v"(rr_[0]), "v"(rr_[1])); } \
    alC = 1.f; \
    if (__builtin_expect(!__all(pmax_ <= FP8_P_LOG2 + THR_LOG2), 0)) {     \
        const float d_ = fmaxf(pmax_ - FP8_P_LOG2, 0.f); alC = __builtin_amdgcn_exp2f(-d_); m_reg += d_; \
        _Pragma("unroll") for (int r_ = 0; r_ < 16; ++r_) { pC0[r_] -= d_; pC1[r_] -= d_; negm[r_] = FP8_P_LOG2 - m_reg; } } SBAR8(); \
    MFMA8(o[2], pf, vc_); \
    _Pragma("unroll") for (int r_ = 0; r_ < 16; ++r_) pC0[r_] = __builtin_amdgcn_exp2f(pC0[r_]); SBAR8(); \
    MFMA8(o[3], pf, vd_); \
    MFMA8(osum, pf, ones8);        \
    \
  } while (0)

template <bool WAITMFMA> __device__ __forceinline__ void partialSM8(f32x16& p0, f32x16& p1, float& m_reg, float& alpha) {
  if (WAITMFMA) asm volatile("s_nop 15\n\ts_nop 7" : "+v"(p0), "+v"(p1));
  float pa = max3f(p0[0], p0[1], p1[0]), pb = max3f(p0[2], p0[3], p1[1]); pa = max3f(pa, p1[2], p1[3]);
#pragma unroll
  for (int r = 4; r < 16; r += 4) { pa = max3f(pa, p0[r], p0[r + 1]); pb = max3f(pb, p0[r + 2], p0[r + 3]); pa = max3f(pa, p1[r], p1[r + 1]); pb = max3f(pb, p1[r + 2], p1[r + 3]); }
  float pmax = fmaxf(pa, pb);
  { auto rr = __builtin_amdgcn_permlane32_swap(__float_as_uint(pmax), __float_as_uint(pmax), false, false);
    pmax = fmaxf(__uint_as_float(rr[0]), __uint_as_float(rr[1])); }
  float mn;
  if (__builtin_expect(__all(pmax - m_reg <= THR_LOG2), 1)) { mn = m_reg; alpha = 1.f; }
  else { mn = fmaxf(m_reg, pmax); alpha = __builtin_amdgcn_exp2f(m_reg - mn); m_reg = mn; }
  const float mnC = FP8_P_LOG2 - mn;
#pragma unroll
  for (int r = 0; r < 16; ++r) p0[r] = __builtin_amdgcn_exp2f(p0[r] + mnC);
#pragma unroll
  for (int r = 0; r < 16; ++r) p1[r] += mnC;
}
__device__ __forceinline__ void finishSM8(f32x16& p0, f32x16& p1, i32x8& pf) {
#pragma unroll
  for (int r = 0; r < 16; ++r) p1[r] = __builtin_amdgcn_exp2f(p1[r]);
#pragma unroll
  for (int q = 0; q < 4; ++q) { pf[q] = (int)pk4(p0[4 * q], p0[4 * q + 1], p0[4 * q + 2], p0[4 * q + 3]); pf[4 + q] = (int)pk4(p1[4 * q], p1[4 * q + 1], p1[4 * q + 2], p1[4 * q + 3]); }
}

__device__ __forceinline__ void attn_unit8(const unsigned short* __restrict__ Qb, const unsigned char* __restrict__ Kh8, const unsigned char* __restrict__ Vt, unsigned char* __restrict__ Ob,
                                           char* lds, __attribute__((address_space(3))) unsigned char* ldsl, const int wid, const float* __restrict__ qg, const int t0) {
  const int lane = lane_id_asm(), tid = wid * 64 + lane, r32 = lane & 31, hi = lane >> 5;
  char* K_lds = lds; char* V_lds = lds + NSLOT * SHM_K;
  float* ws = (float*)(lds + NSLOT * SHM_K + NSLOT * SHM_V) + wid * 64; float* al_l = ws + 32;
  float m_reg = -1e30f; f32x16 o[4] = {}; f32x16 osum = {}; i32x8 qf[2];
  const i32x8 ones8 = {0x38383838, 0x38383838, 0x38383838, 0x38383838, 0x38383838, 0x38383838, 0x38383838, 0x38383838};
  __syncthreads();
  { att::bf16x8 qr[8];
    const unsigned qoff = (unsigned)((wid * QBLK + r32) * LDQ + hi * 8) * 2u;
#pragma unroll
    for (int d0 = 0; d0 < 8; ++d0) qr[d0] = *reinterpret_cast<const att::bf16x8*>((const char*)Qb + qoff + d0 * 32);
    float xf[8][8]; float ss = 0.f;
#pragma unroll
    for (int d0 = 0; d0 < 8; ++d0)
#pragma unroll
      for (int k = 0; k < 8; ++k) { xf[d0][k] = __uint_as_float((unsigned)(unsigned short)qr[d0][k] << 16); ss += xf[d0][k] * xf[d0][k]; }
    { auto rr = __builtin_amdgcn_permlane32_swap(__float_as_uint(ss), __float_as_uint(ss), false, false); ss = __uint_as_float(rr[0]) + __uint_as_float(rr[1]); }
    const float rs = __builtin_amdgcn_rsqf(ss * (1.0f / (float)D) + RMS_EPS) * FP8_Q_SCALE;
#pragma unroll
    for (int d0 = 0; d0 < 8; ++d0) { const f32x4 g0 = *(const f32x4*)(qg + 16 * d0 + 8 * hi), g1 = *(const f32x4*)(qg + 16 * d0 + 8 * hi + 4);
#pragma unroll
      for (int k = 0; k < 4; ++k) { xf[d0][k] *= rs * g0[k]; xf[d0][4 + k] *= rs * g1[k]; } }
    const int t = t0 + wid * QBLK + r32; const float pos[2] = {(float)(t >> 6), (float)(t & 63)};
#pragma unroll
    for (int ax = 0; ax < 2; ++ax)
#pragma unroll
      for (int dd = 0; dd < 2; ++dd)
#pragma unroll
        for (int k = 0; k < 8; ++k) {
          const float inv_freq = __builtin_amdgcn_exp2f(-(float)(16 * dd + 8 * hi + k) * 0.41524101186092029f);
          const float rev = pos[ax] * inv_freq * 0.15915494309189535f, c = __builtin_amdgcn_cosf(rev), s = __builtin_amdgcn_sinf(rev);
          const float y1 = xf[4 * ax + dd][k], y2 = xf[4 * ax + dd + 2][k];
          xf[4 * ax + dd][k] = y1 * c - y2 * s; xf[4 * ax + dd + 2][k] = y2 * c + y1 * s; }
#pragma unroll
    for (int s = 0; s < 2; ++s)
#pragma unroll
      for (int j = 0; j < 4; ++j) { const int d0 = 4 * s + j;
        qf[s][2 * j] = (int)pk4(sat8(xf[d0][0]), sat8(xf[d0][1]), sat8(xf[d0][2]), sat8(xf[d0][3])); qf[s][2 * j + 1] = (int)pk4(sat8(xf[d0][4]), sat8(xf[d0][5]), sat8(xf[d0][6]), sat8(xf[d0][7])); }
  }
  const int skey = tid >> 3, sd = tid >> 2;
  const unsigned kg_off = (unsigned)(skey * LDK8 + (((tid & 7) ^ ((skey >> 1) & 7)) << 4)), vg_off = (unsigned)(sd * 64 + (((tid & 3) ^ ((sd >> 2) & 3)) << 4));
#define TCLAMP(t) ((t) < NT ? (t) : NT - 1)
#define DMAK8(kt, ks) __builtin_amdgcn_global_load_lds((const unsigned*)(Kh8 + (size_t)TCLAMP(kt) * (KVBLK * LDK8) + kg_off), (__attribute__((address_space(3))) unsigned*)(ldsl + (ks) * SHM_K + wid * 1024), 16, 0, 0)
#define DMAV8(vt, vs) __builtin_amdgcn_global_load_lds((const unsigned*)(Vt + (size_t)TCLAMP(vt) * (KVBLK * D) + vg_off), (__attribute__((address_space(3))) unsigned*)(ldsl + NSLOT * SHM_K + (vs) * SHM_V + wid * 1024), 16, 0, 0)
#define STEP_END8() do { asm volatile("s_waitcnt vmcnt(2) lgkmcnt(0)" ::: "memory"); __builtin_amdgcn_s_barrier(); asm volatile("" ::: "memory"); } while (0)
#define RESC8(a) do { if (__any((a) < 1.f)) { if (hi == 0) al_l[r32] = (a); asm volatile("s_waitcnt lgkmcnt(0)" ::: "memory"); asm volatile("s_nop 15\n\ts_nop 7" : "+v"(o[0]), "+v"(o[1]), "+v"(o[2]), "+v"(o[3]), "+v"(osum)); \
    _Pragma("unroll") for (int r = 0; r < 16; ++r) { const float a_ = al_l[crow(r, hi)]; osum[r] *= a_; _Pragma("unroll") for (int d = 0; d < 4; ++d) o[d][r] *= a_; } } } while (0)
  f32x16 pA0, pA1, pB0, pB1, negm; float alA, alB; i32x8 pf;
  DMAK8(0, 0); DMAV8(0, 0); DMAK8(1, 1); DMAK8(2, 2); DMAV8(1, 1);
  STEP_END8();
  qkt8(pA0, pA1, K_lds, qf, r32, hi);
  asm volatile("s_nop 15\n\ts_nop 7" : "+v"(pA0), "+v"(pA1));
#pragma unroll
  for (int r = 8; r < 16; ++r) pA0[r] = -INFINITY;
#pragma unroll
  for (int r = 0; r < 16; ++r) pA1[r] = -INFINITY;
  partialSM8<false>(pA0, pA1, m_reg, alA);
#pragma unroll
  for (int r = 0; r < 16; ++r) negm[r] = FP8_P_LOG2 - m_reg;
  asm volatile("s_waitcnt lgkmcnt(0)" ::: "memory"); __builtin_amdgcn_s_barrier(); asm volatile("" ::: "memory");
  for (int j = 1; j < NT; j += 4) {
    STEP8(pB0, pB1, pA0, pA1, alB, 1, 0, j);     RESC8(alB); STEP_END8();
    STEP8(pA0, pA1, pB0, pB1, alA, 2, 1, j + 1); RESC8(alA); STEP_END8();
    STEP8(pB0, pB1, pA0, pA1, alB, 3, 2, j + 2); RESC8(alB); STEP_END8();
    STEP8(pA0, pA1, pB0, pB1, alA, 0, 3, j + 3); RESC8(alA); STEP_END8();
  }
  asm volatile("s_waitcnt vmcnt(0)" ::: "memory");
  finishSM8(pA0, pA1, pf); SBAR8();
  pv8(o, V_lds + ((NT - 1) & 3) * SHM_V, pf, r32, hi); MFMA8(osum, pf, ones8);
  asm volatile("s_nop 15\n\ts_nop 15\n\ts_nop 15\n\ts_nop 7" : "+v"(o[0]), "+v"(o[1]), "+v"(o[2]), "+v"(o[3]), "+v"(osum));
  float rli[16];
#pragma unroll
  for (int r = 0; r < 16; ++r) rli[r] = __builtin_amdgcn_rcpf(osum[r]) * (pg8::FP8_O_SCALE / FP8_V_SCALE);
  { const int l2 = lane_id_asm(), c32 = l2 & 31, h2 = l2 >> 5; unsigned char* Ow = Ob + (size_t)(wid * QBLK) * LDO;
#pragma unroll
    for (int r = 0; r < 16; ++r) { const unsigned ooff = (unsigned)(crow(r, h2) * LDO + c32);
#pragma unroll
      for (int d0 = 0; d0 < 4; ++d0) { const float v = sat8(o[d0][r] * rli[r]); Ow[ooff + d0 * 32] = (unsigned char)(__builtin_amdgcn_cvt_pk_fp8_f32(v, 0.f, 0, false) & 0xff); } } }
#undef DMAK8
#undef DMAV8
#undef MAXCH8
#undef STEP_END8
#undef TCLAMP
#undef STEP8
#undef RESC8
}
}

#define GAS __attribute__((address_space(1)))
#define LAS __attribute__((address_space(3)))
typedef unsigned short bf16;
typedef unsigned v4u __attribute__((ext_vector_type(4)));
typedef float f32x4 __attribute__((ext_vector_type(4)));
typedef short bf16x8 __attribute__((ext_vector_type(8)));
typedef GAS unsigned gu32;
typedef GAS unsigned long long gu64;
#define RLX_AGENT __ATOMIC_RELAXED, __HIP_MEMORY_SCOPE_AGENT
#define LDS_WAIT() asm volatile("s_waitcnt lgkmcnt(0)" ::: "memory")
#define VM_WAIT() asm volatile("s_waitcnt vmcnt(0)" ::: "memory")
__device__ __forceinline__ unsigned long long rt() { return __builtin_amdgcn_s_memrealtime(); }
__device__ __forceinline__ unsigned f2bf(float f) { unsigned u = __builtin_bit_cast(unsigned, f); return (u + 0x7fffu + ((u >> 16) & 1u)) >> 16; }
__device__ __forceinline__ unsigned pk2(float lo, float hi) { return f2bf(lo) | (f2bf(hi) << 16); }

#define XB_TMO      128
#define XB_XCNT(j)  (256  + 64 * (j))
#define XB_XSUB(j)  (1280 + 64 * (j))
#define XB_XGEN(j)  (2304 + 64 * (j))
#define XB_TOP      3328
#define XB_TOPGEN   3392
#define XCD_BAR_WORDS 3456
#define XB_SPIN_CAP (1u << 18)

__device__ __forceinline__ unsigned xb_ld(unsigned* p)              { return __hip_atomic_load(p, __ATOMIC_RELAXED, __HIP_MEMORY_SCOPE_AGENT); }
__device__ __forceinline__ unsigned xb_add(unsigned* p, unsigned v) { return __hip_atomic_fetch_add(p, v, __ATOMIC_RELAXED, __HIP_MEMORY_SCOPE_AGENT); }
__device__ __forceinline__ unsigned xb_xcc_id() { return (unsigned)__builtin_amdgcn_s_getreg((3 << 11) | 20) & 0xFu; }
#define XB_SPIN(cond, bar) do { unsigned _sp = 0; while (cond) { __builtin_amdgcn_s_sleep(1); \
    if ((++_sp & 255u) == 0u) { if (xb_ld(&(bar)[XB_TMO])) break; if (_sp > XB_SPIN_CAP) { atomicAdd(&(bar)[XB_TMO], 1u); break; } } } } while (0)

struct XcdBarrier {
    unsigned* bar; unsigned x;
    volatile LAS unsigned* st;
};

__device__ __forceinline__ XcdBarrier xcd_barrier_post(unsigned* bar, volatile LAS unsigned* st, const bool t0) {
    XcdBarrier b; b.bar = bar; b.x = xb_xcc_id(); b.st = st;
    if (t0) (void)xb_add(&bar[XB_XCNT(b.x)], 1u);
    return b;
}
__device__ __forceinline__ void xcd_barrier_complete(unsigned* bar, unsigned x, unsigned& nloc, unsigned& nx) {
    const unsigned G = gridDim.x * gridDim.y * gridDim.z;
    unsigned sum, cnt, mine, sp = 0u;
    for (;;) {
        sum = 0u; cnt = 0u; mine = 0u;
#pragma unroll
        for (unsigned j = 0; j < 16; ++j) { const unsigned c = xb_ld(&bar[XB_XCNT(j)]); sum += c; cnt += (c > 0u) ? 1u : 0u; mine = (j == x) ? c : mine; }
        if (sum == G) break;
        __builtin_amdgcn_s_sleep(1);
        if ((++sp & 255u) == 0u) { if (xb_ld(&bar[XB_TMO])) break; if (sp > XB_SPIN_CAP) { atomicAdd(&bar[XB_TMO], 1u); break; } }
    }
    nloc = mine > 0u ? mine : 1u; nx = cnt > 0u ? cnt : 1u;
}

__device__ __forceinline__ void xcd_barrier(const XcdBarrier& b, const bool t0) {
    asm volatile("s_waitcnt vmcnt(0)" ::: "memory");
    __syncthreads();
    if (t0) {
        unsigned* bar = b.bar;
        __builtin_amdgcn_s_waitcnt(0);
        unsigned nloc = b.st[0], nx = b.st[1];
        if (nloc == 0u) { xcd_barrier_complete(bar, b.x, nloc, nx); b.st[0] = nloc; b.st[1] = nx; }
        const unsigned old = xb_add(&bar[XB_XSUB(b.x)], 1u);
        const unsigned gen = old / nloc;
        if (old + 1u == (gen + 1u) * nloc) {
            __builtin_amdgcn_fence(__ATOMIC_RELEASE, "agent");
            asm volatile("s_waitcnt vmcnt(0)" ::: "memory");
            const unsigned og = xb_add(&bar[XB_TOP], 1u);
            const unsigned tg = og / nx;
            if (og + 1u == (tg + 1u) * nx) xb_add(&bar[XB_TOPGEN], 1u);
            else XB_SPIN(xb_ld(&bar[XB_TOPGEN]) == tg, bar);
            __builtin_amdgcn_fence(__ATOMIC_ACQUIRE, "agent");
            xb_add(&bar[XB_XGEN(b.x)], 1u);
            asm volatile("s_waitcnt vmcnt(0)" ::: "memory");
        } else {
            XB_SPIN(xb_ld(&bar[XB_XGEN(b.x)]) == gen, bar);
            __builtin_amdgcn_fence(__ATOMIC_ACQUIRE, "agent");
            asm volatile("s_waitcnt vmcnt(0)" ::: "memory");
        }
    }
    __syncthreads();
}

constexpr size_t MiB = 1u << 20;
constexpr size_t CTL_ZERO_BYTES = 2 * MiB;
constexpr int CW_BAR = 4096;
constexpr size_t RSS_OFF = 256 * 1024;
constexpr int NRSS = 7;
static_assert((CW_BAR + XCD_BAR_WORDS) * 4 <= (int)RSS_OFF && RSS_OFF + (size_t)NRSS * MPAD * 8 <= CTL_ZERO_BYTES, "control region");
constexpr size_t SZ_WGU = (size_t)2 * DFF * DM * 2, SZ_WD = (size_t)DM * DFF * 2, SZ_WCI = (size_t)3 * DM * DM * 2, SZ_WSQ = (size_t)DM * DM * 2, SZ_WQKV = (size_t)NQKV * DM * 2;
constexpr size_t WS_WGU = 2 * MiB;
constexpr size_t WS_WD = WS_WGU + 4 * SZ_WGU;
constexpr size_t WS_WCI = WS_WD + 4 * SZ_WD;
constexpr size_t WS_WCO = WS_WCI + SZ_WCI;
constexpr size_t WS_WQKV = WS_WCO + SZ_WSQ;
constexpr size_t WS_WO = WS_WQKV + SZ_WQKV;
constexpr size_t WS_H = WS_WO + SZ_WSQ;
constexpr size_t WS_HB = WS_H + (size_t)MPAD * DM * 4;
constexpr size_t WS_ACT = WS_HB + (size_t)MPAD * DM * 2;
constexpr size_t SZ_ACT = (size_t)MPAD * DFF * 2;
constexpr size_t WS_BB = WS_ACT, WS_UB = WS_ACT + (size_t)MPAD * DM * 2;
constexpr size_t WS_Q = WS_ACT, WS_K = WS_Q + (size_t)MREAL * DM * 2, WS_V = WS_K + (size_t)NB * KVROWS * NKV * HD * 2;
static_assert(WS_UB + (size_t)MPAD * DM * 2 <= WS_ACT + SZ_ACT && WS_V + (size_t)NB * KVROWS * NKV * HD * 2 <= WS_ACT + SZ_ACT, "overlays fit the FFN hidden buffer");
constexpr size_t WS_AUX = WS_ACT + SZ_ACT;
constexpr size_t SZ_WD8 = (size_t)DM * DFF;
constexpr size_t WS_WD8 = WS_AUX + (size_t)MPAD * DM * 2;
constexpr size_t WS_WQKV8 = WS_WD8 + 4 * SZ_WD8;
constexpr size_t WS_WO8 = WS_WQKV8 + (size_t)NQKV * DM;
constexpr size_t WS_HB8 = WS_WO8 + (size_t)DM * DM;
constexpr size_t WS_K8 = WS_HB8 + (size_t)MPAD * DM;
constexpr size_t WS_VT8 = WS_K8 + (size_t)NB * KVROWS * NKV * HD;
constexpr size_t WS_END = WS_VT8 + (size_t)NB * NKV * (KVROWS / 64) * 128 * 64;
static_assert(WS_WD8 % 256 == 0 && WS_WQKV8 % 256 == 0 && WS_WO8 % 256 == 0 && WS_HB8 % 256 == 0 && WS_K8 % 256 == 0 && WS_VT8 % 256 == 0, "alignment");
static_assert(WS_WGU % 256 == 0 && WS_WD % 256 == 0 && WS_H % 256 == 0 && WS_HB % 256 == 0 && WS_ACT % 256 == 0 && WS_K % 256 == 0 && WS_V % 256 == 0 && WS_AUX % 256 == 0, "alignment");

constexpr int NWAVES = 8;
constexpr int RING_BYTES = 131072;
constexpr int MISC_OFF = 139264 + 320;
constexpr int LDS_BYTES = 147456;

struct Frame {
    LAS unsigned char* lds;
    int tid, lane, wave, G, bid;
};
#define REFRAME(F) do { (F).lane = att::lane_id_asm(); (F).tid = (F).wave * 64 + (F).lane; } while (0)

__device__ __forceinline__ float wave_sum(float v) {
#pragma unroll
    for (int o = 1; o < 64; o <<= 1) v += __shfl_xor(v, o);
    return v;
}
__device__ __forceinline__ float bf2f(unsigned short b) { return __uint_as_float((unsigned)b << 16); }

#define CVT_LOAD32(t, wp, ldw, koff) do { _Pragma("unroll") for (int i_ = 0; i_ < 32; ++i_) (t)[i_] = __builtin_nontemporal_load((wp) + (size_t)((koff) + 2 * i_) * (ldw)); } while (0)
#define CVT_LDSW32(t, scr, koff, lane) do { _Pragma("unroll") for (int i_ = 0; i_ < 32; ++i_) (scr)[((koff) + 2 * i_ + ((lane) >> 5)) * 33 + ((lane) & 31)] = (t)[i_]; } while (0)
__device__ __forceinline__ void cvt_finish(const float (&t)[32], const float* g, bf16* WT, int K, int drow, int k0, LAS float* scr, int lane) {
    const int c = lane & 7;
    f32x4 g0 = {1.f, 1.f, 1.f, 1.f}, g1 = g0;
    if (g) { g0 = *(const f32x4*)(g + k0 + 8 * c); g1 = *(const f32x4*)(g + k0 + 8 * c + 4); }
    CVT_LDSW32(t, scr, 0, lane);
    LDS_WAIT(); asm volatile("" ::: "memory");
#pragma unroll
    for (int j = 0; j < 4; ++j) { const int n = (lane >> 3) + 8 * j; const LAS float* s = scr + (8 * c) * 33 + n;
        v4u o; o.x = pg8::cvt_pk_bf16(s[0 * 33] * g0[0], s[1 * 33] * g0[1]); o.y = pg8::cvt_pk_bf16(s[2 * 33] * g0[2], s[3 * 33] * g0[3]);
        o.z = pg8::cvt_pk_bf16(s[4 * 33] * g1[0], s[5 * 33] * g1[1]); o.w = pg8::cvt_pk_bf16(s[6 * 33] * g1[2], s[7 * 33] * g1[3]);
        __builtin_nontemporal_store(o, (GAS v4u*)(WT + (size_t)(drow + n) * K + k0 + 8 * c)); }
    LDS_WAIT(); asm volatile("" ::: "memory");
}
template <int MODE>
__device__ __forceinline__ const float* cvt_src(const float* W, const float* W2, int ldw, int nblk, int it, int lane, int& drow, int& k0) {
    const int kb = it / nblk, nb = it - kb * nblk; drow = nb * 32; k0 = kb * 64;
    const float* src = W; int scol = drow;
    if (MODE == 1) { src = ((drow >> 7) & 1) ? W2 : W; scol = (drow >> 8) * 128 + (drow & 127); }
    if (MODE == 2) { if (drow < 2 * DM) scol = (((drow >> 7) & 1) ? 2 * DM : DM) + (drow >> 8) * 128 + (drow & 127); else scol = drow - 2 * DM; }
    return src + (size_t)(k0 + (lane >> 5)) * ldw + scol + (lane & 31);
}
template <int MODE>
__device__ __forceinline__ void cvt_matrix(Frame& F, const float* W, const float* W2, int ldw, const float* g, bf16* WT, int K, int ndst) {
    LAS float* scr = (LAS float*)(F.lds + F.wave * 16896);
    const int gw = F.bid * NWAVES + F.wave, NGW = F.G * NWAVES, lane = F.lane;
    const int nblk = ndst / 32, nitems = nblk * (K / 64);
    float ta[32], tb[32]; int da, ka, db, kb;
    int it = gw;
    if (it < nitems) { const float* wp = cvt_src<MODE>(W, W2, ldw, nblk, it, lane, da, ka); CVT_LOAD32(ta, wp, ldw, 0); }
    while (it < nitems) {
        const int it1 = it + NGW;
        if (it1 < nitems) { const float* wp = cvt_src<MODE>(W, W2, ldw, nblk, it1, lane, db, kb); CVT_LOAD32(tb, wp, ldw, 0); }
        __builtin_amdgcn_sched_barrier(0);
        cvt_finish(ta, g, WT, K, da, ka, scr, lane);
        if (it1 >= nitems) break;
        it = it1 + NGW;
        if (it < nitems) { const float* wp = cvt_src<MODE>(W, W2, ldw, nblk, it, lane, da, ka); CVT_LOAD32(ta, wp, ldw, 0); }
        __builtin_amdgcn_sched_barrier(0);
        cvt_finish(tb, g, WT, K, db, kb, scr, lane);
    }
}
__device__ __forceinline__ void cvt_finish8(const float* g, float scale, unsigned char* WT, int K, int drow, int k0, LAS float* scr, int lane) {
    const int c = lane & 7;
    f32x4 gv[4];
#pragma unroll
    for (int q = 0; q < 4; ++q) gv[q] = g ? *(const f32x4*)(g + k0 + 16 * c + 4 * q) * scale : (f32x4){scale, scale, scale, scale};
    LDS_WAIT(); asm volatile("" ::: "memory");
#pragma unroll
    for (int j = 0; j < 4; ++j) { const int n = (lane >> 3) + 8 * j; const LAS float* s = scr + (16 * c) * 33 + n;
        v4u o;
#pragma unroll
        for (int q = 0; q < 4; ++q) o[q] = pg8::pack_fp8x4((f32x4){s[(4 * q + 0) * 33], s[(4 * q + 1) * 33], s[(4 * q + 2) * 33], s[(4 * q + 3) * 33]} * gv[q]);
        __builtin_nontemporal_store(o, (GAS v4u*)(WT + (size_t)(drow + n) * K + k0 + 16 * c)); }
    LDS_WAIT(); asm volatile("" ::: "memory");
}
__device__ __forceinline__ void cvt_matrix8(Frame& F, const float* W, int ldw, const float* g, float scale, unsigned char* WT, int K, int ndst) {
    LAS float* scr = (LAS float*)(F.lds + F.wave * 16896);
    const int gw = F.bid * NWAVES + F.wave, NGW = F.G * NWAVES, lane = F.lane;
    const int nblk = ndst / 32, nitems = nblk * (K / 128);
    float ta[32], tb[32];
    int it = gw;
    if (it < nitems) { const int kb = it / nblk, nb = it - kb * nblk; const float* wp = W + (size_t)(kb * 128 + (lane >> 5)) * ldw + nb * 32 + (lane & 31); CVT_LOAD32(ta, wp, ldw, 0); }
    for (; it < nitems; it += NGW) {
        const int kb = it / nblk, nb = it - kb * nblk; const float* wp = W + (size_t)(kb * 128 + (lane >> 5)) * ldw + nb * 32 + (lane & 31);
        CVT_LOAD32(tb, wp, ldw, 64);
        __builtin_amdgcn_sched_barrier(0);
        CVT_LDSW32(ta, scr, 0, lane);
        const int itn = it + NGW;
        if (itn < nitems) { const int kbn = itn / nblk, nbn = itn - kbn * nblk; const float* wpn = W + (size_t)(kbn * 128 + (lane >> 5)) * ldw + nbn * 32 + (lane & 31); CVT_LOAD32(ta, wpn, ldw, 0); }
        __builtin_amdgcn_sched_barrier(0);
        CVT_LDSW32(tb, scr, 64, lane);
        cvt_finish8(g, scale, WT, K, nb * 32, kb * 128, scr, lane);
    }
}

template <int MODE>
__device__ __forceinline__ void cvt_one(const float* W, const float* W2, int ldw, const float* g, bf16* WT, int K, int ndst, int it, LAS float* scr, int lane) {
    int drow, k0; const float* wp = cvt_src<MODE>(W, W2, ldw, ndst / 32, it, lane, drow, k0);
    float t[32]; CVT_LOAD32(t, wp, ldw, 0);
    cvt_finish(t, g, WT, K, drow, k0, scr, lane);
}
__device__ __forceinline__ void cvt_one8(const float* W, int ldw, const float* g, float scale, unsigned char* WT, int K, int ndst, int it, LAS float* scr, int lane) {
    const int nblk = ndst / 32, kb = it / nblk, nb = it - kb * nblk; const float* wp = W + (size_t)(kb * 128 + (lane >> 5)) * ldw + nb * 32 + (lane & 31);
    float ta[32], tb[32]; CVT_LOAD32(ta, wp, ldw, 0); CVT_LOAD32(tb, wp, ldw, 64);
    CVT_LDSW32(ta, scr, 0, lane); CVT_LDSW32(tb, scr, 64, lane);
    cvt_finish8(g, scale, WT, K, nb * 32, kb * 128, scr, lane);
}
constexpr int BG_N0 = (2 * DFF / 32) * (DM / 64), BG_N1 = (DM / 32) * (DFF / 128), BG_N2 = (NQKV / 32) * (DM / 128), BG_N3 = (2 * NKV * HD / 32) * (DM / 64), BG_N4 = (DM / 32) * (DM / 128);
constexpr int BG_L0 = (DM / 32) * (DFF / 64), BG_L1 = BG_L0 + (3 * DM / 32) * (DM / 64), BG_L2 = BG_L1 + (DM / 32) * (DM / 64), BG_L3 = BG_L2 + BG_N0, BG_L4 = BG_L3 + BG_N1;
constexpr int BG_B1 = BG_L4 + BG_N0, BG_B2 = BG_B1 + BG_N1, BG_B3 = BG_B2 + BG_N2, BG_B4 = BG_B3 + BG_N3, BG_B5 = BG_B4 + BG_N4, BG_B6 = BG_B5 + BG_N0, BG_TOTAL = BG_B6 + BG_N1;
constexpr int BG_END_A = BG_B5;
constexpr size_t BG_CTL_OFF = 1536 * 1024;
constexpr int BG_CH = 2;
__device__ __forceinline__ void bg_item(Frame& F, const float* const* in, unsigned char* ws, int it) {
    LAS float* scr = (LAS float*)(F.lds + F.wave * 16896);
    const size_t LW = (size_t)DM * DFF;
    if (it < BG_L0) cvt_one<0>(in[5], nullptr, DM, nullptr, (bf16*)(ws + WS_WD), DFF, DM, it, scr, F.lane);
    else if (it < BG_L1) cvt_one<2>(in[11], nullptr, 3 * DM, in[10], (bf16*)(ws + WS_WCI), DM, 3 * DM, it - BG_L0, scr, F.lane);
    else if (it < BG_L2) cvt_one<0>(in[14], nullptr, DM, nullptr, (bf16*)(ws + WS_WCO), DM, DM, it - BG_L1, scr, F.lane);
    else if (it < BG_L3) cvt_one<1>(in[7], in[8], DFF, in[6], (bf16*)(ws + WS_WGU) + 1 * (size_t)2 * DFF * DM, DM, 2 * DFF, it - BG_L2, scr, F.lane);
    else if (it < BG_L4) cvt_one8(in[9], DM, nullptr, pg8::FP8_W_SCALE, ws + WS_WD8 + 1 * SZ_WD8, DFF, DM, it - BG_L3, scr, F.lane);
    else if (it < BG_B1) cvt_one<1>(in[3] + LW, in[4] + LW, DFF, in[2] + DM, (bf16*)(ws + WS_WGU) + 2 * (size_t)2 * DFF * DM, DM, 2 * DFF, it - BG_L4, scr, F.lane);
    else if (it < BG_B2) cvt_one8(in[5] + LW, DM, nullptr, pg8::FP8_W_SCALE, ws + WS_WD8 + 2 * SZ_WD8, DFF, DM, it - BG_B1, scr, F.lane);
    else if (it < BG_B3) cvt_one8(in[16], NQKV, in[15], pg8::FP8_W_SCALE, ws + WS_WQKV8, DM, NQKV, it - BG_B2, scr, F.lane);
    else if (it < BG_B4) cvt_one<0>(in[16] + NHEAD * HD, nullptr, NQKV, in[15], (bf16*)(ws + WS_WQKV) + (size_t)NHEAD * HD * DM, DM, 2 * NKV * HD, it - BG_B3, scr, F.lane);
    else if (it < BG_B5) cvt_one8(in[19], DM, nullptr, pg8::FP8_W_SCALE, ws + WS_WO8, DM, DM, it - BG_B4, scr, F.lane);
    else if (it < BG_B6) cvt_one<1>(in[7] + LW, in[8] + LW, DFF, in[6] + DM, (bf16*)(ws + WS_WGU) + 3 * (size_t)2 * DFF * DM, DM, 2 * DFF, it - BG_B5, scr, F.lane);
    else cvt_one8(in[9] + LW, DM, nullptr, pg8::FP8_W_SCALE, ws + WS_WD8 + 3 * SZ_WD8, DFF, DM, it - BG_B6, scr, F.lane);
}
__device__ __forceinline__ void bg_drain(Frame& F, const float* const* in, unsigned char* ws, volatile LAS unsigned* MISC, int k, int need) {
    unsigned* ctl = (unsigned*)(ws + BG_CTL_OFF);
    __syncthreads();
    if (F.tid == 0) (void)__hip_atomic_fetch_add(ctl + 64 * (k + 1), 1u, __ATOMIC_RELAXED, __HIP_MEMORY_SCOPE_AGENT);
    for (;;) {
        if (F.tid == 0) {
            const int c = (int)__hip_atomic_load(ctl, __ATOMIC_RELAXED, __HIP_MEMORY_SCOPE_AGENT);
            const int d = (int)__hip_atomic_load(ctl + 64 * (k + 1), __ATOMIC_RELAXED, __HIP_MEMORY_SCOPE_AGENT);
            const bool go = c < BG_TOTAL && (c < need || d < F.G);
            MISC[20] = go ? 1u : 0u;
            if (go) MISC[21] = __hip_atomic_fetch_add(ctl, (unsigned)(NWAVES * BG_CH), __ATOMIC_RELAXED, __HIP_MEMORY_SCOPE_AGENT);
        }
        __syncthreads();
        const unsigned go = MISC[20]; const int base = (int)MISC[21];
        __syncthreads();
        if (!go) break;
#pragma unroll 1
        for (int i = 0; i < BG_CH; ++i) { const int it = base + F.wave * BG_CH + i; if (it < BG_TOTAL) bg_item(F, in, ws, it); }
    }
}

typedef float f32x16 __attribute__((ext_vector_type(16)));
template <int NT, class Epi>
__device__ __forceinline__ void skinny_phase(Frame& F, const bf16* A, const bf16* Bt, int K, int n_items, const Epi& E) {
    const int r32 = F.lane & 31, hi = F.lane >> 5, kc = K / 8, k0 = F.wave * kc;
    LAS float* P = (LAS float*)F.lds;
    for (int item = F.bid; item < n_items; item += F.G) {
        f32x16 acc[NT];
        const bf16* bp[NT];
        const bf16* ap = A + (size_t)r32 * K + k0 + hi * 16;
#pragma unroll
        for (int t = 0; t < NT; ++t) { acc[t] = f32x16{}; bp[t] = Bt + (size_t)(E.tile_row(item, t) + r32) * K + k0 + hi * 16; }
        constexpr int U = (NT == 1) ? 4 : 2;
        int kk = 0;
        for (; kk + 32 * U <= kc; kk += 32 * U) {
            bf16x8 a[2 * U], b[NT][2 * U];
#pragma unroll
            for (int u = 0; u < 2 * U; ++u) a[u] = *(const bf16x8*)(ap + kk + hi * (16 * U - 16) + 8 * u);
#pragma unroll
            for (int t = 0; t < NT; ++t)
#pragma unroll
                for (int u = 0; u < 2 * U; ++u) b[t][u] = *(const bf16x8*)(bp[t] + kk + hi * (16 * U - 16) + 8 * u);
            __builtin_amdgcn_sched_barrier(0);
#pragma unroll
            for (int t = 0; t < NT; ++t)
#pragma unroll
                for (int u = 0; u < 2 * U; ++u) acc[t] = __builtin_amdgcn_mfma_f32_32x32x16_bf16(a[u], b[t][u], acc[t], 0, 0, 0);
            __builtin_amdgcn_sched_barrier(0);
        }
        for (; kk < kc; kk += 32) {
            const bf16x8 a0 = *(const bf16x8*)(ap + kk), a1 = *(const bf16x8*)(ap + kk + 8);
#pragma unroll
            for (int t = 0; t < NT; ++t) {
                const bf16x8 b0 = *(const bf16x8*)(bp[t] + kk), b1 = *(const bf16x8*)(bp[t] + kk + 8);
                acc[t] = __builtin_amdgcn_mfma_f32_32x32x16_bf16(a0, b0, acc[t], 0, 0, 0);
                acc[t] = __builtin_amdgcn_mfma_f32_32x32x16_bf16(a1, b1, acc[t], 0, 0, 0);
            }
        }
#pragma unroll
        for (int t = 0; t < NT; ++t)
#pragma unroll
            for (int r = 0; r < 16; ++r) P[((F.wave * NT + t) * 32 + att::crow(r, hi)) * 32 + r32] = acc[t][r];
        __syncthreads();
#pragma unroll
        for (int h = 0; h < 2; ++h) {
            const int e = F.tid + h * 512; float v[NT];
#pragma unroll
            for (int t = 0; t < NT; ++t) { float s = 0.f;
#pragma unroll
                for (int w = 0; w < NWAVES; ++w) s += P[(w * NT + t) * 1024 + e];
                v[t] = s; }
            E.apply(item, e >> 5, e & 31, v);
        }
        __syncthreads();
    }
}
template <class Epi>
__device__ __forceinline__ void skinny_phase8(Frame& F, const unsigned char* A, const unsigned char* Bt, int K, int n_items, const Epi& E) {
    typedef int i32x8 __attribute__((ext_vector_type(8))); typedef int i32x4 __attribute__((ext_vector_type(4)));
    const int r32 = F.lane & 31, hi = F.lane >> 5, nst = K / 64, base = nst / 8, rem = nst - base * 8;
    const int st0 = F.wave * base + (F.wave < rem ? F.wave : rem), nmy = base + (F.wave < rem ? 1 : 0);
    LAS float* P = (LAS float*)F.lds;
    for (int item = F.bid; item < n_items; item += F.G) {
        f32x16 acc = f32x16{};
        const unsigned char* ap = A + (size_t)r32 * K + (size_t)st0 * 64 + hi * 32;
        const unsigned char* bp = Bt + (size_t)(E.tile_row(item, 0) + r32) * K + (size_t)st0 * 64 + hi * 32;
        int s = 0;
        for (; s + 4 <= nmy; s += 4) {
            i32x4 a[8], b[8];
#pragma unroll
            for (int u = 0; u < 4; ++u) { a[2 * u] = *(const i32x4*)(ap + (s + u) * 64); a[2 * u + 1] = *(const i32x4*)(ap + (s + u) * 64 + 16); b[2 * u] = *(const i32x4*)(bp + (s + u) * 64); b[2 * u + 1] = *(const i32x4*)(bp + (s + u) * 64 + 16); }
            __builtin_amdgcn_sched_barrier(0);
#pragma unroll
            for (int u = 0; u < 4; ++u) asm volatile("v_mfma_f32_32x32x64_f8f6f4 %0, %1, %2, %0" : "+v"(acc) : "v"((i32x8){a[2*u][0], a[2*u][1], a[2*u][2], a[2*u][3], a[2*u+1][0], a[2*u+1][1], a[2*u+1][2], a[2*u+1][3]}), "v"((i32x8){b[2*u][0], b[2*u][1], b[2*u][2], b[2*u][3], b[2*u+1][0], b[2*u+1][1], b[2*u+1][2], b[2*u+1][3]}));
            __builtin_amdgcn_sched_barrier(0);
        }
        for (; s < nmy; ++s) {
            const i32x4 a0 = *(const i32x4*)(ap + s * 64), a1 = *(const i32x4*)(ap + s * 64 + 16), b0 = *(const i32x4*)(bp + s * 64), b1 = *(const i32x4*)(bp + s * 64 + 16);
            asm volatile("v_mfma_f32_32x32x64_f8f6f4 %0, %1, %2, %0" : "+v"(acc) : "v"((i32x8){a0[0], a0[1], a0[2], a0[3], a1[0], a1[1], a1[2], a1[3]}), "v"((i32x8){b0[0], b0[1], b0[2], b0[3], b1[0], b1[1], b1[2], b1[3]}));
        }
        asm volatile("s_nop 15\n\ts_nop 15\n\ts_nop 7" : "+v"(acc));
#pragma unroll
        for (int r = 0; r < 16; ++r) P[(F.wave * 32 + att::crow(r, hi)) * 32 + r32] = acc[r];
        __syncthreads();
#pragma unroll
        for (int h = 0; h < 2; ++h) {
            const int e = F.tid + h * 512; float v[1]; float sm = 0.f;
#pragma unroll
            for (int w = 0; w < NWAVES; ++w) sm += P[w * 1024 + e];
            v[0] = sm;
            E.apply(item, e >> 5, e & 31, v);
        }
        __syncthreads();
    }
}
struct SkResid {
    const float* hin; float* h; bf16* hb; rss_t* rss_out; float scale;
    __device__ __forceinline__ int tile_row(int item, int) const { return item * 32; }
    __device__ __forceinline__ void apply(int item, int row, int col, const float (&v)[1]) const {
        const size_t o = (size_t)(MREAL + row) * DM + item * 32 + col;
        const float x = hin[o] + scale * v[0];
        h[o] = x; hb[o] = (bf16)f2bf(x);
        float ss = x * x;
#pragma unroll
        for (int d = 1; d < 32; d <<= 1) ss += __shfl_xor(ss, d);
        if (col == 0) rss_add(rss_out + MREAL + row, ss);
    }
};
struct SkConvIn {
    bf16* bbuf; bf16* ubuf; const rss_t* rss;
    __device__ __forceinline__ int tile_row(int item, int t) const { const int ch = item * 32; return t == 0 ? 2 * DM + ch : (ch >> 7) * 256 + (t == 2 ? 128 : 0) + (ch & 127); }
    __device__ __forceinline__ void apply(int item, int row, int col, const float (&v)[3]) const {
        const float rs = rstd_from_ss(rss[MREAL + row]); const size_t o = (size_t)(MREAL + row) * DM + item * 32 + col;
        bbuf[o] = (bf16)f2bf(v[0] * rs); ubuf[o] = (bf16)f2bf((v[1] * rs) * (v[2] * rs));
    }
};
struct SkKV {
    bf16* k; bf16* v; const rss_t* rss;
    __device__ __forceinline__ int tile_row(int item, int) const { return item * 32; }
    __device__ __forceinline__ void apply(int item, int row, int col, const float (&x)[1]) const {
        const float rs = rstd_from_ss(rss[MREAL + row]); const int kvr = (row >> 4) * KVROWS + (row & 15);
        bf16* dst = item < 32 ? k : v; const int c = (item & 31) * 32 + col;
        dst[(size_t)kvr * (NKV * HD) + c] = (bf16)f2bf(x[0] * rs);
    }
};

__device__ __forceinline__ void rows_init(Frame& F, const float* x, const float* meta, float* h, bf16* hb, rss_t* rss0) {
    const int gw = F.bid * NWAVES + F.wave, NGW = F.G * NWAVES;
    for (int r = gw; r < MVALID; r += NGW) {
        const float* src = r < MREAL ? x + (size_t)r * DM : meta + (size_t)((r - MREAL) & (NMETA - 1)) * DM;
        float ss = 0.f;
#pragma unroll
        for (int j = 0; j < 16; ++j) {
            const f32x4 v = *(const GAS f32x4*)(src + (size_t)(64 * j + F.lane) * 4);
            ss += (v.x * v.x + v.y * v.y) + (v.z * v.z + v.w * v.w);
            const unsigned long long pk = (unsigned long long)pg8::cvt_pk_bf16(v.x, v.y) | ((unsigned long long)pg8::cvt_pk_bf16(v.z, v.w) << 32);
            *(GAS unsigned long long*)(hb + (size_t)r * DM + (size_t)(64 * j + F.lane) * 4) = pk;
            if (r >= MREAL) *(GAS f32x4*)(h + (size_t)r * DM + (size_t)(64 * j + F.lane) * 4) = v;
        }
        ss = wave_sum(ss);
        if (F.lane == 0) rss0[r] = rss_fix(ss);
    }
}
__device__ __forceinline__ void seq_neighbours(int r, int& prev, int& next) {
    if (r < MREAL) { const int b = r >> 13, t = r & (SEQ - 1); prev = t > 0 ? r - 1 : MREAL + b * NMETA + (NMETA - 1); next = t < SEQ - 1 ? r + 1 : -1; }
    else { const int b = (r - MREAL) >> 4, j = (r - MREAL) & 15; prev = j > 0 ? r - 1 : -1; next = j < NMETA - 1 ? r + 1 : b * SEQ; }
}
__device__ __forceinline__ void conv_pass(Frame& F, const bf16* bbuf, const bf16* ubuf, const float* cw, const float* cb, bf16* cv) {
    const int gt = F.bid * (NWAVES * 64) + F.tid, NGT = F.G * NWAVES * 64;
    for (int it = gt; it < (MVALID / 8) * (DM / 8); it += NGT) {
        const int r0 = (it >> 9) * 8, c = (it & 511) * 8; int prev, next, dummy; seq_neighbours(r0, prev, dummy); seq_neighbours(r0 + 7, dummy, next);
        const bf16x8 zero = {0, 0, 0, 0, 0, 0, 0, 0};
        bf16x8 uu[10], bv[8];
        uu[0] = prev >= 0 ? *(const GAS bf16x8*)(ubuf + (size_t)prev * DM + c) : zero;
#pragma unroll
        for (int k = 0; k < 8; ++k) { uu[k + 1] = *(const GAS bf16x8*)(ubuf + (size_t)(r0 + k) * DM + c); bv[k] = *(const GAS bf16x8*)(bbuf + (size_t)(r0 + k) * DM + c); }
        uu[9] = next >= 0 ? *(const GAS bf16x8*)(ubuf + (size_t)next * DM + c) : zero;
        float w0[8], w1[8], w2[8], bb[8];
#pragma unroll
        for (int q = 0; q < 2; ++q) {
            const f32x4 a0 = *(const GAS f32x4*)(cw + c + 4 * q), a1 = *(const GAS f32x4*)(cw + DM + c + 4 * q), a2 = *(const GAS f32x4*)(cw + 2 * DM + c + 4 * q), a3 = *(const GAS f32x4*)(cb + c + 4 * q);
#pragma unroll
            for (int j = 0; j < 4; ++j) { w0[4 * q + j] = a0[j]; w1[4 * q + j] = a1[j]; w2[4 * q + j] = a2[j]; bb[4 * q + j] = a3[j]; }
        }
#pragma unroll
        for (int k = 0; k < 8; ++k) {
            float o[8];
#pragma unroll
            for (int e = 0; e < 8; ++e)
                o[e] = bf2f((unsigned short)bv[k][e]) * (w0[e] * bf2f((unsigned short)uu[k][e]) + w1[e] * bf2f((unsigned short)uu[k + 1][e]) + w2[e] * bf2f((unsigned short)uu[k + 2][e]) + bb[e]);
            v4u w; w.x = pg8::cvt_pk_bf16(o[0], o[1]); w.y = pg8::cvt_pk_bf16(o[2], o[3]); w.z = pg8::cvt_pk_bf16(o[4], o[5]); w.w = pg8::cvt_pk_bf16(o[6], o[7]);
            *(GAS v4u*)(cv + (size_t)(r0 + k) * DM + c) = w;
        }
    }
}
__device__ __forceinline__ void rope_head(bf16* p, const float* gain, float rowpos, float colpos, int i) {
    const float x0 = bf2f(p[i]), x1 = bf2f(p[32 + i]), x2 = bf2f(p[64 + i]), x3 = bf2f(p[96 + i]);
    float ss = (x0 * x0 + x1 * x1) + (x2 * x2 + x3 * x3);
#pragma unroll
    for (int d = 1; d < 32; d <<= 1) ss += __shfl_xor(ss, d);
    const float rs = __builtin_amdgcn_rsqf(ss * (1.0f / (float)HD) + RMS_EPS);
    const float y0 = x0 * rs * gain[i], y1 = x1 * rs * gain[32 + i], y2 = x2 * rs * gain[64 + i], y3 = x3 * rs * gain[96 + i];
    const float inv_freq = __builtin_amdgcn_exp2f(-(float)i * 0.41524101186092029f);
    const float ar = rowpos * inv_freq * 0.15915494309189535f, ac = colpos * inv_freq * 0.15915494309189535f;
    const float cr = __builtin_amdgcn_cosf(ar), sr = __builtin_amdgcn_sinf(ar), cc = __builtin_amdgcn_cosf(ac), sc = __builtin_amdgcn_sinf(ac);
    p[i] = (bf16)f2bf(y0 * cr - y1 * sr); p[32 + i] = (bf16)f2bf(y1 * cr + y0 * sr);
    p[64 + i] = (bf16)f2bf(y2 * cc - y3 * sc); p[96 + i] = (bf16)f2bf(y3 * cc + y2 * sc);
}
__device__ __forceinline__ void k_prep_pass(Frame& F, bf16* K, const float* kg) {
    const int ghw = (F.bid * NWAVES + F.wave) * 2 + (F.lane >> 5), NGHW = F.G * NWAVES * 2, i = F.lane & 31;
    constexpr int NK = NB * (NMETA + SEQ) * NKV;
    static_assert(NK % 2 == 0, "both half-waves of a wave leave the loop together");
    for (int j = ghw; j < NK; j += NGHW) {
        const int key = j >> 3, g = j & 7, b = key / (NMETA + SEQ), p = key - b * (NMETA + SEQ);
        const int kvr = b * KVROWS + (p < NMETA ? p : 64 + (p - NMETA));
        const float rowpos = p < NMETA ? -1.f : (float)((p - NMETA) >> 6), colpos = p < NMETA ? (float)p : (float)((p - NMETA) & 63);
        rope_head(K + (size_t)kvr * (NKV * HD) + g * HD, kg, rowpos, colpos, i);
    }
}
template <bool KEEP16>
__device__ __forceinline__ void kv_prep8_pass(Frame& F, bf16* K, const bf16* V, const float* kg, unsigned char* K8, unsigned char* VT8) {
    {   const int ghw = (F.bid * NWAVES + F.wave) * 2 + (F.lane >> 5), NGHW = F.G * NWAVES * 2, i = F.lane & 31;
        constexpr int NK = NB * (NMETA + SEQ) * NKV;
        for (int j = ghw; j < NK; j += NGHW) {
            const int key = j >> 3, g = j & 7, b = key / (NMETA + SEQ), p = key - b * (NMETA + SEQ);
            const int kvr = b * KVROWS + (p < NMETA ? p : 64 + (p - NMETA));
            const float rowpos = p < NMETA ? -1.f : (float)((p - NMETA) >> 6), colpos = p < NMETA ? (float)p : (float)((p - NMETA) & 63);
            bf16* kp = K + (size_t)kvr * (NKV * HD) + g * HD; unsigned char* k8 = K8 + (size_t)kvr * (NKV * HD) + g * HD;
            const float x0 = bf2f(kp[i]), x1 = bf2f(kp[32 + i]), x2 = bf2f(kp[64 + i]), x3 = bf2f(kp[96 + i]);
            float ss = (x0 * x0 + x1 * x1) + (x2 * x2 + x3 * x3);
#pragma unroll
            for (int d = 1; d < 32; d <<= 1) ss += __shfl_xor(ss, d);
            const float rs = __builtin_amdgcn_rsqf(ss * (1.0f / (float)HD) + RMS_EPS);
            const float y0 = x0 * rs * kg[i], y1 = x1 * rs * kg[32 + i], y2 = x2 * rs * kg[64 + i], y3 = x3 * rs * kg[96 + i];
            const float inv_freq = __builtin_amdgcn_exp2f(-(float)i * 0.41524101186092029f);
            const float ar = rowpos * inv_freq * 0.15915494309189535f, ac = colpos * inv_freq * 0.15915494309189535f;
            const float cr = __builtin_amdgcn_cosf(ar), sr = __builtin_amdgcn_sinf(ar), cc = __builtin_amdgcn_cosf(ac), sc = __builtin_amdgcn_sinf(ac);
            const float o0 = y0 * cr - y1 * sr, o1 = y1 * cr + y0 * sr, o2 = y2 * cc - y3 * sc, o3 = y3 * cc + y2 * sc;
            if (KEEP16) { kp[i] = (bf16)f2bf(o0); kp[32 + i] = (bf16)f2bf(o1); kp[64 + i] = (bf16)f2bf(o2); kp[96 + i] = (bf16)f2bf(o3); }
            const float s8 = att8::FP8_KQ_SCALE;
            k8[att8::k8_pos(i)] = (unsigned char)(att8::pk4(att8::sat8(o0 * s8), 0.f, 0.f, 0.f) & 0xff); k8[att8::k8_pos(32 + i)] = (unsigned char)(att8::pk4(att8::sat8(o1 * s8), 0.f, 0.f, 0.f) & 0xff);
            k8[att8::k8_pos(64 + i)] = (unsigned char)(att8::pk4(att8::sat8(o2 * s8), 0.f, 0.f, 0.f) & 0xff); k8[att8::k8_pos(96 + i)] = (unsigned char)(att8::pk4(att8::sat8(o3 * s8), 0.f, 0.f, 0.f) & 0xff);
        }
    }
    {   const int gw = F.bid * NWAVES + F.wave, NGW = F.G * NWAVES; constexpr int NTILE = KVROWS / 64, NITEM = NB * NKV * NTILE * 2;
        for (int it = gw; it < NITEM; it += NGW) {
            const int dh = it & 1, tile = (it >> 1) % NTILE, bk = (it >> 1) / NTILE, b = bk >> 3, g = bk & 7, d = dh * 64 + F.lane;
            const bf16* vp = V + (size_t)(b * KVROWS + tile * 64) * (NKV * HD) + g * HD + d;
            unsigned char* op = VT8 + ((size_t)(bk * NTILE + tile) * 128 + d) * 64;
#pragma unroll
            for (int q = 0; q < 4; ++q) { v4u w;
#pragma unroll
                for (int c = 0; c < 4; ++c) { float x[4];
#pragma unroll
                    for (int e = 0; e < 4; ++e) { const int key = att8::v8_key(16 * q + 4 * c + e); x[e] = (tile == 0 && key >= NMETA) ? 0.f : att8::sat8(bf2f(vp[(size_t)key * (NKV * HD)]) * att8::FP8_V_SCALE); }
                    w[c] = att8::pk4(x[0], x[1], x[2], x[3]); }
                *(GAS v4u*)(op + 16 * q) = w; }
        }
    }
}
__device__ __forceinline__ void final_norm_pass(Frame& F, const float* h, const rss_t* rss, const float* g, float* out) {
    const int gw = F.bid * NWAVES + F.wave, NGW = F.G * NWAVES;
    for (int r = gw; r < MREAL; r += NGW) {
        const float rs = rstd_from_ss(rss[r]);
#pragma unroll
        for (int j = 0; j < 16; ++j) { const size_t o = (size_t)(64 * j + F.lane) * 4;
            const f32x4 v = *(const GAS f32x4*)(h + (size_t)r * DM + o), gv = *(const GAS f32x4*)(g + o);
            *(GAS f32x4*)(out + (size_t)r * DM + o) = v * rs * gv; }
    }
}

#ifndef MK_ONE_LAUNCH
#define MK_ONE_LAUNCH 1
#endif
#ifndef FP8_DOWN_MASK
#define FP8_DOWN_MASK 0xE
#endif
#ifndef FP8_QKV
#define FP8_QKV 1
#endif
#ifndef FP8_ATTN
#define FP8_ATTN 1
#endif
#ifndef FP8_WO
#define FP8_WO 1
#endif
#ifndef BG_DEFER
#define BG_DEFER 1
#endif
constexpr int N_PHASES = 17;
struct Args { const float* in[21]; float* out; unsigned char* ws; int ph_lo, ph_hi; };
static_assert(sizeof(Args) == 192, "Args has no padding bytes");

__global__ void __launch_bounds__(NWAVES * 64, 2) fwd_kernel(Args args) {
    extern __shared__ __attribute__((aligned(16))) unsigned char lds_raw[];
    Frame F;
    F.lds = (LAS unsigned char*)lds_raw;
    F.tid = threadIdx.x; F.lane = F.tid & 63; F.wave = __builtin_amdgcn_readfirstlane(F.tid >> 6);
    F.G = gridDim.x; F.bid = blockIdx.x;
    volatile LAS unsigned* MISC = (volatile LAS unsigned*)(F.lds + MISC_OFF);
    unsigned char* ws = args.ws;
    gu32* ctl = (gu32*)ws;
    for (int u = F.tid; u < (LDS_BYTES - 139264) / 4; u += NWAVES * 64) ((LAS unsigned*)(F.lds + 139264))[u] = 0u;
    __syncthreads();
    XcdBarrier bar; bar.bar = (unsigned*)(ctl + CW_BAR); bar.x = 0; bar.st = nullptr;
    if (MK_ONE_LAUNCH) bar = xcd_barrier_post((unsigned*)(ctl + CW_BAR), MISC + 8, F.tid == 0);
    const int lo = args.ph_lo, hi = args.ph_hi;
#define REFRAME_(F) ((F).lane = att::lane_id_asm(), (F).tid = (F).wave * 64 + (F).lane)
#define IN(k) (lo <= (k) && (k) < hi && (REFRAME_(F), true))
#define SEAM(k) do { if (MK_ONE_LAUNCH && (lo <= (k) + 1 && (k) + 1 < hi)) xcd_barrier(bar, (REFRAME_(F), F.tid == 0)); } while (0)
#define PH_BEGIN(k) if (IN(k)) {
#define BG_NEED(k) ((k) >= 14 ? BG_TOTAL : (k) == 13 ? BG_B6 : (k) == 12 ? BG_B5 : ((k) == 11 || (k) == 10 || (k) == 9) ? BG_B4 : (k) == 8 ? BG_B2 : (k) == 7 ? BG_B1 : (k) == 6 ? BG_L4 : (k) == 5 ? BG_L3 : ((k) == 4 || (k) == 3) ? BG_L2 : (k) == 2 ? BG_L1 : (k) == 1 ? BG_L0 : 0)
#define BG_SITE(k) ((k) <= 10 || (k) == 12 || (k) == 13 || (k) == 14)
#define PH_END(k) if (BG_DEFER && MK_ONE_LAUNCH && BG_SITE(k)) { REFRAME_(F); bg_drain(F, args.in, ws, MISC, (k), BG_NEED(k)); } SEAM(k); }

    const float* x = args.in[0]; const float* meta = args.in[1];
    const float* conv_norm = args.in[10]; const float* conv_w_in = args.in[11]; const float* conv_w = args.in[12]; const float* conv_b = args.in[13]; const float* conv_w_out = args.in[14];
    const float* attn_norm = args.in[15]; const float* attn_w_qkv = args.in[16]; const float* q_gain = args.in[17]; const float* k_gain = args.in[18]; const float* attn_w_o = args.in[19];
    const float* final_g = args.in[20];
    bf16* WGU = (bf16*)(ws + WS_WGU); bf16* WD = (bf16*)(ws + WS_WD); bf16* WCI = (bf16*)(ws + WS_WCI); bf16* WCO = (bf16*)(ws + WS_WCO); bf16* WQKV = (bf16*)(ws + WS_WQKV); bf16* WO = (bf16*)(ws + WS_WO);
    float* H = (float*)(ws + WS_H); bf16* HB = (bf16*)(ws + WS_HB); bf16* ACT = (bf16*)(ws + WS_ACT); bf16* BB = (bf16*)(ws + WS_BB); bf16* UB = (bf16*)(ws + WS_UB);
    bf16* QB = (bf16*)(ws + WS_Q); bf16* KB = (bf16*)(ws + WS_K); bf16* VB = (bf16*)(ws + WS_V); bf16* AUX = (bf16*)(ws + WS_AUX);
    rss_t* RSS = (rss_t*)(ws + RSS_OFF);
#define RSSK(k) (RSS + (size_t)(k) * MPAD)
    constexpr size_t NWGU = (size_t)2 * DFF * DM, NWD = (size_t)DM * DFF;
#define D8(f) (((FP8_DOWN_MASK >> (f)) & 1) != 0)
    unsigned char* HB8 = ws + WS_HB8; unsigned char* K8 = ws + WS_K8; unsigned char* VT8 = ws + WS_VT8;

    PH_BEGIN(0)
        cvt_matrix<1>(F, args.in[3] + (size_t)0 * DM * DFF, args.in[4] + (size_t)0 * DM * DFF, DFF, args.in[2] + 0 * DM, WGU + 0 * NWGU, DM, 2 * DFF);
        if (D8(0)) cvt_matrix8(F, args.in[5] + (size_t)0 * DFF * DM, DM, nullptr, pg8::FP8_W_SCALE, ws + WS_WD8 + 0 * SZ_WD8, DFF, DM);
        if (!BG_DEFER && (!D8(0))) cvt_matrix<0>(F, args.in[5] + (size_t)0 * DFF * DM, nullptr, DM, nullptr, WD + 0 * NWD, DFF, DM);
        if (!BG_DEFER) { cvt_matrix<1>(F, args.in[7] + (size_t)0 * DM * DFF, args.in[8] + (size_t)0 * DM * DFF, DFF, args.in[6] + 0 * DM, WGU + 1 * NWGU, DM, 2 * DFF); }
        if (!BG_DEFER && (D8(1))) cvt_matrix8(F, args.in[9] + (size_t)0 * DFF * DM, DM, nullptr, pg8::FP8_W_SCALE, ws + WS_WD8 + 1 * SZ_WD8, DFF, DM);
        if (!D8(1)) cvt_matrix<0>(F, args.in[9] + (size_t)0 * DFF * DM, nullptr, DM, nullptr, WD + 1 * NWD, DFF, DM);
        if (!BG_DEFER) cvt_matrix<1>(F, args.in[3] + (size_t)1 * DM * DFF, args.in[4] + (size_t)1 * DM * DFF, DFF, args.in[2] + 1 * DM, WGU + 2 * NWGU, DM, 2 * DFF);
        if (D8(2) && !BG_DEFER) cvt_matrix8(F, args.in[5] + (size_t)1 * DFF * DM, DM, nullptr, pg8::FP8_W_SCALE, ws + WS_WD8 + 2 * SZ_WD8, DFF, DM);
        if (!D8(2)) cvt_matrix<0>(F, args.in[5] + (size_t)1 * DFF * DM, nullptr, DM, nullptr, WD + 2 * NWD, DFF, DM);
        if (!BG_DEFER) cvt_matrix<1>(F, args.in[7] + (size_t)1 * DM * DFF, args.in[8] + (size_t)1 * DM * DFF, DFF, args.in[6] + 1 * DM, WGU + 3 * NWGU, DM, 2 * DFF);
        if (D8(3) && !BG_DEFER) cvt_matrix8(F, args.in[9] + (size_t)1 * DFF * DM, DM, nullptr, pg8::FP8_W_SCALE, ws + WS_WD8 + 3 * SZ_WD8, DFF, DM);
        if (!D8(3)) cvt_matrix<0>(F, args.in[9] + (size_t)1 * DFF * DM, nullptr, DM, nullptr, WD + 3 * NWD, DFF, DM);
        if (!BG_DEFER) { cvt_matrix<2>(F, conv_w_in, nullptr, 3 * DM, conv_norm, WCI, DM, 3 * DM); }
        if (!BG_DEFER) { cvt_matrix<0>(F, conv_w_out, nullptr, DM, nullptr, WCO, DM, DM); }
        if (BG_DEFER) { static_assert(!BG_DEFER || (D8(1) && D8(2) && D8(3) && !D8(0) && FP8_QKV && FP8_WO), "the background queue is written for this configuration"); }
        else if (FP8_QKV) {
            cvt_matrix8(F, attn_w_qkv, NQKV, attn_norm, pg8::FP8_W_SCALE, ws + WS_WQKV8, DM, NQKV);
            cvt_matrix<0>(F, attn_w_qkv + NHEAD * HD, nullptr, NQKV, attn_norm, WQKV + (size_t)NHEAD * HD * DM, DM, 2 * NKV * HD);
        } else cvt_matrix<0>(F, attn_w_qkv, nullptr, NQKV, attn_norm, WQKV, DM, NQKV);
        if (!BG_DEFER) { if (FP8_WO) cvt_matrix8(F, attn_w_o, DM, nullptr, pg8::FP8_W_SCALE, ws + WS_WO8, DM, DM); else cvt_matrix<0>(F, attn_w_o, nullptr, DM, nullptr, WO, DM, DM); }
        rows_init(F, x, meta, H, HB, RSSK(0));
    PH_END(0)

#define FFN_UP(ph, f, rows, rin) PH_BEGIN(ph) \
        pg8::Gemm g{HB, WGU + (size_t)(f) * NWGU, (rows), 2 * DFF, DM}; pg8::StaticOrder S; S.init((rows), 2 * DFF, F.G, F.bid); \
        pg8::EpiSwiGLU<D8(f)> E{ACT, RSSK(rin)}; \
        pg8::gemm_phase<pg8::EpiSwiGLU<D8(f)>, pg8::StaticOrder, true, true>(F.lds, g, S, E, F.wave); \
        PH_END(ph)
#define FFN_DOWN(ph, f, basep, hbp, hb8p, rout, with_meta) PH_BEGIN(ph) \
        pg8::Gemm g{ACT, D8(f) ? (const bf16*)(ws + WS_WD8 + (f) * SZ_WD8) : WD + (size_t)(f) * NWD, MREAL, DM, DFF}; pg8::StaticOrder S; S.init(MREAL, DM, F.G, F.bid); \
        pg8::EpiResid E{(basep), H, (hbp), (hb8p), RSSK(rout), D8(f) ? 0.5f / (pg8::FP8_ACT_SCALE * pg8::FP8_W_SCALE) : 0.5f}; \
        pg8::gemm_phase<pg8::EpiResid, pg8::StaticOrder, true, true, D8(f)>(F.lds, g, S, E, F.wave); \
        if (with_meta) { SkResid SE{H, H, HB, RSSK(rout), D8(f) ? 0.5f / (pg8::FP8_ACT_SCALE * pg8::FP8_W_SCALE) : 0.5f}; \
            if (D8(f)) skinny_phase8<SkResid>(F, (const unsigned char*)ACT + (size_t)MREAL * DFF, ws + WS_WD8 + (f) * SZ_WD8, DFF, DM / 32, SE); \
            else skinny_phase<1, SkResid>(F, ACT + (size_t)MREAL * DFF, WD + (size_t)(f) * NWD, DFF, DM / 32, SE); } \
        PH_END(ph)

    FFN_UP(1, 0, MPAD, 0)
    FFN_DOWN(2, 0, x, HB, (unsigned char*)nullptr, 1, true)
    PH_BEGIN(3)
        pg8::Gemm g{HB, WCI, MREAL, 3 * DM, DM}; pg8::StaticOrder S; S.init(MREAL, 3 * DM, F.G, F.bid);
        pg8::EpiConvIn E{BB, UB, RSSK(1)};
        pg8::gemm_phase<pg8::EpiConvIn, pg8::StaticOrder, true, true>(F.lds, g, S, E, F.wave);
        SkConvIn SE{BB, UB, RSSK(1)}; skinny_phase<3, SkConvIn>(F, HB + (size_t)MREAL * DM, WCI, DM, DM / 32, SE);
    PH_END(3)
    PH_BEGIN(4) conv_pass(F, BB, UB, conv_w, conv_b, AUX); PH_END(4)
    PH_BEGIN(5)
        pg8::Gemm g{AUX, WCO, MREAL, DM, DM}; pg8::StaticOrder S; S.init(MREAL, DM, F.G, F.bid);
        pg8::EpiResid E{H, H, HB, (unsigned char*)nullptr, RSSK(2), 1.0f};
        pg8::gemm_phase<pg8::EpiResid, pg8::StaticOrder, true, true>(F.lds, g, S, E, F.wave);
        SkResid SE{H, H, HB, RSSK(2), 1.0f}; skinny_phase<1, SkResid>(F, AUX + (size_t)MREAL * DM, WCO, DM, DM / 32, SE);
    PH_END(5)
    FFN_UP(6, 1, MPAD, 2)
    FFN_DOWN(7, 1, H, HB, (unsigned char*)nullptr, 3, true)
    FFN_UP(8, 2, MPAD, 3)
    FFN_DOWN(9, 2, H, FP8_QKV ? (bf16*)nullptr : HB, FP8_QKV ? HB8 : (unsigned char*)nullptr, 4, true)
    PH_BEGIN(10)
        pg8::Gemm g{FP8_QKV ? (const bf16*)HB8 : HB, FP8_QKV ? (const bf16*)(ws + WS_WQKV8) : WQKV, MREAL, NQKV, DM}; pg8::StaticOrder S; S.init(MREAL, NQKV, F.G, F.bid);
        pg8::EpiQKV E{QB, KB, VB, RSSK(4), FP8_QKV ? 1.0f / (pg8::FP8_H_SCALE * pg8::FP8_W_SCALE) : 1.0f};
        pg8::gemm_phase<pg8::EpiQKV, pg8::StaticOrder, true, true, FP8_QKV != 0>(F.lds, g, S, E, F.wave);
        SkKV SE{KB, VB, RSSK(4)}; skinny_phase<1, SkKV>(F, HB + (size_t)MREAL * DM, WQKV + (size_t)NHEAD * HD * DM, DM, 2 * NKV * HD / 32, SE);
        for (int i = F.bid * (NWAVES * 64) + F.tid; i < NB * 48 * (NKV * HD / 8); i += F.G * NWAVES * 64) {
            const int b = i / (48 * 128), r = (i / 128) % 48, c = (i & 127) * 8; const size_t o = (size_t)(b * KVROWS + NMETA + r) * (NKV * HD) + c;
            *(GAS v4u*)(KB + o) = (v4u){0u, 0u, 0u, 0u}; *(GAS v4u*)(VB + o) = (v4u){0u, 0u, 0u, 0u};
        }
    PH_END(10)
    PH_BEGIN(11) if (FP8_ATTN) kv_prep8_pass<false>(F, KB, VB, k_gain, K8, VT8); else k_prep_pass(F, KB, k_gain); PH_END(11)
    PH_BEGIN(12)
        constexpr int NUNITS = NB * NHEAD * (SEQ / 256);
        const bool xcd_deal = (F.G == 256);
        for (int i = 0;; ++i) {
            int un;
            if (xcd_deal) { if (i >= 8) break; un = (F.bid & 7) * 256 + i * 32 + (F.bid >> 3); } else { un = i * F.G + F.bid; if (un >= NUNITS) break; }
            const int grp = un >> 7, rem = un & 127, b = grp >> 3, kvh = grp & 7, hq = kvh * 4 + (rem >> 5), qb = rem & 31;
            const size_t qoff = (size_t)(b * SEQ + qb * 256) * DM + hq * HD, koff = (size_t)(b * KVROWS) * (NKV * HD) + kvh * HD;
            if (FP8_ATTN) att8::attn_unit8(QB + qoff, K8 + koff, VT8 + (size_t)grp * (KVROWS / 64) * 8192, (unsigned char*)AUX + qoff, (char*)lds_raw, F.lds, F.wave, q_gain, qb * 256);
            else att::attn_unit<FP8_WO != 0>(QB + qoff, KB + koff, VB + koff, FP8_WO ? (void*)((unsigned char*)AUX + qoff) : (void*)(AUX + qoff), (char*)lds_raw, F.wave, q_gain, qb * 256);
        }
    PH_END(12)
    PH_BEGIN(13)
        pg8::Gemm g{AUX, FP8_WO ? (const bf16*)(ws + WS_WO8) : WO, MREAL, DM, DM}; pg8::StaticOrder S; S.init(MREAL, DM, F.G, F.bid);
        pg8::EpiResid E{H, H, HB, (unsigned char*)nullptr, RSSK(5), FP8_WO ? 1.0f / (pg8::FP8_O_SCALE * pg8::FP8_W_SCALE) : 1.0f};
        pg8::gemm_phase<pg8::EpiResid, pg8::StaticOrder, true, true, FP8_WO != 0>(F.lds, g, S, E, F.wave);
    PH_END(13)
    FFN_UP(14, 3, MREAL, 5)
    FFN_DOWN(15, 3, H, (bf16*)nullptr, (unsigned char*)nullptr, 6, false)
    PH_BEGIN(16) final_norm_pass(F, H, RSSK(6), final_g, args.out); PH_END(16)
#undef IN
#undef SEAM
}

extern "C" void kernel_launch(void* const* d_in, const int* in_sizes, int n_in, void* d_out, int out_size, void* d_ws, size_t ws_size, hipStream_t stream) {
    static int grid = 0;
    if (grid == 0) {
        if (n_in != 21 || in_sizes[0] != MREAL * DM || out_size != MREAL * DM || ws_size < WS_END) {
            fprintf(stderr, "kernel_launch: built for 21 inputs, x/out of %d floats, >= %zu bytes of workspace; got n_in %d, in0 %d, out %d, ws %zu; nothing launched\n", MREAL * DM, (size_t)WS_END, n_in, n_in > 0 ? in_sizes[0] : -1, out_size, ws_size);
            grid = -1; return; }
        int dev = 0, cus = 0, per_cu = 0;
        if (hipGetDevice(&dev) != hipSuccess || hipDeviceGetAttribute(&cus, hipDeviceAttributeMultiprocessorCount, dev) != hipSuccess) { fprintf(stderr, "kernel_launch: device query failed\n"); grid = -1; return; }
        if (hipFuncSetAttribute((const void*)fwd_kernel, hipFuncAttributeMaxDynamicSharedMemorySize, LDS_BYTES) != hipSuccess) { fprintf(stderr, "kernel_launch: hipFuncSetAttribute failed\n"); grid = -1; return; }
        if (hipOccupancyMaxActiveBlocksPerMultiprocessor(&per_cu, (const void*)fwd_kernel, NWAVES * 64, LDS_BYTES) != hipSuccess || per_cu < 1)
            fprintf(stderr, "kernel_launch: note: occupancy query reports %d workgroups per CU\n", per_cu);
        (void)hipGetLastError();
        grid = cus;
    }
    if (grid < 0) return;
    if (hipMemsetAsync(d_ws, 0, CTL_ZERO_BYTES, stream) != hipSuccess) { fprintf(stderr, "kernel_launch: hipMemsetAsync failed\n"); return; }
    Args a{};
    for (int i = 0; i < 21; ++i) a.in[i] = (const float*)d_in[i];
    a.out = (float*)d_out; a.ws = (unsigned char*)d_ws;
#if MK_ONE_LAUNCH
    a.ph_lo = 0; a.ph_hi = N_PHASES;
    hipLaunchKernelGGL(fwd_kernel, dim3(grid), dim3(NWAVES * 64), LDS_BYTES, stream, a);
#else
    for (int p = 0; p < N_PHASES; ++p) { a.ph_lo = p; a.ph_hi = p + 1; hipLaunchKernelGGL(fwd_kernel, dim3(grid), dim3(NWAVES * 64), LDS_BYTES, stream, a); }
#endif
    const hipError_t le = hipPeekAtLastError();
    if (le != hipSuccess) fprintf(stderr, "kernel_launch: launch failed: %s\n", hipGetErrorName(le));
}
```

```cpp
#include <hip/hip_runtime.h>
#include <hip/hip_bf16.h>
#include <cstdio>
#include <cstdint>

constexpr int DM = 4096, DFF = 11008, SEQ = 8192, NB = 2, NMETA = 16, NHEAD = 32, NKV = 8, HD = 128;
constexpr int MREAL = NB * SEQ;
constexpr int MVALID = MREAL + NB * NMETA;
constexpr int MPAD = 16640;
constexpr int KVROWS = 64 + SEQ;
constexpr int NQKV = (NHEAD + 2 * NKV) * HD;
constexpr float RMS_EPS = 1e-6f;

typedef unsigned long long rss_t;
constexpr float RSS_FX = 16777216.0f;
__device__ __forceinline__ rss_t rss_fix(float ss) { return (rss_t)(ss * RSS_FX + 0.5f); }
__device__ __forceinline__ void rss_add(rss_t* p, float ss) { (void)__hip_atomic_fetch_add(p, rss_fix(ss), __ATOMIC_RELAXED, __HIP_MEMORY_SCOPE_AGENT); }
__device__ __forceinline__ float rstd_from_ss(rss_t v) { return __builtin_amdgcn_rsqf((float)v * (1.0f / (RSS_FX * (float)DM)) + RMS_EPS); }
__device__ __forceinline__ float silu_f(float x) { return x * __builtin_amdgcn_rcpf(1.0f + __builtin_amdgcn_exp2f(-1.4426950408889634f * x)); }
__device__ __forceinline__ int kv_row_of_real(int row) { return (row >> 13) * KVROWS + 64 + (row & (SEQ - 1)); }

namespace pg8 {
#define PG8_LAS __attribute__((address_space(3)))
typedef unsigned short bf16_t;
typedef short bf16x8 __attribute__((ext_vector_type(8)));
typedef float f32x4 __attribute__((ext_vector_type(4)));
typedef unsigned u32x4 __attribute__((ext_vector_type(4)));
constexpr int BM = 256, BK = 64, HALF = 128, HTB = HALF * BK * 2  , STAGE_BYTES = 8 * HTB, NXCD = 8, WGM = 8;

__host__ __device__ __forceinline__ int lds_byte(int r, int c) { const int st = (r >> 4) * 2 + (c >> 5), rr = r & 15, cc = c & 31, ob = rr * 64 + cc * 2; return st * 1024 + (ob ^ (((ob >> 9) & 1) << 5)); }
__host__ __device__ __forceinline__ void stage_rc(int b, int& R, int& C) { const int st = b / 1024, sb = b % 1024, swz = sb ^ (((sb >> 9) & 1) << 5); R = (st >> 1) * 16 + swz / 64; C = (st & 1) * 32 + (swz % 64) / 2; }
__host__ __device__ __forceinline__ int perm32(int rho) { const int n = rho >> 4, i = rho & 15; return 8 * (i >> 2) + 4 * n + (i & 3); }

struct Unit { int pm, pn; };
struct Gemm { const bf16_t* A; const bf16_t* Bt; int M, N, K; };

struct StaticOrder {
    int nM, nN, nwg, G, c;
    __host__ __device__ void init(int M, int N, int G_, int c_) { nM = M / BM; nN = N / BM; nwg = nM * nN; G = G_; c = c_; }
    __host__ __device__ bool next(int i, Unit& u) const {
        const long L = (long)i * G + c; if (L >= nwg) return false;
        int wgid = (int)L; { const int q = nwg / NXCD, r = nwg % NXCD, xcd = wgid % NXCD, off = wgid / NXCD; wgid = (xcd < r ? xcd * (q + 1) : r * (q + 1) + (xcd - r) * q) + off; }
        const int nig = WGM * nN, gid = wgid / nig, fm = gid * WGM, gsz = (nM - fm) < WGM ? (nM - fm) : WGM;
        u.pm = fm + ((wgid % nig) % gsz); u.pn = (wgid % nig) / gsz; return true;
    }
    __device__ __forceinline__ void a_ready(const Unit&) const {}
    __device__ __forceinline__ void done(const Unit&) const {}
};

__device__ __forceinline__ unsigned cvt_pk_bf16(float lo, float hi) { unsigned r; asm volatile("v_cvt_pk_bf16_f32 %0, %1, %2" : "=v"(r) : "v"(lo), "v"(hi)); return r; }

__device__ __forceinline__ u32x4 pack8(const f32x4 a, const f32x4 b) { u32x4 w; w.x = cvt_pk_bf16(a[0], a[1]); w.y = cvt_pk_bf16(a[2], a[3]); w.z = cvt_pk_bf16(b[0], b[1]); w.w = cvt_pk_bf16(b[2], b[3]); return w; }

typedef int i32x8 __attribute__((ext_vector_type(8)));
__device__ __forceinline__ i32x8 cat8(const bf16x8 a, const bf16x8 b) { typedef int i32x4 __attribute__((ext_vector_type(4))); const i32x4 x = __builtin_bit_cast(i32x4, a), y = __builtin_bit_cast(i32x4, b); return (i32x8){x[0], x[1], x[2], x[3], y[0], y[1], y[2], y[3]}; }
__device__ __forceinline__ unsigned pack_fp8x4(const f32x4 v) {
    int w = 0;
    w = __builtin_amdgcn_cvt_pk_fp8_f32(__builtin_amdgcn_fmed3f(v[0], -448.f, 448.f), __builtin_amdgcn_fmed3f(v[1], -448.f, 448.f), w, false);
    w = __builtin_amdgcn_cvt_pk_fp8_f32(__builtin_amdgcn_fmed3f(v[2], -448.f, 448.f), __builtin_amdgcn_fmed3f(v[3], -448.f, 448.f), w, true);
    return (unsigned)w;
}
constexpr float FP8_ACT_SCALE = 4.f, FP8_W_SCALE = 64.f, FP8_H_SCALE = 8.f, FP8_O_SCALE = 16.f;

template <bool OUT8> struct EpiSwiGLU {
    static constexpr bool PERM = true, AFTER_DRAIN = false;
    bf16_t* act; const rss_t* rss;
    __device__ __forceinline__ void operator()(const f32x4 (&acc)[2][2][4][2], const Unit& u, int wr, int wc, int fr, int fq) const {
        const int row0 = u.pm * BM + wr * 64 + fr, col0 = u.pn * 128 + wc * 32 + 8 * fq;
        rss_t rv[2][4];
#pragma unroll
        for (int ai = 0; ai < 2; ++ai)
#pragma unroll
            for (int m = 0; m < 4; ++m) rv[ai][m] = rss[row0 + ai * HALF + m * 16];
#pragma unroll
        for (int ai = 0; ai < 2; ++ai)
#pragma unroll
            for (int m = 0; m < 4; ++m) {
                const int row = row0 + ai * HALF + m * 16;
                const float rs = rstd_from_ss(rv[ai][m]);
                f32x4 o[2];
#pragma unroll
                for (int n = 0; n < 2; ++n)
#pragma unroll
                    for (int j = 0; j < 4; ++j) o[n][j] = silu_f(acc[ai][0][m][n][j] * rs) * (acc[ai][1][m][n][j] * rs);
                if constexpr (OUT8) { typedef unsigned u32x2 __attribute__((ext_vector_type(2))); *(u32x2*)((unsigned char*)act + (size_t)row * DFF + col0) = (u32x2){pack_fp8x4(o[0] * FP8_ACT_SCALE), pack_fp8x4(o[1] * FP8_ACT_SCALE)}; }
                else *(u32x4*)(act + (size_t)row * DFF + col0) = pack8(o[0], o[1]);
            }
    }
};

struct EpiResid {
    static constexpr bool PERM = true, AFTER_DRAIN = false;
    const float* base; float* out; bf16_t* hb; unsigned char* hb8; rss_t* rss_out; float scale;
    __device__ __forceinline__ void operator()(const f32x4 (&acc)[2][2][4][2], const Unit& u, int wr, int wc, int fr, int fq) const {
        const int lane = fq * 16 + fr;
        const int row0 = u.pm * BM + wr * 64 + fr, colb = u.pn * BM + wc * 32 + 8 * fq;
        f32x4 bv[4][2][2];
#define RESID_LOADM(ai, m) _Pragma("unroll") for (int bj = 0; bj < 2; ++bj) { const size_t o = (size_t)(row0 + (ai) * HALF + (m) * 16) * DM + colb + bj * HALF; \
            bv[m][bj][0] = __builtin_nontemporal_load((const f32x4*)(base + o)); bv[m][bj][1] = __builtin_nontemporal_load((const f32x4*)(base + o + 4)); }
#define RESID_ROWM(ai, m, sel) do { const size_t ro = (size_t)(row0 + (ai) * HALF + (m) * 16) * DM + colb; float ss = 0.f; \
            _Pragma("unroll") for (int bj = 0; bj < 2; ++bj) { const size_t o = ro + bj * HALF; \
                const f32x4 v0 = bv[m][bj][0] + acc[ai][bj][m][0] * scale, v1 = bv[m][bj][1] + acc[ai][bj][m][1] * scale; \
                __builtin_nontemporal_store(v0, (f32x4*)(out + o)); __builtin_nontemporal_store(v1, (f32x4*)(out + o + 4));     \
                if (hb) *(u32x4*)(hb + o) = pack8(v0, v1); \
                if (hb8) { typedef unsigned u32x2 __attribute__((ext_vector_type(2))); *(u32x2*)(hb8 + o) = (u32x2){pack_fp8x4(v0 * FP8_H_SCALE), pack_fp8x4(v1 * FP8_H_SCALE)}; } \
                ss += (v0[0] * v0[0] + v0[1] * v0[1]) + (v0[2] * v0[2] + v0[3] * v0[3]) + (v1[0] * v1[0] + v1[1] * v1[1]) + (v1[2] * v1[2] + v1[3] * v1[3]); } \
            ss += __shfl_xor(ss, 16); ss += __shfl_xor(ss, 32); sel = (fq == (m)) ? ss : sel; } while (0)
        float sel0 = 0.f, sel1 = 0.f;
#pragma unroll
        for (int m = 0; m < 4; ++m) RESID_LOADM(0, m)
#pragma unroll
        for (int m = 0; m < 4; ++m) { RESID_ROWM(0, m, sel0); asm volatile("" ::: "memory"); RESID_LOADM(1, m) asm volatile("" ::: "memory"); }
        rss_add(rss_out + u.pm * BM + 0 * HALF + wr * 64 + lane, sel0);
#pragma unroll
        for (int m = 0; m < 4; ++m) RESID_ROWM(1, m, sel1);
        rss_add(rss_out + u.pm * BM + 1 * HALF + wr * 64 + lane, sel1);
#undef RESID_LOADM
#undef RESID_ROWM
    }
};

struct EpiConvIn {
    static constexpr bool PERM = true, AFTER_DRAIN = false;
    bf16_t* bbuf; bf16_t* ubuf; const rss_t* rss;
    __device__ __forceinline__ void operator()(const f32x4 (&acc)[2][2][4][2], const Unit& u, int wr, int wc, int fr, int fq) const {
        const int row0 = u.pm * BM + wr * 64 + fr;
        rss_t rv[2][4];
#pragma unroll
        for (int ai = 0; ai < 2; ++ai)
#pragma unroll
            for (int m = 0; m < 4; ++m) rv[ai][m] = rss[row0 + ai * HALF + m * 16];
        if (u.pn < 32) {
            const int col0 = u.pn * 128 + wc * 32 + 8 * fq;
#pragma unroll
            for (int ai = 0; ai < 2; ++ai)
#pragma unroll
                for (int m = 0; m < 4; ++m) {
                    const int row = row0 + ai * HALF + m * 16;
                    const float rs = rstd_from_ss(rv[ai][m]);
                    f32x4 o[2];
#pragma unroll
                    for (int n = 0; n < 2; ++n) o[n] = (acc[ai][0][m][n] * rs) * (acc[ai][1][m][n] * rs);
                    *(u32x4*)(ubuf + (size_t)row * DM + col0) = pack8(o[0], o[1]);
                }
        } else {
            const int colb = (u.pn - 32) * BM + wc * 32 + 8 * fq;
#pragma unroll
            for (int ai = 0; ai < 2; ++ai)
#pragma unroll
                for (int m = 0; m < 4; ++m) {
                    const int row = row0 + ai * HALF + m * 16;
                    const float rs = rstd_from_ss(rv[ai][m]);
#pragma unroll
                    for (int bj = 0; bj < 2; ++bj) *(u32x4*)(bbuf + (size_t)row * DM + colb + bj * HALF) = pack8(acc[ai][bj][m][0] * rs, acc[ai][bj][m][1] * rs);
                }
        }
    }
};

struct EpiQKV {
    static constexpr bool PERM = true, AFTER_DRAIN = false;
    bf16_t* q; bf16_t* k; bf16_t* v; const rss_t* rss; float cs;
    __device__ __forceinline__ void operator()(const f32x4 (&acc)[2][2][4][2], const Unit& u, int wr, int wc, int fr, int fq) const {
        const int row0 = u.pm * BM + wr * 64 + fr;
        bf16_t* dst; int ld, colb; const bool isq = u.pn < 16;
        if (isq) { dst = q; ld = DM; colb = u.pn * BM; } else if (u.pn < 20) { dst = k; ld = NKV * HD; colb = (u.pn - 16) * BM; } else { dst = v; ld = NKV * HD; colb = (u.pn - 20) * BM; }
        colb += wc * 32 + 8 * fq;
        rss_t rv[2][4];
#pragma unroll
        for (int ai = 0; ai < 2; ++ai)
#pragma unroll
            for (int m = 0; m < 4; ++m) rv[ai][m] = rss[row0 + ai * HALF + m * 16];
#pragma unroll
        for (int ai = 0; ai < 2; ++ai)
#pragma unroll
            for (int m = 0; m < 4; ++m) {
                const int row = row0 + ai * HALF + m * 16;
                const float rs = rstd_from_ss(rv[ai][m]) * cs;
                const int drow = isq ? row : kv_row_of_real(row);
#pragma unroll
                for (int bj = 0; bj < 2; ++bj) *(u32x4*)(dst + (size_t)drow * ld + colb + bj * HALF) = pack8(acc[ai][bj][m][0] * rs, acc[ai][bj][m][1] * rs);
            }
    }
};

template <class Epi, class Sched, bool ALIGN_EPI = false, bool SP2 = false, bool FP8 = false>
__device__ __forceinline__ void gemm_phase(PG8_LAS unsigned char* lds, const Gemm g, const Sched& S, const Epi& E, const int wid) {
    int lane; asm volatile("v_mbcnt_lo_u32_b32 %0, -1, 0\n\tv_mbcnt_hi_u32_b32 %0, -1, %0" : "=v"(lane));
    const int tid = wid * 64 + lane, wr = wid >> 2, wc = wid & 3, fr = lane & 15, fq = lane >> 4;
    const int KB = FP8 ? g.K : 2 * g.K, nt = KB / (BK * 2);
    unsigned voffA[2], voffB[2];
#pragma unroll
    for (int i = 0; i < 2; ++i) { int R, C; stage_rc(tid * 16 + i * 8192, R, C); const int Rb = Epi::PERM ? ((R & ~31) + perm32(R & 31)) : R;
        voffA[i] = (unsigned)(R * KB + C * 2); voffB[i] = (unsigned)(Rb * KB + C * 2); }
    const size_t kstep = (size_t)(BK * 2);
    const size_t hstep = (size_t)HALF * KB;
    const size_t tstep = 2 * hstep;
    const unsigned ldsw = (unsigned)wid * 1024u;
    const int aoff = lds_byte(wr * 64 + fr, fq * 8), boff = lds_byte(wc * 32 + fr, fq * 8);
#define PG8_SA(b, h) (((b) * 2 + (h)) * HTB)
#define PG8_SB(b, h) ((4 + (b) * 2 + (h)) * HTB)
#define PG8_STAGE(bufoff, gbase, voff) do { _Pragma("unroll") for (int _i = 0; _i < 2; ++_i) \
        __builtin_amdgcn_global_load_lds((const unsigned*)((const char*)(gbase) + (voff)[_i]), (PG8_LAS unsigned*)(lds + (bufoff) + ldsw + _i * 8192), 16, 0, 0); } while (0)
#define PG8_LDA(dst, b, h) do { _Pragma("unroll") for (int m = 0; m < 4; ++m) _Pragma("unroll") for (int k = 0; k < 2; ++k) dst[m][k] = *(const PG8_LAS bf16x8*)(lds + PG8_SA(b, h) + aoff + m * 2048 + k * 1024); } while (0)
#define PG8_LDB(dst, b, h) do { _Pragma("unroll") for (int n = 0; n < 2; ++n) _Pragma("unroll") for (int k = 0; k < 2; ++k) dst[n][k] = *(const PG8_LAS bf16x8*)(lds + PG8_SB(b, h) + boff + n * 2048 + k * 1024); } while (0)
#define PG8_MMA(ai, bj, At, Bt) do { __builtin_amdgcn_s_setprio(1); if constexpr (FP8) { _Pragma("unroll") for (int m = 0; m < 4; ++m) _Pragma("unroll") for (int n = 0; n < 2; ++n) \
        asm volatile("v_mfma_f32_16x16x128_f8f6f4 %0, %1, %2, %0" : "+v"(acc[ai][bj][m][n]) : "v"(cat8(Bt[n][0], Bt[n][1])), "v"(cat8(At[m][0], At[m][1]))); } \
        else { _Pragma("unroll") for (int m = 0; m < 4; ++m) _Pragma("unroll") for (int n = 0; n < 2; ++n) _Pragma("unroll") for (int k = 0; k < 2; ++k) \
        acc[ai][bj][m][n] = __builtin_amdgcn_mfma_f32_16x16x32_bf16(Bt[n][k], At[m][k], acc[ai][bj][m][n], 0, 0, 0); } __builtin_amdgcn_s_setprio(0); } while (0)
#define PG8_WAIT_V(n) asm volatile("s_waitcnt vmcnt(" #n ")" ::: "memory")
#define PG8_WAIT_L(n) asm volatile("s_waitcnt lgkmcnt(" #n ")" ::: "memory")
#define PG8_BAR __builtin_amdgcn_s_barrier()
#define PG8_SCHED __builtin_amdgcn_sched_barrier(0)
    Unit cur, nxt; int ui = 0;
    if (!S.next(0, cur)) return;
    f32x4 acc[2][2][4][2];
#pragma unroll
    for (int a = 0; a < 2; ++a)
#pragma unroll
        for (int b = 0; b < 2; ++b)
#pragma unroll
            for (int m = 0; m < 4; ++m)
#pragma unroll
                for (int n = 0; n < 2; ++n) acc[a][b][m][n] = (f32x4){0.f, 0.f, 0.f, 0.f};
    bf16x8 At[4][2], B0[2][2], B1[2][2];
    const char* cA = (const char*)g.A + (size_t)cur.pm * tstep; const char* cB = (const char*)g.Bt + (size_t)cur.pn * tstep;
    S.a_ready(cur);
    if constexpr (SP2) {
        PG8_STAGE(PG8_SB(0, 0), cB, voffB); PG8_STAGE(PG8_SB(0, 1), cB + hstep, voffB); PG8_STAGE(PG8_SA(0, 0), cA, voffA); PG8_STAGE(PG8_SA(0, 1), cA + hstep, voffA);
        if (wr == 1) PG8_BAR;
        PG8_WAIT_V(2); PG8_BAR;
        PG8_STAGE(PG8_SB(1, 0), cB + kstep, voffB); PG8_STAGE(PG8_SA(1, 0), cA + kstep, voffA); PG8_STAGE(PG8_SB(1, 1), cB + hstep + kstep, voffB);
        PG8_WAIT_V(6); PG8_BAR;
    } else {
        PG8_STAGE(PG8_SB(0, 0), cB, voffB); PG8_STAGE(PG8_SA(0, 0), cA, voffA); PG8_STAGE(PG8_SB(0, 1), cB + hstep, voffB); PG8_STAGE(PG8_SA(0, 1), cA + hstep, voffA);
        if (wr == 1) PG8_BAR;
        PG8_WAIT_V(4); PG8_BAR;
        PG8_STAGE(PG8_SB(1, 0), cB + kstep, voffB); PG8_STAGE(PG8_SA(1, 0), cA + kstep, voffA); PG8_STAGE(PG8_SB(1, 1), cB + hstep + kstep, voffB);
        PG8_WAIT_V(6); PG8_BAR;
    }
    for (;;) {
        const bool has_next = S.next(ui + 1, nxt);
        const char* nA = has_next ? (const char*)g.A + (size_t)nxt.pm * tstep : cA; const char* nB = has_next ? (const char*)g.Bt + (size_t)nxt.pn * tstep : cB;
        for (int t = 0; t < nt; t += 2) {
            const bool last = (t == nt - 2);
            const char* a1 = cA + (size_t)(t + 1) * kstep;
            const char* a2 = last ? nA : cA + (size_t)(t + 2) * kstep; const char* b2 = last ? nB : cB + (size_t)(t + 2) * kstep;
            const char* a3 = a2 + kstep; const char* b3 = b2 + kstep;
            if (last && has_next) S.a_ready(nxt);
            if constexpr (SP2) {
            PG8_LDB(B0, 0, 0); PG8_LDB(B1, 0, 1); PG8_SCHED; PG8_LDA(At, 0, 0); PG8_STAGE(PG8_SA(1, 1), a1 + hstep, voffA);
            PG8_WAIT_V(8); PG8_WAIT_L(0); PG8_BAR; PG8_MMA(0, 0, At, B0); PG8_MMA(0, 1, At, B1); PG8_BAR; PG8_SCHED;
            PG8_LDA(At, 0, 1); PG8_STAGE(PG8_SB(0, 0), b2, voffB); PG8_STAGE(PG8_SB(0, 1), b2 + hstep, voffB); PG8_STAGE(PG8_SA(0, 0), a2, voffA);
            PG8_WAIT_V(8); PG8_WAIT_L(0); PG8_BAR; PG8_MMA(1, 0, At, B0); PG8_MMA(1, 1, At, B1); PG8_BAR; PG8_SCHED;
            PG8_LDB(B0, 1, 0); PG8_LDB(B1, 1, 1); PG8_SCHED; PG8_LDA(At, 1, 0); PG8_STAGE(PG8_SA(0, 1), a2 + hstep, voffA);
            PG8_WAIT_V(8); PG8_WAIT_L(0); PG8_BAR; PG8_MMA(0, 0, At, B0); PG8_MMA(0, 1, At, B1); PG8_BAR; PG8_SCHED;
            PG8_LDA(At, 1, 1); PG8_STAGE(PG8_SB(1, 0), b3, voffB); PG8_STAGE(PG8_SB(1, 1), b3 + hstep, voffB); PG8_STAGE(PG8_SA(1, 0), a3, voffA);
            PG8_WAIT_V(8); PG8_WAIT_L(0); PG8_BAR; PG8_MMA(1, 0, At, B0); PG8_MMA(1, 1, At, B1); PG8_BAR; PG8_SCHED;
            } else {
            PG8_LDB(B0, 0, 0); PG8_SCHED; PG8_LDA(At, 0, 0); PG8_STAGE(PG8_SA(1, 1), a1 + hstep, voffA);
            PG8_WAIT_L(8); PG8_BAR; PG8_WAIT_L(0); PG8_MMA(0, 0, At, B0); PG8_BAR; PG8_SCHED;
            PG8_LDB(B1, 0, 1); PG8_STAGE(PG8_SB(0, 0), b2, voffB);
            PG8_BAR; PG8_WAIT_L(0); PG8_MMA(0, 1, At, B1); PG8_BAR;
            PG8_LDA(At, 0, 1); PG8_STAGE(PG8_SA(0, 0), a2, voffA);
            PG8_BAR; PG8_WAIT_L(0); PG8_MMA(1, 0, At, B0); PG8_BAR; PG8_SCHED;
            PG8_STAGE(PG8_SB(0, 1), b2 + hstep, voffB);
            PG8_WAIT_V(6); PG8_BAR; PG8_MMA(1, 1, At, B1); PG8_BAR;
            PG8_LDB(B0, 1, 0); PG8_SCHED; PG8_LDA(At, 1, 0); PG8_STAGE(PG8_SA(0, 1), a2 + hstep, voffA);
            PG8_WAIT_L(8); PG8_BAR; PG8_WAIT_L(0); PG8_MMA(0, 0, At, B0); PG8_BAR; PG8_SCHED;
            PG8_LDB(B1, 1, 1); PG8_STAGE(PG8_SB(1, 0), b3, voffB);
            PG8_BAR; PG8_WAIT_L(0); PG8_MMA(0, 1, At, B1); PG8_BAR;
            PG8_LDA(At, 1, 1); PG8_STAGE(PG8_SA(1, 0), a3, voffA);
            PG8_BAR; PG8_WAIT_L(0); PG8_MMA(1, 0, At, B0); PG8_BAR; PG8_SCHED;
            PG8_STAGE(PG8_SB(1, 1), b3 + hstep, voffB);
            PG8_WAIT_V(6); PG8_BAR; PG8_MMA(1, 1, At, B1); PG8_BAR;
            }
        }
        if constexpr (FP8) {
            asm volatile("s_nop 15\n\ts_nop 15" : "+v"(At[0][0]), "+v"(At[0][1]), "+v"(At[1][0]), "+v"(At[1][1]), "+v"(At[2][0]), "+v"(At[2][1]), "+v"(At[3][0]), "+v"(At[3][1]),
                         "+v"(B0[0][0]), "+v"(B0[0][1]), "+v"(B0[1][0]), "+v"(B0[1][1]), "+v"(B1[0][0]), "+v"(B1[0][1]), "+v"(B1[1][0]), "+v"(B1[1][1]) :: "memory");
        }
        if constexpr (ALIGN_EPI) { if (wr == 0) PG8_BAR; }
        if constexpr (FP8) {
            asm volatile("s_nop 15\n\ts_nop 15\n\ts_nop 7" : "+v"(acc[1][1][0][0]), "+v"(acc[1][1][0][1]), "+v"(acc[1][1][1][0]), "+v"(acc[1][1][1][1]), "+v"(acc[1][1][2][0]), "+v"(acc[1][1][2][1]), "+v"(acc[1][1][3][0]), "+v"(acc[1][1][3][1]) :: "memory");
            asm volatile("" : "+v"(acc[1][0][0][0]), "+v"(acc[1][0][0][1]), "+v"(acc[1][0][1][0]), "+v"(acc[1][0][1][1]), "+v"(acc[1][0][2][0]), "+v"(acc[1][0][2][1]), "+v"(acc[1][0][3][0]), "+v"(acc[1][0][3][1]));
        }
        if constexpr (!Epi::AFTER_DRAIN) { E(acc, cur, wr, wc, fr, fq); S.done(cur); }
        if (!has_next) break;
#pragma unroll
        for (int a = 0; a < 2; ++a)
#pragma unroll
            for (int b = 0; b < 2; ++b)
#pragma unroll
                for (int m = 0; m < 4; ++m)
#pragma unroll
                    for (int n = 0; n < 2; ++n) acc[a][b][m][n] = (f32x4){0.f, 0.f, 0.f, 0.f};
        cur = nxt; cA = nA; cB = nB; ++ui;
        if constexpr (ALIGN_EPI) { if (wr == 1) PG8_BAR; }
    }
    PG8_WAIT_V(0);
    if constexpr (!ALIGN_EPI) { if (wr == 0) PG8_BAR; }
    PG8_BAR;
    if constexpr (Epi::AFTER_DRAIN) { E.fused(acc, cur, wr, wc, fr, fq, lds, wid, lane); S.done(cur); }
#undef PG8_SA
#undef PG8_SB
#undef PG8_STAGE
#undef PG8_LDA
#undef PG8_LDB
#undef PG8_MMA
#undef PG8_WAIT_V
#undef PG8_WAIT_L
#undef PG8_BAR
#undef PG8_SCHED
}
}

namespace att {
typedef unsigned short bf16_t;
using bf16x8 = __attribute__((ext_vector_type(8))) short;
using s16x4  = __attribute__((ext_vector_type(4))) short;
using f32x16 = __attribute__((ext_vector_type(16))) float;
using u32x4  = __attribute__((ext_vector_type(4))) unsigned;
using f32x4  = __attribute__((ext_vector_type(4))) float;
constexpr int D = 128, NW = 8, QBLK = 32, KVBLK = 64;
constexpr float SCALE = 0.088388347648318440f;
constexpr float THR = 8.f;
constexpr int LDQ = NHEAD * HD, LDK = NKV * HD, LDO = NHEAD * HD;
constexpr int SHM_V = KVBLK * D * 2, SHM_K = KVBLK * D * 2, SHM_ATTN = 2 * SHM_V + 2 * SHM_K + NW * 64 * 4;
constexpr int NT = KVROWS / KVBLK;
static_assert(NT % 2 == 1 && NT >= 3, "the loop below is written for an odd tile count");
#define KSWZ(row, colB) ((row) * 256 + ((colB) ^ (((row) & 7) << 4)))
#define SBAR() __builtin_amdgcn_sched_barrier(0)
__device__ __forceinline__ int crow(int r, int hi) { return (r & 3) + 8 * (r >> 2) + 4 * hi; }
__device__ __forceinline__ unsigned cvtpk(float lo, float hi) { unsigned r; asm volatile("v_cvt_pk_bf16_f32 %0, %1, %2" : "=v"(r) : "v"(lo), "v"(hi)); return r; }

__device__ __forceinline__ void partialSM(f32x16& p0, f32x16& p1, float& m_reg, float& mn, float& alpha) {
  constexpr float C = SCALE * 1.4426950408889634f;
  float pmax = p0[0];
#pragma unroll
  for (int r = 1; r < 16; ++r) pmax = fmaxf(pmax, p0[r]);
#pragma unroll
  for (int r = 0; r < 16; ++r) pmax = fmaxf(pmax, p1[r]);
  { auto rr = __builtin_amdgcn_permlane32_swap(__float_as_uint(pmax), __float_as_uint(pmax), false, false);
    pmax = fmaxf(__uint_as_float(rr[0]), __uint_as_float(rr[1])); }
  if (__builtin_expect(__all(pmax - m_reg <= THR / SCALE), 1)) { mn = m_reg; alpha = 1.f; }
  else { mn = fmaxf(m_reg, pmax); alpha = __builtin_amdgcn_exp2f((m_reg - mn) * C); m_reg = mn; }
  float mnC = -mn * C;
#pragma unroll
  for (int r = 0; r < 16; ++r) p0[r] = fmaf(p0[r], C, mnC);
#pragma unroll
  for (int r = 0; r < 16; ++r) p1[r] = fmaf(p1[r], C, mnC);
#pragma unroll
  for (int r = 0; r < 16; ++r) p0[r] = __builtin_amdgcn_exp2f(p0[r]);
}
__device__ __forceinline__ void finishSM(f32x16& p0, f32x16& p1, float alpha, float& l_reg, bf16x8& pa0, bf16x8& pa1, bf16x8& pa2, bf16x8& pa3) {
#pragma unroll
  for (int r = 0; r < 16; ++r) p1[r] = __builtin_amdgcn_exp2f(p1[r]);
  float ps = 0;
#pragma unroll
  for (int r = 0; r < 16; ++r) ps += p0[r];
#pragma unroll
  for (int r = 0; r < 16; ++r) ps += p1[r];
  { auto rr = __builtin_amdgcn_permlane32_swap(__float_as_uint(ps), __float_as_uint(ps), false, false);
    ps = __uint_as_float(rr[0]) + __uint_as_float(rr[1]); }
  l_reg = l_reg * alpha + ps;
#define PK4(P, BASE, OUT) do { unsigned a0 = cvtpk(P[BASE + 0], P[BASE + 1]), a1 = cvtpk(P[BASE + 2], P[BASE + 3]);   \
    unsigned b0 = cvtpk(P[BASE + 4], P[BASE + 5]), b1 = cvtpk(P[BASE + 6], P[BASE + 7]);                              \
    auto r0 = __builtin_amdgcn_permlane32_swap(a0, b0, false, false); auto r1 = __builtin_amdgcn_permlane32_swap(a1, b1, false, false); \
    u32x4 w = {r0[0], r1[0], r0[1], r1[1]}; OUT = *reinterpret_cast<bf16x8*>(&w); } while (0)
  PK4(p0, 0, pa0); PK4(p0, 8, pa1); PK4(p1, 0, pa2); PK4(p1, 8, pa3);
#undef PK4
}
__device__ __forceinline__ void qkt(f32x16& p0, f32x16& p1, const bf16_t* Ks, const bf16x8* qr, int r32, int hi) {
  p0 = f32x16{}; p1 = f32x16{};
#pragma unroll
  for (int d0 = 0; d0 < 8; ++d0) { int cb = (d0 * 16 + hi * 8) * 2;
    bf16x8 b0 = *reinterpret_cast<const bf16x8*>((const char*)Ks + KSWZ(r32, cb));
    bf16x8 b1 = *reinterpret_cast<const bf16x8*>((const char*)Ks + KSWZ(32 + r32, cb));
    p0 = __builtin_amdgcn_mfma_f32_32x32x16_bf16(b0, qr[d0], p0, 0, 0, 0);
    p1 = __builtin_amdgcn_mfma_f32_32x32x16_bf16(b1, qr[d0], p1, 0, 0, 0); }
}
__device__ __forceinline__ int v_st(int k, int c) { const int kk = (k & ~0xC) | ((k & 4) << 1) | ((k & 8) >> 1); return ((kk >> 3) * 4 + (c >> 5)) * 512 + ((kk & 7) * 32 + (c & 31)) * 2; }
__device__ __forceinline__ int v_rd_base(int lane) { return ((lane & 3) << 3) | (((lane >> 2) & 3) << 6) | (((lane >> 4) & 1) << 5) | (((lane >> 5) & 1) << 8); }
constexpr int v_rd_off(int d0, int ks, int half) { return d0 * 512 + ks * 4096 + half * 2048; }
template <int OFF> __device__ __forceinline__ s16x4 tr_read(int vb) {
  s16x4 r; asm volatile("ds_read_b64_tr_b16 %0, %1 offset:%2" : "=&v"(r) : "v"(vb), "i"(OFF) : "memory"); return r;
}
template <int D0> __device__ __forceinline__ void pv_one(f32x16& od, int vb, bf16x8 pa0, bf16x8 pa1, bf16x8 pa2, bf16x8 pa3) {
  const s16x4 l0 = tr_read<v_rd_off(D0, 0, 0)>(vb), h0 = tr_read<v_rd_off(D0, 0, 1)>(vb), l1 = tr_read<v_rd_off(D0, 1, 0)>(vb), h1 = tr_read<v_rd_off(D0, 1, 1)>(vb);
  const s16x4 l2 = tr_read<v_rd_off(D0, 2, 0)>(vb), h2 = tr_read<v_rd_off(D0, 2, 1)>(vb), l3 = tr_read<v_rd_off(D0, 3, 0)>(vb), h3 = tr_read<v_rd_off(D0, 3, 1)>(vb);
  asm volatile("s_waitcnt lgkmcnt(0)" ::: "memory"); SBAR();
#define PK(L, H) (bf16x8){L[0], L[1], L[2], L[3], H[0], H[1], H[2], H[3]}
  od = __builtin_amdgcn_mfma_f32_32x32x16_bf16(pa0, PK(l0, h0), od, 0, 0, 0);
  od = __builtin_amdgcn_mfma_f32_32x32x16_bf16(pa1, PK(l1, h1), od, 0, 0, 0);
  od = __builtin_amdgcn_mfma_f32_32x32x16_bf16(pa2, PK(l2, h2), od, 0, 0, 0);
  od = __builtin_amdgcn_mfma_f32_32x32x16_bf16(pa3, PK(l3, h3), od, 0, 0, 0);
#undef PK
}
__device__ __forceinline__ void pv_d0(f32x16* o, int vb, bf16x8 pa0, bf16x8 pa1, bf16x8 pa2, bf16x8 pa3) {
  pv_one<0>(o[0], vb, pa0, pa1, pa2, pa3); pv_one<1>(o[1], vb, pa0, pa1, pa2, pa3); pv_one<2>(o[2], vb, pa0, pa1, pa2, pa3); pv_one<3>(o[3], vb, pa0, pa1, pa2, pa3);
}

__device__ __forceinline__ int lane_id_asm() { int l; asm volatile("v_mbcnt_lo_u32_b32 %0, -1, 0\n\tv_mbcnt_hi_u32_b32 %0, -1, %0" : "=v"(l)); return l; }
template <bool O8> __device__ __forceinline__ void attn_unit(const bf16_t* __restrict__ Qb, const bf16_t* __restrict__ Kh, const bf16_t* __restrict__ Vh, void* __restrict__ Ob, char* lds, const int wid, const float* __restrict__ qg, const int t0) {
  const int lane = lane_id_asm(), tid = wid * 64 + lane, r32 = lane & 31, hi = lane >> 5;
  bf16_t* V_lds = (bf16_t*)lds; bf16_t* K_lds = (bf16_t*)(lds + 2 * SHM_V);
  float* ws = (float*)(lds + 2 * SHM_V + 2 * SHM_K) + wid * 64; float* li_l = ws; float* al_l = ws + 32;
  float m_reg = -1e30f, l_reg = 0; f32x16 o[4] = {}; bf16x8 qr[8];
  __syncthreads();
  { const unsigned qoff = (unsigned)((wid * QBLK + r32) * LDQ + hi * 8) * 2u;
#pragma unroll
    for (int d0 = 0; d0 < 8; ++d0) qr[d0] = *reinterpret_cast<const bf16x8*>((const char*)Qb + qoff + d0 * 32); }
  { float xf[8][8]; float ss = 0.f;
#pragma unroll
    for (int d0 = 0; d0 < 8; ++d0)
#pragma unroll
      for (int k = 0; k < 8; ++k) { xf[d0][k] = __uint_as_float((unsigned)(unsigned short)qr[d0][k] << 16); ss += xf[d0][k] * xf[d0][k]; }
    { auto rr = __builtin_amdgcn_permlane32_swap(__float_as_uint(ss), __float_as_uint(ss), false, false); ss = __uint_as_float(rr[0]) + __uint_as_float(rr[1]); }
    const float rs = __builtin_amdgcn_rsqf(ss * (1.0f / (float)D) + RMS_EPS);
#pragma unroll
    for (int d0 = 0; d0 < 8; ++d0) { const f32x4 g0 = *(const f32x4*)(qg + 16 * d0 + 8 * hi), g1 = *(const f32x4*)(qg + 16 * d0 + 8 * hi + 4);
#pragma unroll
      for (int k = 0; k < 4; ++k) { xf[d0][k] *= rs * g0[k]; xf[d0][4 + k] *= rs * g1[k]; } }
    const int t = t0 + wid * QBLK + r32; const float pos[2] = {(float)(t >> 6), (float)(t & 63)};
#pragma unroll
    for (int ax = 0; ax < 2; ++ax)
#pragma unroll
      for (int dd = 0; dd < 2; ++dd)
#pragma unroll
        for (int k = 0; k < 8; ++k) {
          const float inv_freq = __builtin_amdgcn_exp2f(-(float)(16 * dd + 8 * hi + k) * 0.41524101186092029f);
          const float rev = pos[ax] * inv_freq * 0.15915494309189535f, c = __builtin_amdgcn_cosf(rev), s = __builtin_amdgcn_sinf(rev);
          const float y1 = xf[4 * ax + dd][k], y2 = xf[4 * ax + dd + 2][k];
          xf[4 * ax + dd][k] = y1 * c - y2 * s; xf[4 * ax + dd + 2][k] = y2 * c + y1 * s; }
#pragma unroll
    for (int d0 = 0; d0 < 8; ++d0) { u32x4 w = {cvtpk(xf[d0][0], xf[d0][1]), cvtpk(xf[d0][2], xf[d0][3]), cvtpk(xf[d0][4], xf[d0][5]), cvtpk(xf[d0][6], xf[d0][7])}; qr[d0] = *reinterpret_cast<bf16x8*>(&w); }
  }
  const int sr = tid >> 4, sc = (tid & 15) * 8, vst0 = v_st(sr, sc), vst1 = v_st(32 + sr, sc);
  const int vb0 = (int)(uintptr_t)V_lds + v_rd_base(lane);
  struct { bf16x8 vs0, vs1, ks0, ks1; } sr_[2];
#define LD8(p) (*reinterpret_cast<const bf16x8*>(p))
  const unsigned goff0 = (unsigned)(sr * LDK + sc) * 2u, goff1 = goff0 + 32u * LDK * 2u;
#define SLOAD(i, k0) do { const char* vt_ = (const char*)Vh + (size_t)(k0) * (LDK * 2); const char* kt_ = (const char*)Kh + (size_t)(k0) * (LDK * 2); \
    sr_[i].vs0 = LD8(vt_ + goff0); sr_[i].vs1 = LD8(vt_ + goff1); sr_[i].ks0 = LD8(kt_ + goff0); sr_[i].ks1 = LD8(kt_ + goff1); } while (0)
#define SWRITE(b, i) do { *(bf16x8*)((char*)V_lds + (b) * SHM_V + vst0) = sr_[i].vs0;          \
    *(bf16x8*)((char*)V_lds + (b) * SHM_V + vst1) = sr_[i].vs1; int kc = sc * 2;               \
    *(bf16x8*)((char*)K_lds + (b) * SHM_K + KSWZ(sr, kc)) = sr_[i].ks0;                       \
    *(bf16x8*)((char*)K_lds + (b) * SHM_K + KSWZ(32 + sr, kc)) = sr_[i].ks1; } while (0)
#define SWAIT() asm volatile("s_waitcnt vmcnt(4)" ::: "memory")
#define RESC(a) do { if (__any((a) < 1.f)) { if (hi == 0) al_l[r32] = (a); asm volatile("s_waitcnt lgkmcnt(0)" ::: "memory"); \
    _Pragma("unroll") for (int d = 0; d < 4; ++d) _Pragma("unroll") for (int r = 0; r < 16; ++r) o[d][r] *= al_l[crow(r, hi)]; } } while (0)
  f32x16 pA0, pA1, pB0, pB1; float mnA, mnB, alA, alB; bf16x8 pa0, pa1, pa2, pa3;
  constexpr int SE = 0, SO = 1;
  SLOAD(SE, 0); asm volatile("s_waitcnt vmcnt(0)" ::: "memory"); SWRITE(0, SE); __syncthreads();
  qkt(pA0, pA1, K_lds, qr, r32, hi);
#pragma unroll
  for (int r = 8; r < 16; ++r) pA0[r] = -INFINITY;
#pragma unroll
  for (int r = 0; r < 16; ++r) pA1[r] = -INFINITY;
  partialSM(pA0, pA1, m_reg, mnA, alA);
  SLOAD(SO, KVBLK); SLOAD(SE, 2 * KVBLK);
  SWAIT(); SWRITE(1, SO); __syncthreads();
  for (int j = 1; j + 1 < NT; j += 2) {
    SBAR(); qkt(pB0, pB1, (bf16_t*)((char*)K_lds + SHM_K), qr, r32, hi);
    finishSM(pA0, pA1, alA, l_reg, pa0, pa1, pa2, pa3); SBAR();
    if (j + 2 < NT) SLOAD(SO, (j + 2) * KVBLK); SBAR();
    pv_d0(o, vb0, pa0, pa1, pa2, pa3); partialSM(pB0, pB1, m_reg, mnB, alB);
    __syncthreads(); SWAIT(); SWRITE(0, SE);
    RESC(alB); __syncthreads();
    SBAR(); qkt(pA0, pA1, K_lds, qr, r32, hi);
    finishSM(pB0, pB1, alB, l_reg, pa0, pa1, pa2, pa3); SBAR();
    if (j + 3 < NT) SLOAD(SE, (j + 3) * KVBLK); SBAR();
    pv_d0(o, vb0 + (int)SHM_V, pa0, pa1, pa2, pa3); partialSM(pA0, pA1, m_reg, mnA, alA);
    __syncthreads(); SWAIT(); if (j + 2 < NT) SWRITE(1, SO);
    RESC(alA); __syncthreads();
  }
  finishSM(pA0, pA1, alA, l_reg, pa0, pa1, pa2, pa3); SBAR();
  pv_d0(o, vb0, pa0, pa1, pa2, pa3);
  if (hi == 0) li_l[r32] = l_reg; asm volatile("s_waitcnt lgkmcnt(0)" ::: "memory");
  float rli[16];
#pragma unroll
  for (int r = 0; r < 16; ++r) rli[r] = __builtin_amdgcn_rcpf(li_l[crow(r, hi)]);
  { const int l2 = lane_id_asm(), c32 = l2 & 31, h2 = l2 >> 5;
    if constexpr (O8) { unsigned char* Ow = (unsigned char*)Ob + (size_t)(wid * QBLK) * LDO;
#pragma unroll
      for (int r = 0; r < 16; ++r) { const unsigned ooff = (unsigned)(crow(r, h2) * LDO + c32);
#pragma unroll
        for (int d0 = 0; d0 < 4; ++d0) { const float v = __builtin_amdgcn_fmed3f(o[d0][r] * rli[r] * pg8::FP8_O_SCALE, -448.f, 448.f); Ow[ooff + d0 * 32] = (unsigned char)(__builtin_amdgcn_cvt_pk_fp8_f32(v, 0.f, 0, false) & 0xff); } } }
    else { char* Ow = (char*)Ob + (size_t)(wid * QBLK) * (LDO * 2);
#pragma unroll
      for (int r = 0; r < 16; ++r) { const unsigned ooff = (unsigned)(crow(r, h2) * LDO + c32) * 2u;
#pragma unroll
        for (int d0 = 0; d0 < 4; ++d0) *(bf16_t*)(Ow + ooff + d0 * 64) = (bf16_t)(cvtpk(o[d0][r] * rli[r], 0.f) & 0xffffu); } } }
#undef LD8
#undef SLOAD
#undef SWRITE
#undef SWAIT
#undef RESC
}
#undef KSWZ
}


namespace att8 {
using att::f32x16; using att::f32x4; using att::u32x4; using att::crow; using att::lane_id_asm;
typedef int i32x8 __attribute__((ext_vector_type(8)));
typedef int i32x4 __attribute__((ext_vector_type(4)));
constexpr int D = 128, NW = 8, QBLK = 32, KVBLK = 64, NT = att::NT;
constexpr float FP8_K_SCALE = 0.5f, FP8_Q_SCALE = att::SCALE * 1.4426950408889634f * 2.0f;
constexpr float FP8_KQ_SCALE = FP8_K_SCALE;
constexpr float FP8_V_SCALE = 16.f, FP8_P_LOG2 = 4.f, THR_LOG2 = 4.f;
constexpr int LDQ = NHEAD * HD, LDK8 = NKV * HD, LDO = NHEAD * HD;
constexpr int SHM_K = KVBLK * D, SHM_V = KVBLK * D, NSLOT = 4, SHM_ATTN8 = NSLOT * SHM_K + NSLOT * SHM_V + NW * 64 * 4;
#define SBAR8() __builtin_amdgcn_sched_barrier(0)
#define MFMA8(acc, a, b) asm volatile("v_mfma_f32_32x32x64_f8f6f4 %0, %1, %2, %0" : "+v"(acc) : "v"(a), "v"(b))
#define MFMA8N(dst, a, b, c) asm volatile("v_mfma_f32_32x32x64_f8f6f4 %0, %1, %2, %3" : "=&v"(dst) : "v"(a), "v"(b), "v"(c))
__device__ __forceinline__ i32x8 cat(const i32x4 x, const i32x4 y) { return (i32x8){x[0], x[1], x[2], x[3], y[0], y[1], y[2], y[3]}; }
__device__ __forceinline__ int k8_pos(int e) { const int d0 = e >> 4, hi = (e >> 3) & 1, k = e & 7; return (d0 >> 2) * 64 + hi * 32 + (d0 & 3) * 8 + k; }
__device__ __forceinline__ int v8_key(int j) { const int h = j >> 5, i = j & 31; return i < 16 ? crow(i, h) : 32 + crow(i - 16, h); }
__device__ __forceinline__ unsigned pk4(float a, float b, float c, float d) { int w = 0; w = __builtin_amdgcn_cvt_pk_fp8_f32(a, b, w, false); w = __builtin_amdgcn_cvt_pk_fp8_f32(c, d, w, true); return (unsigned)w; }
__device__ __forceinline__ unsigned pk4u(float a, float b, float c, float d) { int w; asm volatile("" : "=v"(w)); w = __builtin_amdgcn_cvt_pk_fp8_f32(a, b, w, false); w = __builtin_amdgcn_cvt_pk_fp8_f32(c, d, w, true); return (unsigned)w; }
__device__ __forceinline__ float sat8(float v) { return __builtin_amdgcn_fmed3f(v, -448.f, 448.f); }
__device__ __forceinline__ float max3f(float a, float b, float c) { float r; asm("v_max3_f32 %0, %1, %2, %3" : "=v"(r) : "v"(a), "v"(b), "v"(c)); return r; }

__device__ __forceinline__ void qkt8(f32x16& p0, f32x16& p1, const char* Ks, const i32x8 (&qf)[2], int r32, int hi) {
  p0 = f32x16{}; p1 = f32x16{};
#pragma unroll
  for (int s = 0; s < 2; ++s) {
    const int c0 = s * 4 + hi * 2;
#pragma unroll
    for (int hp = 0; hp < 2; ++hp) { const int key = hp * 32 + r32, swz = (key >> 1) & 7; const char* kr = Ks + key * 128;
      const i32x4 a0 = *reinterpret_cast<const i32x4*>(kr + ((c0 ^ swz) << 4)), a1 = *reinterpret_cast<const i32x4*>(kr + (((c0 + 1) ^ swz) << 4));
      if (hp == 0) MFMA8(p0, cat(a0, a1), qf[s]); else MFMA8(p1, cat(a0, a1), qf[s]); }
  }
}
__device__ __forceinline__ void pv8(f32x16* o, const char* Vs, const i32x8 pf, int r32, int hi) {
#pragma unroll
  for (int d0 = 0; d0 < 4; ++d0) { const int d = d0 * 32 + r32, swz = (d >> 2) & 3; const char* vr = Vs + d * 64;
    const i32x4 b0 = *reinterpret_cast<const i32x4*>(vr + (((hi * 2) ^ swz) << 4)), b1 = *reinterpret_cast<const i32x4*>(vr + (((hi * 2 + 1) ^ swz) << 4));
    MFMA8(o[d0], pf, cat(b0, b1)); }
}
__device__ __forceinline__ i32x8 kfrag8(const char* Ks, int hp, int s, int r32, int hi) { const int key = hp * 32 + r32, swz = (key >> 1) & 7, c0 = s * 4 + hi * 2; const char* kr = Ks + key * 128;
  return cat(*reinterpret_cast<const i32x4*>(kr + ((c0 ^ swz) << 4)), *reinterpret_cast<const i32x4*>(kr + (((c0 + 1) ^ swz) << 4))); }
__device__ __forceinline__ i32x8 vfrag8(const char* Vs, int d0, int r32, int hi) { const int d = d0 * 32 + r32, swz = (d >> 2) & 3; const char* vr = Vs + d * 64;
  return cat(*reinterpret_cast<const i32x4*>(vr + (((hi * 2) ^ swz) << 4)), *reinterpret_cast<const i32x4*>(vr + (((hi * 2 + 1) ^ swz) << 4))); }
#define MAXCH8(m_, p_) do { float b_; asm("v_max3_f32 %0, %2, %3, %4\n\tv_max3_f32 %1, %5, %6, %7\n\tv_max3_f32 %0, %0, %8, %9\n\tv_max3_f32 %1, %1, %10, %11\n\tv_max3_f32 %0, %0, %12, %13\n\tv_max3_f32 %1, %1, %14, %15\n\tv_max3_f32 %0, %0, %16, %17\n\tv_max_f32 %0, %0, %1" \
    : "=&v"(m_), "=&v"(b_) : "v"(p_[0]), "v"(p_[1]), "v"(p_[2]), "v"(p_[3]), "v"(p_[4]), "v"(p_[5]), "v"(p_[6]), "v"(p_[7]), "v"(p_[8]), "v"(p_[9]), "v"(p_[10]), "v"(p_[11]), "v"(p_[12]), "v"(p_[13]), "v"(p_[14]), "v"(p_[15])); } while (0)
#define STEP8(pC0, pC1, pP0, pP1, alC, KS, VS, JT) do { \
    const char* Kb_ = K_lds + (KS) * SHM_K; const char* Vb_ = V_lds + (VS) * SHM_V; \
    DMAK8((JT) + 2, ((KS) + 2) & 3); DMAV8((JT) + 1, ((VS) + 2) & 3); \
    i32x8 ka_ = kfrag8(Kb_, 0, 0, r32, hi), kb_ = kfrag8(Kb_, 1, 0, r32, hi), kc_ = kfrag8(Kb_, 0, 1, r32, hi); SBAR8();     \
    MFMA8N(pC0, ka_, qf[0], negm); \
    i32x8 kd_ = kfrag8(Kb_, 1, 1, r32, hi); _Pragma("unroll") for (int r_ = 0; r_ < 8; ++r_) pP1[r_] = __builtin_amdgcn_exp2f(pP1[r_]); SBAR8(); \
    MFMA8N(pC1, kb_, qf[0], negm); \
    i32x8 va_ = vfrag8(Vb_, 0, r32, hi); _Pragma("unroll") for (int r_ = 8; r_ < 16; ++r_) pP1[r_] = __builtin_amdgcn_exp2f(pP1[r_]); SBAR8(); \
    MFMA8(pC0, kc_, qf[1]); \
    i32x8 vb_ = vfrag8(Vb_, 1, r32, hi); _Pragma("unroll") for (int q_ = 0; q_ < 4; ++q_) { \
        pf[q_] = (int)pk4u(pP0[4 * q_], pP0[4 * q_ + 1], pP0[4 * q_ + 2], pP0[4 * q_ + 3]); pf[4 + q_] = (int)pk4u(pP1[4 * q_], pP1[4 * q_ + 1], pP1[4 * q_ + 2], pP1[4 * q_ + 3]); } SBAR8(); \
    MFMA8(pC1, kd_, qf[1]); \
    i32x8 vc_ = vfrag8(Vb_, 2, r32, hi); SBAR8(); \
    MFMA8(o[0], pf, va_); \
    i32x8 vd_ = vfrag8(Vb_, 3, r32, hi); float m0_; MAXCH8(m0_, pC0); SBAR8(); \
    MFMA8(o[1], pf, vb_); \
    float m1_; MAXCH8(m1_, pC1); float pmax_; asm("v_max_f32 %0, %1, %2" : "=v"(pmax_) : "v"(m0_), "v"(m1_)); \
    { auto rr_ = __builtin_amdgcn_permlane32_swap(__float_as_uint(pmax_), __float_as_uint(pmax_), false, false); asm("v_max_f32 %0, %1, %2" : "=v"(pmax_) : "v"(rr_[0]), "v"(rr_[1])); } \
    alC = 1.f; \
    if (__builtin_expect(!__all(pmax_ <= FP8_P_LOG2 + THR_LOG2), 0)) {     \
        const float d_ = fmaxf(pmax_ - FP8_P_LOG2, 0.f); alC = __builtin_amdgcn_exp2f(-d_); m_reg += d_; \
        _Pragma("unroll") for (int r_ = 0; r_ < 16; ++r_) { pC0[r_] -= d_; pC1[r_] -= d_; negm[r_] = FP8_P_LOG2 - m_reg; } } SBAR8(); \
    MFMA8(o[2], pf, vc_); \
    _Pragma("unroll") for (int r_ = 0; r_ < 16; ++r_) pC0[r_] = __builtin_amdgcn_exp2f(pC0[r_]); SBAR8(); \
    MFMA8(o[3], pf, vd_); \
    MFMA8(osum, pf, ones8);        \
    \
  } while (0)

template <bool WAITMFMA> __device__ __forceinline__ void partialSM8(f32x16& p0, f32x16& p1, float& m_reg, float& alpha) {
  if (WAITMFMA) asm volatile("s_nop 15\n\ts_nop 7" : "+v"(p0), "+v"(p1));
  float pa = max3f(p0[0], p0[1], p1[0]), pb = max3f(p0[2], p0[3], p1[1]); pa = max3f(pa, p1[2], p1[3]);
#pragma unroll
  for (int r = 4; r < 16; r += 4) { pa = max3f(pa, p0[r], p0[r + 1]); pb = max3f(pb, p0[r + 2], p0[r + 3]); pa = max3f(pa, p1[r], p1[r + 1]); pb = max3f(pb, p1[r + 2], p1[r + 3]); }
  float pmax = fmaxf(pa, pb);
  { auto rr = __builtin_amdgcn_permlane32_swap(__float_as_uint(pmax), __float_as_uint(pmax), false, false);
    pmax = fmaxf(__uint_as_float(rr[0]), __uint_as_float(rr[1])); }
  float mn;
  if (__builtin_expect(__all(pmax - m_reg <= THR_LOG2), 1)) { mn = m_reg; alpha = 1.f; }
  else { mn = fmaxf(m_reg, pmax); alpha = __builtin_amdgcn_exp2f(m_reg - mn); m_reg = mn; }
  const float mnC = FP8_P_LOG2 - mn;
#pragma unroll
  for (int r = 0; r < 16; ++r) p0[r] = __builtin_amdgcn_exp2f(p0[r] + mnC);
#pragma unroll
  for (int r = 0; r < 16; ++r) p1[r] += mnC;
}
__device__ __forceinline__ void finishSM8(f32x16& p0, f32x16& p1, i32x8& pf) {
#pragma unroll
  for (int r = 0; r < 16; ++r) p1[r] = __builtin_amdgcn_exp2f(p1[r]);
#pragma unroll
  for (int q = 0; q < 4; ++q) { pf[q] = (int)pk4(p0[4 * q], p0[4 * q + 1], p0[4 * q + 2], p0[4 * q + 3]); pf[4 + q] = (int)pk4(p1[4 * q], p1[4 * q + 1], p1[4 * q + 2], p1[4 * q + 3]); }
}

__device__ __forceinline__ void attn_unit8(const unsigned short* __restrict__ Qb, const unsigned char* __restrict__ Kh8, const unsigned char* __restrict__ Vt, unsigned char* __restrict__ Ob,
                                           char* lds, __attribute__((address_space(3))) unsigned char* ldsl, const int wid, const float* __restrict__ qg, const int t0) {
  const int lane = lane_id_asm(), tid = wid * 64 + lane, r32 = lane & 31, hi = lane >> 5;
  char* K_lds = lds; char* V_lds = lds + NSLOT * SHM_K;
  float* ws = (float*)(lds + NSLOT * SHM_K + NSLOT * SHM_V) + wid * 64; float* al_l = ws + 32;
  float m_reg = -1e30f; f32x16 o[4] = {}; f32x16 osum = {}; i32x8 qf[2];
  const i32x8 ones8 = {0x38383838, 0x38383838, 0x38383838, 0x38383838, 0x38383838, 0x38383838, 0x38383838, 0x38383838};
  __syncthreads();
  { att::bf16x8 qr[8];
    const unsigned qoff = (unsigned)((wid * QBLK + r32) * LDQ + hi * 8) * 2u;
#pragma unroll
    for (int d0 = 0; d0 < 8; ++d0) qr[d0] = *reinterpret_cast<const att::bf16x8*>((const char*)Qb + qoff + d0 * 32);
    float xf[8][8]; float ss = 0.f;
#pragma unroll
    for (int d0 = 0; d0 < 8; ++d0)
#pragma unroll
      for (int k = 0; k < 8; ++k) { xf[d0][k] = __uint_as_float((unsigned)(unsigned short)qr[d0][k] << 16); ss += xf[d0][k] * xf[d0][k]; }
    { auto rr = __builtin_amdgcn_permlane32_swap(__float_as_uint(ss), __float_as_uint(ss), false, false); ss = __uint_as_float(rr[0]) + __uint_as_float(rr[1]); }
    const float rs = __builtin_amdgcn_rsqf(ss * (1.0f / (float)D) + RMS_EPS) * FP8_Q_SCALE;
#pragma unroll
    for (int d0 = 0; d0 < 8; ++d0) { const f32x4 g0 = *(const f32x4*)(qg + 16 * d0 + 8 * hi), g1 = *(const f32x4*)(qg + 16 * d0 + 8 * hi + 4);
#pragma unroll
      for (int k = 0; k < 4; ++k) { xf[d0][k] *= rs * g0[k]; xf[d0][4 + k] *= rs * g1[k]; } }
    const int t = t0 + wid * QBLK + r32; const float pos[2] = {(float)(t >> 6), (float)(t & 63)};
#pragma unroll
    for (int ax = 0; ax < 2; ++ax)
#pragma unroll
      for (int dd = 0; dd < 2; ++dd)
#pragma unroll
        for (int k = 0; k < 8; ++k) {
          const float inv_freq = __builtin_amdgcn_exp2f(-(float)(16 * dd + 8 * hi + k) * 0.41524101186092029f);
          const float rev = pos[ax] * inv_freq * 0.15915494309189535f, c = __builtin_amdgcn_cosf(rev), s = __builtin_amdgcn_sinf(rev);
          const float y1 = xf[4 * ax + dd][k], y2 = xf[4 * ax + dd + 2][k];
          xf[4 * ax + dd][k] = y1 * c - y2 * s; xf[4 * ax + dd + 2][k] = y2 * c + y1 * s; }
#pragma unroll
    for (int s = 0; s < 2; ++s)
#pragma unroll
      for (int j = 0; j < 4; ++j) { const int d0 = 4 * s + j;
        qf[s][2 * j] = (int)pk4(sat8(xf[d0][0]), sat8(xf[d0][1]), sat8(xf[d0][2]), sat8(xf[d0][3])); qf[s][2 * j + 1] = (int)pk4(sat8(xf[d0][4]), sat8(xf[d0][5]), sat8(xf[d0][6]), sat8(xf[d0][7])); }
  }
  const int skey = tid >> 3, sd = tid >> 2;
  const unsigned kg_off = (unsigned)(skey * LDK8 + (((tid & 7) ^ ((skey >> 1) & 7)) << 4)), vg_off = (unsigned)(sd * 64 + (((tid & 3) ^ ((sd >> 2) & 3)) << 4));
#define TCLAMP(t) ((t) < NT ? (t) : NT - 1)
#define DMAK8(kt, ks) __builtin_amdgcn_global_load_lds((const unsigned*)(Kh8 + (size_t)TCLAMP(kt) * (KVBLK * LDK8) + kg_off), (__attribute__((address_space(3))) unsigned*)(ldsl + (ks) * SHM_K + wid * 1024), 16, 0, 0)
#define DMAV8(vt, vs) __builtin_amdgcn_global_load_lds((const unsigned*)(Vt + (size_t)TCLAMP(vt) * (KVBLK * D) + vg_off), (__attribute__((address_space(3))) unsigned*)(ldsl + NSLOT * SHM_K + (vs) * SHM_V + wid * 1024), 16, 0, 0)
#define STEP_END8() do { asm volatile("s_waitcnt vmcnt(2) lgkmcnt(0)" ::: "memory"); __builtin_amdgcn_s_barrier(); asm volatile("" ::: "memory"); } while (0)
#define RESC8(a) do { if (__any((a) < 1.f)) { if (hi == 0) al_l[r32] = (a); asm volatile("s_waitcnt lgkmcnt(0)" ::: "memory"); asm volatile("s_nop 15\n\ts_nop 7" : "+v"(o[0]), "+v"(o[1]), "+v"(o[2]), "+v"(o[3]), "+v"(osum)); \
    _Pragma("unroll") for (int r = 0; r < 16; ++r) { const float a_ = al_l[crow(r, hi)]; osum[r] *= a_; _Pragma("unroll") for (int d = 0; d < 4; ++d) o[d][r] *= a_; } } } while (0)
  f32x16 pA0, pA1, pB0, pB1, negm; float alA, alB; i32x8 pf;
  DMAK8(0, 0); DMAV8(0, 0); DMAK8(1, 1); DMAK8(2, 2); DMAV8(1, 1);
  STEP_END8();
  qkt8(pA0, pA1, K_lds, qf, r32, hi);
  asm volatile("s_nop 15\n\ts_nop 7" : "+v"(pA0), "+v"(pA1));
#pragma unroll
  for (int r = 8; r < 16; ++r) pA0[r] = -INFINITY;
#pragma unroll
  for (int r = 0; r < 16; ++r) pA1[r] = -INFINITY;
  partialSM8<false>(pA0, pA1, m_reg, alA);
#pragma unroll
  for (int r = 0; r < 16; ++r) negm[r] = FP8_P_LOG2 - m_reg;
  asm volatile("s_waitcnt lgkmcnt(0)" ::: "memory"); __builtin_amdgcn_s_barrier(); asm volatile("" ::: "memory");
  for (int j = 1; j < NT; j += 4) {
    STEP8(pB0, pB1, pA0, pA1, alB, 1, 0, j);     RESC8(alB); STEP_END8();
    STEP8(pA0, pA1, pB0, pB1, alA, 2, 1, j + 1); RESC8(alA); STEP_END8();
    STEP8(pB0, pB1, pA0, pA1, alB, 3, 2, j + 2); RESC8(alB); STEP_END8();
    STEP8(pA0, pA1, pB0, pB1, alA, 0, 3, j + 3); RESC8(alA); STEP_END8();
  }
  asm volatile("s_waitcnt vmcnt(0)" ::: "memory");
  finishSM8(pA0, pA1, pf); SBAR8();
  pv8(o, V_lds + ((NT - 1) & 3) * SHM_V, pf, r32, hi); MFMA8(osum, pf, ones8);
  asm volatile("s_nop 15\n\ts_nop 15\n\ts_nop 15\n\ts_nop 7" : "+v"(o[0]), "+v"(o[1]), "+v"(o[2]), "+v"(o[3]), "+v"(osum));
  float rli[16];
#pragma unroll
  for (int r = 0; r < 16; ++r) rli[r] = __builtin_amdgcn_rcpf(osum[r]) * (pg8::FP8_O_SCALE / FP8_V_SCALE);
  { const int l2 = lane_id_asm(), c32 = l2 & 31, h2 = l2 >> 5; unsigned char* Ow = Ob + (size_t)(wid * QBLK) * LDO;
#pragma unroll
    for (int r = 0; r < 16; ++r) { const unsigned ooff = (unsigned)(crow(r, h2) * LDO + c32);
#pragma unroll
      for (int d0 = 0; d0 < 4; ++d0) { const float v = sat8(o[d0][r] * rli[r]); Ow[ooff + d0 * 32] = (unsigned char)(__builtin_amdgcn_cvt_pk_fp8_f32(v, 0.f, 0, false) & 0xff); } } }
#undef DMAK8
#undef DMAV8
#undef MAXCH8
#undef STEP_END8
#undef TCLAMP
#undef STEP8
#undef RESC8
}
}

#define GAS __attribute__((address_space(1)))
#define LAS __attribute__((address_space(3)))
typedef unsigned short bf16;
typedef unsigned v4u __attribute__((ext_vector_type(4)));
typedef float f32x4 __attribute__((ext_vector_type(4)));
typedef short bf16x8 __attribute__((ext_vector_type(8)));
typedef GAS unsigned gu32;
typedef GAS unsigned long long gu64;
#define RLX_AGENT __ATOMIC_RELAXED, __HIP_MEMORY_SCOPE_AGENT
#define LDS_WAIT() asm volatile("s_waitcnt lgkmcnt(0)" ::: "memory")
#define VM_WAIT() asm volatile("s_waitcnt vmcnt(0)" ::: "memory")
__device__ __forceinline__ unsigned long long rt() { return __builtin_amdgcn_s_memrealtime(); }
__device__ __forceinline__ unsigned f2bf(float f) { unsigned u = __builtin_bit_cast(unsigned, f); return (u + 0x7fffu + ((u >> 16) & 1u)) >> 16; }
__device__ __forceinline__ unsigned pk2(float lo, float hi) { return f2bf(lo) | (f2bf(hi) << 16); }

#define XB_TMO      128
#define XB_XCNT(j)  (256  + 64 * (j))
#define XB_XSUB(j)  (1280 + 64 * (j))
#define XB_XGEN(j)  (2304 + 64 * (j))
#define XB_TOP      3328
#define XB_TOPGEN   3392
#define XCD_BAR_WORDS 3456
#define XB_SPIN_CAP (1u << 18)

__device__ __forceinline__ unsigned xb_ld(unsigned* p)              { return __hip_atomic_load(p, __ATOMIC_RELAXED, __HIP_MEMORY_SCOPE_AGENT); }
__device__ __forceinline__ unsigned xb_add(unsigned* p, unsigned v) { return __hip_atomic_fetch_add(p, v, __ATOMIC_RELAXED, __HIP_MEMORY_SCOPE_AGENT); }
__device__ __forceinline__ unsigned xb_xcc_id() { return (unsigned)__builtin_amdgcn_s_getreg((3 << 11) | 20) & 0xFu; }
#define XB_SPIN(cond, bar) do { unsigned _sp = 0; while (cond) { __builtin_amdgcn_s_sleep(1); \
    if ((++_sp & 255u) == 0u) { if (xb_ld(&(bar)[XB_TMO])) break; if (_sp > XB_SPIN_CAP) { atomicAdd(&(bar)[XB_TMO], 1u); break; } } } } while (0)

struct XcdBarrier {
    unsigned* bar; unsigned x;
    volatile LAS unsigned* st;
};

__device__ __forceinline__ XcdBarrier xcd_barrier_post(unsigned* bar, volatile LAS unsigned* st, const bool t0) {
    XcdBarrier b; b.bar = bar; b.x = xb_xcc_id(); b.st = st;
    if (t0) (void)xb_add(&bar[XB_XCNT(b.x)], 1u);
    return b;
}
__device__ __forceinline__ void xcd_barrier_complete(unsigned* bar, unsigned x, unsigned& nloc, unsigned& nx) {
    const unsigned G = gridDim.x * gridDim.y * gridDim.z;
    unsigned sum, cnt, mine, sp = 0u;
    for (;;) {
        sum = 0u; cnt = 0u; mine = 0u;
#pragma unroll
        for (unsigned j = 0; j < 16; ++j) { const unsigned c = xb_ld(&bar[XB_XCNT(j)]); sum += c; cnt += (c > 0u) ? 1u : 0u; mine = (j == x) ? c : mine; }
        if (sum == G) break;
        __builtin_amdgcn_s_sleep(1);
        if ((++sp & 255u) == 0u) { if (xb_ld(&bar[XB_TMO])) break; if (sp > XB_SPIN_CAP) { atomicAdd(&bar[XB_TMO], 1u); break; } }
    }
    nloc = mine > 0u ? mine : 1u; nx = cnt > 0u ? cnt : 1u;
}

__device__ __forceinline__ void xcd_barrier(const XcdBarrier& b, const bool t0) {
    asm volatile("s_waitcnt vmcnt(0)" ::: "memory");
    __syncthreads();
    if (t0) {
        unsigned* bar = b.bar;
        __builtin_amdgcn_s_waitcnt(0);
        unsigned nloc = b.st[0], nx = b.st[1];
        if (nloc == 0u) { xcd_barrier_complete(bar, b.x, nloc, nx); b.st[0] = nloc; b.st[1] = nx; }
        const unsigned old = xb_add(&bar[XB_XSUB(b.x)], 1u);
        const unsigned gen = old / nloc;
        if (old + 1u == (gen + 1u) * nloc) {
            __builtin_amdgcn_fence(__ATOMIC_RELEASE, "agent");
            asm volatile("s_waitcnt vmcnt(0)" ::: "memory");
            const unsigned og = xb_add(&bar[XB_TOP], 1u);
            const unsigned tg = og / nx;
            if (og + 1u == (tg + 1u) * nx) xb_add(&bar[XB_TOPGEN], 1u);
            else XB_SPIN(xb_ld(&bar[XB_TOPGEN]) == tg, bar);
            __builtin_amdgcn_fence(__ATOMIC_ACQUIRE, "agent");
            xb_add(&bar[XB_XGEN(b.x)], 1u);
            asm volatile("s_waitcnt vmcnt(0)" ::: "memory");
        } else {
            XB_SPIN(xb_ld(&bar[XB_XGEN(b.x)]) == gen, bar);
            __builtin_amdgcn_fence(__ATOMIC_ACQUIRE, "agent");
            asm volatile("s_waitcnt vmcnt(0)" ::: "memory");
        }
    }
    __syncthreads();
}

constexpr size_t MiB = 1u << 20;
constexpr size_t CTL_ZERO_BYTES = 2 * MiB;
constexpr int CW_BAR = 4096;
constexpr size_t RSS_OFF = 256 * 1024;
constexpr int NRSS = 7;
static_assert((CW_BAR + XCD_BAR_WORDS) * 4 <= (int)RSS_OFF && RSS_OFF + (size_t)NRSS * MPAD * 8 <= CTL_ZERO_BYTES, "control region");
constexpr size_t SZ_WGU = (size_t)2 * DFF * DM * 2, SZ_WD = (size_t)DM * DFF * 2, SZ_WCI = (size_t)3 * DM * DM * 2, SZ_WSQ = (size_t)DM * DM * 2, SZ_WQKV = (size_t)NQKV * DM * 2;
constexpr size_t WS_WGU = 2 * MiB;
constexpr size_t WS_WD = WS_WGU + 4 * SZ_WGU;
constexpr size_t WS_WCI = WS_WD + 4 * SZ_WD;
constexpr size_t WS_WCO = WS_WCI + SZ_WCI;
constexpr size_t WS_WQKV = WS_WCO + SZ_WSQ;
constexpr size_t WS_WO = WS_WQKV + SZ_WQKV;
constexpr size_t WS_H = WS_WO + SZ_WSQ;
constexpr size_t WS_HB = WS_H + (size_t)MPAD * DM * 4;
constexpr size_t WS_ACT = WS_HB + (size_t)MPAD * DM * 2;
constexpr size_t SZ_ACT = (size_t)MPAD * DFF * 2;
constexpr size_t WS_BB = WS_ACT, WS_UB = WS_ACT + (size_t)MPAD * DM * 2;
constexpr size_t WS_Q = WS_ACT, WS_K = WS_Q + (size_t)MREAL * DM * 2, WS_V = WS_K + (size_t)NB * KVROWS * NKV * HD * 2;
static_assert(WS_UB + (size_t)MPAD * DM * 2 <= WS_ACT + SZ_ACT && WS_V + (size_t)NB * KVROWS * NKV * HD * 2 <= WS_ACT + SZ_ACT, "overlays fit the FFN hidden buffer");
constexpr size_t WS_AUX = WS_ACT + SZ_ACT;
constexpr size_t SZ_WD8 = (size_t)DM * DFF;
constexpr size_t WS_WD8 = WS_AUX + (size_t)MPAD * DM * 2;
constexpr size_t WS_WQKV8 = WS_WD8 + 4 * SZ_WD8;
constexpr size_t WS_WO8 = WS_WQKV8 + (size_t)NQKV * DM;
constexpr size_t WS_HB8 = WS_WO8 + (size_t)DM * DM;
constexpr size_t WS_K8 = WS_HB8 + (size_t)MPAD * DM;
constexpr size_t WS_VT8 = WS_K8 + (size_t)NB * KVROWS * NKV * HD;
constexpr size_t WS_END = WS_VT8 + (size_t)NB * NKV * (KVROWS / 64) * 128 * 64;
static_assert(WS_WD8 % 256 == 0 && WS_WQKV8 % 256 == 0 && WS_WO8 % 256 == 0 && WS_HB8 % 256 == 0 && WS_K8 % 256 == 0 && WS_VT8 % 256 == 0, "alignment");
static_assert(WS_WGU % 256 == 0 && WS_WD % 256 == 0 && WS_H % 256 == 0 && WS_HB % 256 == 0 && WS_ACT % 256 == 0 && WS_K % 256 == 0 && WS_V % 256 == 0 && WS_AUX % 256 == 0, "alignment");

constexpr int NWAVES = 8;
constexpr int RING_BYTES = 131072;
constexpr int MISC_OFF = 139264 + 320;
constexpr int LDS_BYTES = 147456;

struct Frame {
    LAS unsigned char* lds;
    int tid, lane, wave, G, bid;
};
#define REFRAME(F) do { (F).lane = att::lane_id_asm(); (F).tid = (F).wave * 64 + (F).lane; } while (0)

__device__ __forceinline__ float wave_sum(float v) {
#pragma unroll
    for (int o = 1; o < 64; o <<= 1) v += __shfl_xor(v, o);
    return v;
}
__device__ __forceinline__ float bf2f(unsigned short b) { return __uint_as_float((unsigned)b << 16); }

#define CVT_LOAD32(t, wp, ldw, koff) do { _Pragma("unroll") for (int i_ = 0; i_ < 32; ++i_) (t)[i_] = __builtin_nontemporal_load((wp) + (size_t)((koff) + 2 * i_) * (ldw)); } while (0)
#define CVT_LDSW32(t, scr, koff, lane) do { _Pragma("unroll") for (int i_ = 0; i_ < 32; ++i_) (scr)[((koff) + 2 * i_ + ((lane) >> 5)) * 33 + ((lane) & 31)] = (t)[i_]; } while (0)
__device__ __forceinline__ void cvt_finish(const float (&t)[32], const float* g, bf16* WT, int K, int drow, int k0, LAS float* scr, int lane) {
    const int c = lane & 7;
    f32x4 g0 = {1.f, 1.f, 1.f, 1.f}, g1 = g0;
    if (g) { g0 = *(const f32x4*)(g + k0 + 8 * c); g1 = *(const f32x4*)(g + k0 + 8 * c + 4); }
    CVT_LDSW32(t, scr, 0, lane);
    LDS_WAIT(); asm volatile("" ::: "memory");
#pragma unroll
    for (int j = 0; j < 4; ++j) { const int n = (lane >> 3) + 8 * j; const LAS float* s = scr + (8 * c) * 33 + n;
        v4u o; o.x = pg8::cvt_pk_bf16(s[0 * 33] * g0[0], s[1 * 33] * g0[1]); o.y = pg8::cvt_pk_bf16(s[2 * 33] * g0[2], s[3 * 33] * g0[3]);
        o.z = pg8::cvt_pk_bf16(s[4 * 33] * g1[0], s[5 * 33] * g1[1]); o.w = pg8::cvt_pk_bf16(s[6 * 33] * g1[2], s[7 * 33] * g1[3]);
        __builtin_nontemporal_store(o, (GAS v4u*)(WT + (size_t)(drow + n) * K + k0 + 8 * c)); }
    LDS_WAIT(); asm volatile("" ::: "memory");
}
template <int MODE>
__device__ __forceinline__ const float* cvt_src(const float* W, const float* W2, int ldw, int nblk, int it, int lane, int& drow, int& k0) {
    const int kb = it / nblk, nb = it - kb * nblk; drow = nb * 32; k0 = kb * 64;
    const float* src = W; int scol = drow;
    if (MODE == 1) { src = ((drow >> 7) & 1) ? W2 : W; scol = (drow >> 8) * 128 + (drow & 127); }
    if (MODE == 2) { if (drow < 2 * DM) scol = (((drow >> 7) & 1) ? 2 * DM : DM) + (drow >> 8) * 128 + (drow & 127); else scol = drow - 2 * DM; }
    return src + (size_t)(k0 + (lane >> 5)) * ldw + scol + (lane & 31);
}
template <int MODE>
__device__ __forceinline__ void cvt_matrix(Frame& F, const float* W, const float* W2, int ldw, const float* g, bf16* WT, int K, int ndst) {
    LAS float* scr = (LAS float*)(F.lds + F.wave * 16896);
    const int gw = F.bid * NWAVES + F.wave, NGW = F.G * NWAVES, lane = F.lane;
    const int nblk = ndst / 32, nitems = nblk * (K / 64);
    float ta[32], tb[32]; int da, ka, db, kb;
    int it = gw;
    if (it < nitems) { const float* wp = cvt_src<MODE>(W, W2, ldw, nblk, it, lane, da, ka); CVT_LOAD32(ta, wp, ldw, 0); }
    while (it < nitems) {
        const int it1 = it + NGW;
        if (it1 < nitems) { const float* wp = cvt_src<MODE>(W, W2, ldw, nblk, it1, lane, db, kb); CVT_LOAD32(tb, wp, ldw, 0); }
        __builtin_amdgcn_sched_barrier(0);
        cvt_finish(ta, g, WT, K, da, ka, scr, lane);
        if (it1 >= nitems) break;
        it = it1 + NGW;
        if (it < nitems) { const float* wp = cvt_src<MODE>(W, W2, ldw, nblk, it, lane, da, ka); CVT_LOAD32(ta, wp, ldw, 0); }
        __builtin_amdgcn_sched_barrier(0);
        cvt_finish(tb, g, WT, K, db, kb, scr, lane);
    }
}
__device__ __forceinline__ void cvt_finish8(const float* g, float scale, unsigned char* WT, int K, int drow, int k0, LAS float* scr, int lane) {
    const int c = lane & 7;
    f32x4 gv[4];
#pragma unroll
    for (int q = 0; q < 4; ++q) gv[q] = g ? *(const f32x4*)(g + k0 + 16 * c + 4 * q) * scale : (f32x4){scale, scale, scale, scale};
    LDS_WAIT(); asm volatile("" ::: "memory");
#pragma unroll
    for (int j = 0; j < 4; ++j) { const int n = (lane >> 3) + 8 * j; const LAS float* s = scr + (16 * c) * 33 + n;
        v4u o;
#pragma unroll
        for (int q = 0; q < 4; ++q) o[q] = pg8::pack_fp8x4((f32x4){s[(4 * q + 0) * 33], s[(4 * q + 1) * 33], s[(4 * q + 2) * 33], s[(4 * q + 3) * 33]} * gv[q]);
        __builtin_nontemporal_store(o, (GAS v4u*)(WT + (size_t)(drow + n) * K + k0 + 16 * c)); }
    LDS_WAIT(); asm volatile("" ::: "memory");
}
__device__ __forceinline__ void cvt_matrix8(Frame& F, const float* W, int ldw, const float* g, float scale, unsigned char* WT, int K, int ndst) {
    LAS float* scr = (LAS float*)(F.lds + F.wave * 16896);
    const int gw = F.bid * NWAVES + F.wave, NGW = F.G * NWAVES, lane = F.lane;
    const int nblk = ndst / 32, nitems = nblk * (K / 128);
    float ta[32], tb[32];
    int it = gw;
    if (it < nitems) { const int kb = it / nblk, nb = it - kb * nblk; const float* wp = W + (size_t)(kb * 128 + (lane >> 5)) * ldw + nb * 32 + (lane & 31); CVT_LOAD32(ta, wp, ldw, 0); }
    for (; it < nitems; it += NGW) {
        const int kb = it / nblk, nb = it - kb * nblk; const float* wp = W + (size_t)(kb * 128 + (lane >> 5)) * ldw + nb * 32 + (lane & 31);
        CVT_LOAD32(tb, wp, ldw, 64);
        __builtin_amdgcn_sched_barrier(0);
        CVT_LDSW32(ta, scr, 0, lane);
        const int itn = it + NGW;
        if (itn < nitems) { const int kbn = itn / nblk, nbn = itn - kbn * nblk; const float* wpn = W + (size_t)(kbn * 128 + (lane >> 5)) * ldw + nbn * 32 + (lane & 31); CVT_LOAD32(ta, wpn, ldw, 0); }
        __builtin_amdgcn_sched_barrier(0);
        CVT_LDSW32(tb, scr, 64, lane);
        cvt_finish8(g, scale, WT, K, nb * 32, kb * 128, scr, lane);
    }
}

template <int MODE>
__device__ __forceinline__ void cvt_one(const float* W, const float* W2, int ldw, const float* g, bf16* WT, int K, int ndst, int it, LAS float* scr, int lane) {
    int drow, k0; const float* wp = cvt_src<MODE>(W, W2, ldw, ndst / 32, it, lane, drow, k0);
    float t[32]; CVT_LOAD32(t, wp, ldw, 0);
    cvt_finish(t, g, WT, K, drow, k0, scr, lane);
}
__device__ __forceinline__ void cvt_one8(const float* W, int ldw, const float* g, float scale, unsigned char* WT, int K, int ndst, int it, LAS float* scr, int lane) {
    const int nblk = ndst / 32, kb = it / nblk, nb = it - kb * nblk; const float* wp = W + (size_t)(kb * 128 + (lane >> 5)) * ldw + nb * 32 + (lane & 31);
    float ta[32], tb[32]; CVT_LOAD32(ta, wp, ldw, 0); CVT_LOAD32(tb, wp, ldw, 64);
    CVT_LDSW32(ta, scr, 0, lane); CVT_LDSW32(tb, scr, 64, lane);
    cvt_finish8(g, scale, WT, K, nb * 32, kb * 128, scr, lane);
}
constexpr int BG_N0 = (2 * DFF / 32) * (DM / 64), BG_N1 = (DM / 32) * (DFF / 128), BG_N2 = (NQKV / 32) * (DM / 128), BG_N3 = (2 * NKV * HD / 32) * (DM / 64), BG_N4 = (DM / 32) * (DM / 128);
constexpr int BG_L0 = (DM / 32) * (DFF / 64), BG_L1 = BG_L0 + (3 * DM / 32) * (DM / 64), BG_L2 = BG_L1 + (DM / 32) * (DM / 64), BG_L3 = BG_L2 + BG_N0, BG_L4 = BG_L3 + BG_N1;
constexpr int BG_B1 = BG_L4 + BG_N0, BG_B2 = BG_B1 + BG_N1, BG_B3 = BG_B2 + BG_N2, BG_B4 = BG_B3 + BG_N3, BG_B5 = BG_B4 + BG_N4, BG_B6 = BG_B5 + BG_N0, BG_TOTAL = BG_B6 + BG_N1;
constexpr int BG_END_A = BG_B5;
constexpr size_t BG_CTL_OFF = 1536 * 1024;
constexpr int BG_CH = 2;
__device__ __forceinline__ void bg_item(Frame& F, const float* const* in, unsigned char* ws, int it) {
    LAS float* scr = (LAS float*)(F.lds + F.wave * 16896);
    const size_t LW = (size_t)DM * DFF;
    if (it < BG_L0) cvt_one<0>(in[5], nullptr, DM, nullptr, (bf16*)(ws + WS_WD), DFF, DM, it, scr, F.lane);
    else if (it < BG_L1) cvt_one<2>(in[11], nullptr, 3 * DM, in[10], (bf16*)(ws + WS_WCI), DM, 3 * DM, it - BG_L0, scr, F.lane);
    else if (it < BG_L2) cvt_one<0>(in[14], nullptr, DM, nullptr, (bf16*)(ws + WS_WCO), DM, DM, it - BG_L1, scr, F.lane);
    else if (it < BG_L3) cvt_one<1>(in[7], in[8], DFF, in[6], (bf16*)(ws + WS_WGU) + 1 * (size_t)2 * DFF * DM, DM, 2 * DFF, it - BG_L2, scr, F.lane);
    else if (it < BG_L4) cvt_one8(in[9], DM, nullptr, pg8::FP8_W_SCALE, ws + WS_WD8 + 1 * SZ_WD8, DFF, DM, it - BG_L3, scr, F.lane);
    else if (it < BG_B1) cvt_one<1>(in[3] + LW, in[4] + LW, DFF, in[2] + DM, (bf16*)(ws + WS_WGU) + 2 * (size_t)2 * DFF * DM, DM, 2 * DFF, it - BG_L4, scr, F.lane);
    else if (it < BG_B2) cvt_one8(in[5] + LW, DM, nullptr, pg8::FP8_W_SCALE, ws + WS_WD8 + 2 * SZ_WD8, DFF, DM, it - BG_B1, scr, F.lane);
    else if (it < BG_B3) cvt_one8(in[16], NQKV, in[15], pg8::FP8_W_SCALE, ws + WS_WQKV8, DM, NQKV, it - BG_B2, scr, F.lane);
    else if (it < BG_B4) cvt_one<0>(in[16] + NHEAD * HD, nullptr, NQKV, in[15], (bf16*)(ws + WS_WQKV) + (size_t)NHEAD * HD * DM, DM, 2 * NKV * HD, it - BG_B3, scr, F.lane);
    else if (it < BG_B5) cvt_one8(in[19], DM, nullptr, pg8::FP8_W_SCALE, ws + WS_WO8, DM, DM, it - BG_B4, scr, F.lane);
    else if (it < BG_B6) cvt_one<1>(in[7] + LW, in[8] + LW, DFF, in[6] + DM, (bf16*)(ws + WS_WGU) + 3 * (size_t)2 * DFF * DM, DM, 2 * DFF, it - BG_B5, scr, F.lane);
    else cvt_one8(in[9] + LW, DM, nullptr, pg8::FP8_W_SCALE, ws + WS_WD8 + 3 * SZ_WD8, DFF, DM, it - BG_B6, scr, F.lane);
}
__device__ __forceinline__ void bg_drain(Frame& F, const float* const* in, unsigned char* ws, volatile LAS unsigned* MISC, int k, int need) {
    unsigned* ctl = (unsigned*)(ws + BG_CTL_OFF);
    __syncthreads();
    if (F.tid == 0) (void)__hip_atomic_fetch_add(ctl + 64 * (k + 1), 1u, __ATOMIC_RELAXED, __HIP_MEMORY_SCOPE_AGENT);
    for (;;) {
        if (F.tid == 0) {
            const int c = (int)__hip_atomic_load(ctl, __ATOMIC_RELAXED, __HIP_MEMORY_SCOPE_AGENT);
            const int d = (int)__hip_atomic_load(ctl + 64 * (k + 1), __ATOMIC_RELAXED, __HIP_MEMORY_SCOPE_AGENT);
            const bool go = c < BG_TOTAL && (c < need || d < F.G);
            MISC[20] = go ? 1u : 0u;
            if (go) MISC[21] = __hip_atomic_fetch_add(ctl, (unsigned)(NWAVES * BG_CH), __ATOMIC_RELAXED, __HIP_MEMORY_SCOPE_AGENT);
        }
        __syncthreads();
        const unsigned go = MISC[20]; const int base = (int)MISC[21];
        __syncthreads();
        if (!go) break;
#pragma unroll 1
        for (int i = 0; i < BG_CH; ++i) { const int it = base + F.wave * BG_CH + i; if (it < BG_TOTAL) bg_item(F, in, ws, it); }
    }
}

typedef float f32x16 __attribute__((ext_vector_type(16)));
template <int NT, class Epi>
__device__ __forceinline__ void skinny_phase(Frame& F, const bf16* A, const bf16* Bt, int K, int n_items, const Epi& E) {
    const int r32 = F.lane & 31, hi = F.lane >> 5, kc = K / 8, k0 = F.wave * kc;
    LAS float* P = (LAS float*)F.lds;
    for (int item = F.bid; item < n_items; item += F.G) {
        f32x16 acc[NT];
        const bf16* bp[NT];
        const bf16* ap = A + (size_t)r32 * K + k0 + hi * 16;
#pragma unroll
        for (int t = 0; t < NT; ++t) { acc[t] = f32x16{}; bp[t] = Bt + (size_t)(E.tile_row(item, t) + r32) * K + k0 + hi * 16; }
        constexpr int U = (NT == 1) ? 4 : 2;
        int kk = 0;
        for (; kk + 32 * U <= kc; kk += 32 * U) {
            bf16x8 a[2 * U], b[NT][2 * U];
#pragma unroll
            for (int u = 0; u < 2 * U; ++u) a[u] = *(const bf16x8*)(ap + kk + hi * (16 * U - 16) + 8 * u);
#pragma unroll
            for (int t = 0; t < NT; ++t)
#pragma unroll
                for (int u = 0; u < 2 * U; ++u) b[t][u] = *(const bf16x8*)(bp[t] + kk + hi * (16 * U - 16) + 8 * u);
            __builtin_amdgcn_sched_barrier(0);
#pragma unroll
            for (int t = 0; t < NT; ++t)
#pragma unroll
                for (int u = 0; u < 2 * U; ++u) acc[t] = __builtin_amdgcn_mfma_f32_32x32x16_bf16(a[u], b[t][u], acc[t], 0, 0, 0);
            __builtin_amdgcn_sched_barrier(0);
        }
        for (; kk < kc; kk += 32) {
            const bf16x8 a0 = *(const bf16x8*)(ap + kk), a1 = *(const bf16x8*)(ap + kk + 8);
#pragma unroll
            for (int t = 0; t < NT; ++t) {
                const bf16x8 b0 = *(const bf16x8*)(bp[t] + kk), b1 = *(const bf16x8*)(bp[t] + kk + 8);
                acc[t] = __builtin_amdgcn_mfma_f32_32x32x16_bf16(a0, b0, acc[t], 0, 0, 0);
                acc[t] = __builtin_amdgcn_mfma_f32_32x32x16_bf16(a1, b1, acc[t], 0, 0, 0);
            }
        }
#pragma unroll
        for (int t = 0; t < NT; ++t)
#pragma unroll
            for (int r = 0; r < 16; ++r) P[((F.wave * NT + t) * 32 + att::crow(r, hi)) * 32 + r32] = acc[t][r];
        __syncthreads();
#pragma unroll
        for (int h = 0; h < 2; ++h) {
            const int e = F.tid + h * 512; float v[NT];
#pragma unroll
            for (int t = 0; t < NT; ++t) { float s = 0.f;
#pragma unroll
                for (int w = 0; w < NWAVES; ++w) s += P[(w * NT + t) * 1024 + e];
                v[t] = s; }
            E.apply(item, e >> 5, e & 31, v);
        }
        __syncthreads();
    }
}
template <class Epi>
__device__ __forceinline__ void skinny_phase8(Frame& F, const unsigned char* A, const unsigned char* Bt, int K, int n_items, const Epi& E) {
    typedef int i32x8 __attribute__((ext_vector_type(8))); typedef int i32x4 __attribute__((ext_vector_type(4)));
    const int r32 = F.lane & 31, hi = F.lane >> 5, nst = K / 64, base = nst / 8, rem = nst - base * 8;
    const int st0 = F.wave * base + (F.wave < rem ? F.wave : rem), nmy = base + (F.wave < rem ? 1 : 0);
    LAS float* P = (LAS float*)F.lds;
    for (int item = F.bid; item < n_items; item += F.G) {
        f32x16 acc = f32x16{};
        const unsigned char* ap = A + (size_t)r32 * K + (size_t)st0 * 64 + hi * 32;
        const unsigned char* bp = Bt + (size_t)(E.tile_row(item, 0) + r32) * K + (size_t)st0 * 64 + hi * 32;
        int s = 0;
        for (; s + 4 <= nmy; s += 4) {
            i32x4 a[8], b[8];
#pragma unroll
            for (int u = 0; u < 4; ++u) { a[2 * u] = *(const i32x4*)(ap + (s + u) * 64); a[2 * u + 1] = *(const i32x4*)(ap + (s + u) * 64 + 16); b[2 * u] = *(const i32x4*)(bp + (s + u) * 64); b[2 * u + 1] = *(const i32x4*)(bp + (s + u) * 64 + 16); }
            __builtin_amdgcn_sched_barrier(0);
#pragma unroll
            for (int u = 0; u < 4; ++u) asm volatile("v_mfma_f32_32x32x64_f8f6f4 %0, %1, %2, %0" : "+v"(acc) : "v"((i32x8){a[2*u][0], a[2*u][1], a[2*u][2], a[2*u][3], a[2*u+1][0], a[2*u+1][1], a[2*u+1][2], a[2*u+1][3]}), "v"((i32x8){b[2*u][0], b[2*u][1], b[2*u][2], b[2*u][3], b[2*u+1][0], b[2*u+1][1], b[2*u+1][2], b[2*u+1][3]}));
            __builtin_amdgcn_sched_barrier(0);
        }
        for (; s < nmy; ++s) {
            const i32x4 a0 = *(const i32x4*)(ap + s * 64), a1 = *(const i32x4*)(ap + s * 64 + 16), b0 = *(const i32x4*)(bp + s * 64), b1 = *(const i32x4*)(bp + s * 64 + 16);
            asm volatile("v_mfma_f32_32x32x64_f8f6f4 %0, %1, %2, %0" : "+v"(acc) : "v"((i32x8){a0[0], a0[1], a0[2], a0[3], a1[0], a1[1], a1[2], a1[3]}), "v"((i32x8){b0[0], b0[1], b0[2], b0[3], b1[0], b1[1], b1[2], b1[3]}));
        }
        asm volatile("s_nop 15\n\ts_nop 15\n\ts_nop 7" : "+v"(acc));
#pragma unroll
        for (int r = 0; r < 16; ++r) P[(F.wave * 32 + att::crow(r, hi)) * 32 + r32] = acc[r];
        __syncthreads();
#pragma unroll
        for (int h = 0; h < 2; ++h) {
            const int e = F.tid + h * 512; float v[1]; float sm = 0.f;
#pragma unroll
            for (int w = 0; w < NWAVES; ++w) sm += P[w * 1024 + e];
            v[0] = sm;
            E.apply(item, e >> 5, e & 31, v);
        }
        __syncthreads();
    }
}
struct SkResid {
    const float* hin; float* h; bf16* hb; rss_t* rss_out; float scale;
    __device__ __forceinline__ int tile_row(int item, int) const { return item * 32; }
    __device__ __forceinline__ void apply(int item, int row, int col, const float (&v)[1]) const {
        const size_t o = (size_t)(MREAL + row) * DM + item * 32 + col;
        const float x = hin[o] + scale * v[0];
        h[o] = x; hb[o] = (bf16)f2bf(x);
        float ss = x * x;
#pragma unroll
        for (int d = 1; d < 32; d <<= 1) ss += __shfl_xor(ss, d);
        if (col == 0) rss_add(rss_out + MREAL + row, ss);
    }
};
struct SkConvIn {
    bf16* bbuf; bf16* ubuf; const rss_t* rss;
    __device__ __forceinline__ int tile_row(int item, int t) const { const int ch = item * 32; return t == 0 ? 2 * DM + ch : (ch >> 7) * 256 + (t == 2 ? 128 : 0) + (ch & 127); }
    __device__ __forceinline__ void apply(int item, int row, int col, const float (&v)[3]) const {
        const float rs = rstd_from_ss(rss[MREAL + row]); const size_t o = (size_t)(MREAL + row) * DM + item * 32 + col;
        bbuf[o] = (bf16)f2bf(v[0] * rs); ubuf[o] = (bf16)f2bf((v[1] * rs) * (v[2] * rs));
    }
};
struct SkKV {
    bf16* k; bf16* v; const rss_t* rss;
    __device__ __forceinline__ int tile_row(int item, int) const { return item * 32; }
    __device__ __forceinline__ void apply(int item, int row, int col, const float (&x)[1]) const {
        const float rs = rstd_from_ss(rss[MREAL + row]); const int kvr = (row >> 4) * KVROWS + (row & 15);
        bf16* dst = item < 32 ? k : v; const int c = (item & 31) * 32 + col;
        dst[(size_t)kvr * (NKV * HD) + c] = (bf16)f2bf(x[0] * rs);
    }
};

__device__ __forceinline__ void rows_init(Frame& F, const float* x, const float* meta, float* h, bf16* hb, rss_t* rss0) {
    const int gw = F.bid * NWAVES + F.wave, NGW = F.G * NWAVES;
    for (int r = gw; r < MVALID; r += NGW) {
        const float* src = r < MREAL ? x + (size_t)r * DM : meta + (size_t)((r - MREAL) & (NMETA - 1)) * DM;
        float ss = 0.f;
#pragma unroll
        for (int j = 0; j < 16; ++j) {
            const f32x4 v = *(const GAS f32x4*)(src + (size_t)(64 * j + F.lane) * 4);
            ss += (v.x * v.x + v.y * v.y) + (v.z * v.z + v.w * v.w);
            const unsigned long long pk = (unsigned long long)pg8::cvt_pk_bf16(v.x, v.y) | ((unsigned long long)pg8::cvt_pk_bf16(v.z, v.w) << 32);
            *(GAS unsigned long long*)(hb + (size_t)r * DM + (size_t)(64 * j + F.lane) * 4) = pk;
            if (r >= MREAL) *(GAS f32x4*)(h + (size_t)r * DM + (size_t)(64 * j + F.lane) * 4) = v;
        }
        ss = wave_sum(ss);
        if (F.lane == 0) rss0[r] = rss_fix(ss);
    }
}
__device__ __forceinline__ void seq_neighbours(int r, int& prev, int& next) {
    if (r < MREAL) { const int b = r >> 13, t = r & (SEQ - 1); prev = t > 0 ? r - 1 : MREAL + b * NMETA + (NMETA - 1); next = t < SEQ - 1 ? r + 1 : -1; }
    else { const int b = (r - MREAL) >> 4, j = (r - MREAL) & 15; prev = j > 0 ? r - 1 : -1; next = j < NMETA - 1 ? r + 1 : b * SEQ; }
}
__device__ __forceinline__ void conv_pass(Frame& F, const bf16* bbuf, const bf16* ubuf, const float* cw, const float* cb, bf16* cv) {
    const int gt = F.bid * (NWAVES * 64) + F.tid, NGT = F.G * NWAVES * 64;
    for (int it = gt; it < (MVALID / 8) * (DM / 8); it += NGT) {
        const int r0 = (it >> 9) * 8, c = (it & 511) * 8; int prev, next, dummy; seq_neighbours(r0, prev, dummy); seq_neighbours(r0 + 7, dummy, next);
        const bf16x8 zero = {0, 0, 0, 0, 0, 0, 0, 0};
        bf16x8 uu[10], bv[8];
        uu[0] = prev >= 0 ? *(const GAS bf16x8*)(ubuf + (size_t)prev * DM + c) : zero;
#pragma unroll
        for (int k = 0; k < 8; ++k) { uu[k + 1] = *(const GAS bf16x8*)(ubuf + (size_t)(r0 + k) * DM + c); bv[k] = *(const GAS bf16x8*)(bbuf + (size_t)(r0 + k) * DM + c); }
        uu[9] = next >= 0 ? *(const GAS bf16x8*)(ubuf + (size_t)next * DM + c) : zero;
        float w0[8], w1[8], w2[8], bb[8];
#pragma unroll
        for (int q = 0; q < 2; ++q) {
            const f32x4 a0 = *(const GAS f32x4*)(cw + c + 4 * q), a1 = *(const GAS f32x4*)(cw + DM + c + 4 * q), a2 = *(const GAS f32x4*)(cw + 2 * DM + c + 4 * q), a3 = *(const GAS f32x4*)(cb + c + 4 * q);
#pragma unroll
            for (int j = 0; j < 4; ++j) { w0[4 * q + j] = a0[j]; w1[4 * q + j] = a1[j]; w2[4 * q + j] = a2[j]; bb[4 * q + j] = a3[j]; }
        }
#pragma unroll
        for (int k = 0; k < 8; ++k) {
            float o[8];
#pragma unroll
            for (int e = 0; e < 8; ++e)
                o[e] = bf2f((unsigned short)bv[k][e]) * (w0[e] * bf2f((unsigned short)uu[k][e]) + w1[e] * bf2f((unsigned short)uu[k + 1][e]) + w2[e] * bf2f((unsigned short)uu[k + 2][e]) + bb[e]);
            v4u w; w.x = pg8::cvt_pk_bf16(o[0], o[1]); w.y = pg8::cvt_pk_bf16(o[2], o[3]); w.z = pg8::cvt_pk_bf16(o[4], o[5]); w.w = pg8::cvt_pk_bf16(o[6], o[7]);
            *(GAS v4u*)(cv + (size_t)(r0 + k) * DM + c) = w;
        }
    }
}
__device__ __forceinline__ void rope_head(bf16* p, const float* gain, float rowpos, float colpos, int i) {
    const float x0 = bf2f(p[i]), x1 = bf2f(p[32 + i]), x2 = bf2f(p[64 + i]), x3 = bf2f(p[96 + i]);
    float ss = (x0 * x0 + x1 * x1) + (x2 * x2 + x3 * x3);
#pragma unroll
    for (int d = 1; d < 32; d <<= 1) ss += __shfl_xor(ss, d);
    const float rs = __builtin_amdgcn_rsqf(ss * (1.0f / (float)HD) + RMS_EPS);
    const float y0 = x0 * rs * gain[i], y1 = x1 * rs * gain[32 + i], y2 = x2 * rs * gain[64 + i], y3 = x3 * rs * gain[96 + i];
    const float inv_freq = __builtin_amdgcn_exp2f(-(float)i * 0.41524101186092029f);
    const float ar = rowpos * inv_freq * 0.15915494309189535f, ac = colpos * inv_freq * 0.15915494309189535f;
    const float cr = __builtin_amdgcn_cosf(ar), sr = __builtin_amdgcn_sinf(ar), cc = __builtin_amdgcn_cosf(ac), sc = __builtin_amdgcn_sinf(ac);
    p[i] = (bf16)f2bf(y0 * cr - y1 * sr); p[32 + i] = (bf16)f2bf(y1 * cr + y0 * sr);
    p[64 + i] = (bf16)f2bf(y2 * cc - y3 * sc); p[96 + i] = (bf16)f2bf(y3 * cc + y2 * sc);
}
__device__ __forceinline__ void k_prep_pass(Frame& F, bf16* K, const float* kg) {
    const int ghw = (F.bid * NWAVES + F.wave) * 2 + (F.lane >> 5), NGHW = F.G * NWAVES * 2, i = F.lane & 31;
    constexpr int NK = NB * (NMETA + SEQ) * NKV;
    static_assert(NK % 2 == 0, "both half-waves of a wave leave the loop together");
    for (int j = ghw; j < NK; j += NGHW) {
        const int key = j >> 3, g = j & 7, b = key / (NMETA + SEQ), p = key - b * (NMETA + SEQ);
        const int kvr = b * KVROWS + (p < NMETA ? p : 64 + (p - NMETA));
        const float rowpos = p < NMETA ? -1.f : (float)((p - NMETA) >> 6), colpos = p < NMETA ? (float)p : (float)((p - NMETA) & 63);
        rope_head(K + (size_t)kvr * (NKV * HD) + g * HD, kg, rowpos, colpos, i);
    }
}
template <bool KEEP16>
__device__ __forceinline__ void kv_prep8_pass(Frame& F, bf16* K, const bf16* V, const float* kg, unsigned char* K8, unsigned char* VT8) {
    {   const int ghw = (F.bid * NWAVES + F.wave) * 2 + (F.lane >> 5), NGHW = F.G * NWAVES * 2, i = F.lane & 31;
        constexpr int NK = NB * (NMETA + SEQ) * NKV;
        for (int j = ghw; j < NK; j += NGHW) {
            const int key = j >> 3, g = j & 7, b = key / (NMETA + SEQ), p = key - b * (NMETA + SEQ);
            const int kvr = b * KVROWS + (p < NMETA ? p : 64 + (p - NMETA));
            const float rowpos = p < NMETA ? -1.f : (float)((p - NMETA) >> 6), colpos = p < NMETA ? (float)p : (float)((p - NMETA) & 63);
            bf16* kp = K + (size_t)kvr * (NKV * HD) + g * HD; unsigned char* k8 = K8 + (size_t)kvr * (NKV * HD) + g * HD;
            const float x0 = bf2f(kp[i]), x1 = bf2f(kp[32 + i]), x2 = bf2f(kp[64 + i]), x3 = bf2f(kp[96 + i]);
            float ss = (x0 * x0 + x1 * x1) + (x2 * x2 + x3 * x3);
#pragma unroll
            for (int d = 1; d < 32; d <<= 1) ss += __shfl_xor(ss, d);
            const float rs = __builtin_amdgcn_rsqf(ss * (1.0f / (float)HD) + RMS_EPS);
            const float y0 = x0 * rs * kg[i], y1 = x1 * rs * kg[32 + i], y2 = x2 * rs * kg[64 + i], y3 = x3 * rs * kg[96 + i];
            const float inv_freq = __builtin_amdgcn_exp2f(-(float)i * 0.41524101186092029f);
            const float ar = rowpos * inv_freq * 0.15915494309189535f, ac = colpos * inv_freq * 0.15915494309189535f;
            const float cr = __builtin_amdgcn_cosf(ar), sr = __builtin_amdgcn_sinf(ar), cc = __builtin_amdgcn_cosf(ac), sc = __builtin_amdgcn_sinf(ac);
            const float o0 = y0 * cr - y1 * sr, o1 = y1 * cr + y0 * sr, o2 = y2 * cc - y3 * sc, o3 = y3 * cc + y2 * sc;
            if (KEEP16) { kp[i] = (bf16)f2bf(o0); kp[32 + i] = (bf16)f2bf(o1); kp[64 + i] = (bf16)f2bf(o2); kp[96 + i] = (bf16)f2bf(o3); }
            const float s8 = att8::FP8_KQ_SCALE;
            k8[att8::k8_pos(i)] = (unsigned char)(att8::pk4(att8::sat8(o0 * s8), 0.f, 0.f, 0.f) & 0xff); k8[att8::k8_pos(32 + i)] = (unsigned char)(att8::pk4(att8::sat8(o1 * s8), 0.f, 0.f, 0.f) & 0xff);
            k8[att8::k8_pos(64 + i)] = (unsigned char)(att8::pk4(att8::sat8(o2 * s8), 0.f, 0.f, 0.f) & 0xff); k8[att8::k8_pos(96 + i)] = (unsigned char)(att8::pk4(att8::sat8(o3 * s8), 0.f, 0.f, 0.f) & 0xff);
        }
    }
    {   const int gw = F.bid * NWAVES + F.wave, NGW = F.G * NWAVES; constexpr int NTILE = KVROWS / 64, NITEM = NB * NKV * NTILE * 2;
        for (int it = gw; it < NITEM; it += NGW) {
            const int dh = it & 1, tile = (it >> 1) % NTILE, bk = (it >> 1) / NTILE, b = bk >> 3, g = bk & 7, d = dh * 64 + F.lane;
            const bf16* vp = V + (size_t)(b * KVROWS + tile * 64) * (NKV * HD) + g * HD + d;
            unsigned char* op = VT8 + ((size_t)(bk * NTILE + tile) * 128 + d) * 64;
#pragma unroll
            for (int q = 0; q < 4; ++q) { v4u w;
#pragma unroll
                for (int c = 0; c < 4; ++c) { float x[4];
#pragma unroll
                    for (int e = 0; e < 4; ++e) { const int key = att8::v8_key(16 * q + 4 * c + e); x[e] = (tile == 0 && key >= NMETA) ? 0.f : att8::sat8(bf2f(vp[(size_t)key * (NKV * HD)]) * att8::FP8_V_SCALE); }
                    w[c] = att8::pk4(x[0], x[1], x[2], x[3]); }
                *(GAS v4u*)(op + 16 * q) = w; }
        }
    }
}
__device__ __forceinline__ void final_norm_pass(Frame& F, const float* h, const rss_t* rss, const float* g, float* out) {
    const int gw = F.bid * NWAVES + F.wave, NGW = F.G * NWAVES;
    for (int r = gw; r < MREAL; r += NGW) {
        const float rs = rstd_from_ss(rss[r]);
#pragma unroll
        for (int j = 0; j < 16; ++j) { const size_t o = (size_t)(64 * j + F.lane) * 4;
            const f32x4 v = *(const GAS f32x4*)(h + (size_t)r * DM + o), gv = *(const GAS f32x4*)(g + o);
            *(GAS f32x4*)(out + (size_t)r * DM + o) = v * rs * gv; }
    }
}

#ifndef MK_ONE_LAUNCH
#define MK_ONE_LAUNCH 1
#endif
#ifndef FP8_DOWN_MASK
#define FP8_DOWN_MASK 0xE
#endif
#ifndef FP8_QKV
#define FP8_QKV 1
#endif
#ifndef FP8_ATTN
#define FP8_ATTN 1
#endif
#ifndef FP8_WO
#define FP8_WO 1
#endif
#ifndef BG_DEFER
#define BG_DEFER 1
#endif
constexpr int N_PHASES = 17;
struct Args { const float* in[21]; float* out; unsigned char* ws; int ph_lo, ph_hi; };
static_assert(sizeof(Args) == 192, "Args has no padding bytes");

__global__ void __launch_bounds__(NWAVES * 64, 2) fwd_kernel(Args args) {
    extern __shared__ __attribute__((aligned(16))) unsigned char lds_raw[];
    Frame F;
    F.lds = (LAS unsigned char*)lds_raw;
    F.tid = threadIdx.x; F.lane = F.tid & 63; F.wave = __builtin_amdgcn_readfirstlane(F.tid >> 6);
    F.G = gridDim.x; F.bid = blockIdx.x;
    volatile LAS unsigned* MISC = (volatile LAS unsigned*)(F.lds + MISC_OFF);
    unsigned char* ws = args.ws;
    gu32* ctl = (gu32*)ws;
    for (int u = F.tid; u < (LDS_BYTES - 139264) / 4; u += NWAVES * 64) ((LAS unsigned*)(F.lds + 139264))[u] = 0u;
    __syncthreads();
    XcdBarrier bar; bar.bar = (unsigned*)(ctl + CW_BAR); bar.x = 0; bar.st = nullptr;
    if (MK_ONE_LAUNCH) bar = xcd_barrier_post((unsigned*)(ctl + CW_BAR), MISC + 8, F.tid == 0);
    const int lo = args.ph_lo, hi = args.ph_hi;
#define REFRAME_(F) ((F).lane = att::lane_id_asm(), (F).tid = (F).wave * 64 + (F).lane)
#define IN(k) (lo <= (k) && (k) < hi && (REFRAME_(F), true))
#define SEAM(k) do { if (MK_ONE_LAUNCH && (lo <= (k) + 1 && (k) + 1 < hi)) xcd_barrier(bar, (REFRAME_(F), F.tid == 0)); } while (0)
#define PH_BEGIN(k) if (IN(k)) {
#define BG_NEED(k) ((k) >= 14 ? BG_TOTAL : (k) == 13 ? BG_B6 : (k) == 12 ? BG_B5 : ((k) == 11 || (k) == 10 || (k) == 9) ? BG_B4 : (k) == 8 ? BG_B2 : (k) == 7 ? BG_B1 : (k) == 6 ? BG_L4 : (k) == 5 ? BG_L3 : ((k) == 4 || (k) == 3) ? BG_L2 : (k) == 2 ? BG_L1 : (k) == 1 ? BG_L0 : 0)
#define BG_SITE(k) ((k) <= 10 || (k) == 12 || (k) == 13 || (k) == 14)
#define PH_END(k) if (BG_DEFER && MK_ONE_LAUNCH && BG_SITE(k)) { REFRAME_(F); bg_drain(F, args.in, ws, MISC, (k), BG_NEED(k)); } SEAM(k); }

    const float* x = args.in[0]; const float* meta = args.in[1];
    const float* conv_norm = args.in[10]; const float* conv_w_in = args.in[11]; const float* conv_w = args.in[12]; const float* conv_b = args.in[13]; const float* conv_w_out = args.in[14];
    const float* attn_norm = args.in[15]; const float* attn_w_qkv = args.in[16]; const float* q_gain = args.in[17]; const float* k_gain = args.in[18]; const float* attn_w_o = args.in[19];
    const float* final_g = args.in[20];
    bf16* WGU = (bf16*)(ws + WS_WGU); bf16* WD = (bf16*)(ws + WS_WD); bf16* WCI = (bf16*)(ws + WS_WCI); bf16* WCO = (bf16*)(ws + WS_WCO); bf16* WQKV = (bf16*)(ws + WS_WQKV); bf16* WO = (bf16*)(ws + WS_WO);
    float* H = (float*)(ws + WS_H); bf16* HB = (bf16*)(ws + WS_HB); bf16* ACT = (bf16*)(ws + WS_ACT); bf16* BB = (bf16*)(ws + WS_BB); bf16* UB = (bf16*)(ws + WS_UB);
    bf16* QB = (bf16*)(ws + WS_Q); bf16* KB = (bf16*)(ws + WS_K); bf16* VB = (bf16*)(ws + WS_V); bf16* AUX = (bf16*)(ws + WS_AUX);
    rss_t* RSS = (rss_t*)(ws + RSS_OFF);
#define RSSK(k) (RSS + (size_t)(k) * MPAD)
    constexpr size_t NWGU = (size_t)2 * DFF * DM, NWD = (size_t)DM * DFF;
#define D8(f) (((FP8_DOWN_MASK >> (f)) & 1) != 0)
    unsigned char* HB8 = ws + WS_HB8; unsigned char* K8 = ws + WS_K8; unsigned char* VT8 = ws + WS_VT8;

    PH_BEGIN(0)
        cvt_matrix<1>(F, args.in[3] + (size_t)0 * DM * DFF, args.in[4] + (size_t)0 * DM * DFF, DFF, args.in[2] + 0 * DM, WGU + 0 * NWGU, DM, 2 * DFF);
        if (D8(0)) cvt_matrix8(F, args.in[5] + (size_t)0 * DFF * DM, DM, nullptr, pg8::FP8_W_SCALE, ws + WS_WD8 + 0 * SZ_WD8, DFF, DM);
        if (!BG_DEFER && (!D8(0))) cvt_matrix<0>(F, args.in[5] + (size_t)0 * DFF * DM, nullptr, DM, nullptr, WD + 0 * NWD, DFF, DM);
        if (!BG_DEFER) { cvt_matrix<1>(F, args.in[7] + (size_t)0 * DM * DFF, args.in[8] + (size_t)0 * DM * DFF, DFF, args.in[6] + 0 * DM, WGU + 1 * NWGU, DM, 2 * DFF); }
        if (!BG_DEFER && (D8(1))) cvt_matrix8(F, args.in[9] + (size_t)0 * DFF * DM, DM, nullptr, pg8::FP8_W_SCALE, ws + WS_WD8 + 1 * SZ_WD8, DFF, DM);
        if (!D8(1)) cvt_matrix<0>(F, args.in[9] + (size_t)0 * DFF * DM, nullptr, DM, nullptr, WD + 1 * NWD, DFF, DM);
        if (!BG_DEFER) cvt_matrix<1>(F, args.in[3] + (size_t)1 * DM * DFF, args.in[4] + (size_t)1 * DM * DFF, DFF, args.in[2] + 1 * DM, WGU + 2 * NWGU, DM, 2 * DFF);
        if (D8(2) && !BG_DEFER) cvt_matrix8(F, args.in[5] + (size_t)1 * DFF * DM, DM, nullptr, pg8::FP8_W_SCALE, ws + WS_WD8 + 2 * SZ_WD8, DFF, DM);
        if (!D8(2)) cvt_matrix<0>(F, args.in[5] + (size_t)1 * DFF * DM, nullptr, DM, nullptr, WD + 2 * NWD, DFF, DM);
        if (!BG_DEFER) cvt_matrix<1>(F, args.in[7] + (size_t)1 * DM * DFF, args.in[8] + (size_t)1 * DM * DFF, DFF, args.in[6] + 1 * DM, WGU + 3 * NWGU, DM, 2 * DFF);
        if (D8(3) && !BG_DEFER) cvt_matrix8(F, args.in[9] + (size_t)1 * DFF * DM, DM, nullptr, pg8::FP8_W_SCALE, ws + WS_WD8 + 3 * SZ_WD8, DFF, DM);
        if (!D8(3)) cvt_matrix<0>(F, args.in[9] + (size_t)1 * DFF * DM, nullptr, DM, nullptr, WD + 3 * NWD, DFF, DM);
        if (!BG_DEFER) { cvt_matrix<2>(F, conv_w_in, nullptr, 3 * DM, conv_norm, WCI, DM, 3 * DM); }
        if (!BG_DEFER) { cvt_matrix<0>(F, conv_w_out, nullptr, DM, nullptr, WCO, DM, DM); }
        if (BG_DEFER) { static_assert(!BG_DEFER || (D8(1) && D8(2) && D8(3) && !D8(0) && FP8_QKV && FP8_WO), "the background queue is written for this configuration"); }
        else if (FP8_QKV) {
            cvt_matrix8(F, attn_w_qkv, NQKV, attn_norm, pg8::FP8_W_SCALE, ws + WS_WQKV8, DM, NQKV);
            cvt_matrix<0>(F, attn_w_qkv + NHEAD * HD, nullptr, NQKV, attn_norm, WQKV + (size_t)NHEAD * HD * DM, DM, 2 * NKV * HD);
        } else cvt_matrix<0>(F, attn_w_qkv, nullptr, NQKV, attn_norm, WQKV, DM, NQKV);
        if (!BG_DEFER) { if (FP8_WO) cvt_matrix8(F, attn_w_o, DM, nullptr, pg8::FP8_W_SCALE, ws + WS_WO8, DM, DM); else cvt_matrix<0>(F, attn_w_o, nullptr, DM, nullptr, WO, DM, DM); }
        rows_init(F, x, meta, H, HB, RSSK(0));
    PH_END(0)

#define FFN_UP(ph, f, rows, rin) PH_BEGIN(ph) \
        pg8::Gemm g{HB, WGU + (size_t)(f) * NWGU, (rows), 2 * DFF, DM}; pg8::StaticOrder S; S.init((rows), 2 * DFF, F.G, F.bid); \
        pg8::EpiSwiGLU<D8(f)> E{ACT, RSSK(rin)}; \
        pg8::gemm_phase<pg8::EpiSwiGLU<D8(f)>, pg8::StaticOrder, true, true>(F.lds, g, S, E, F.wave); \
        PH_END(ph)
#define FFN_DOWN(ph, f, basep, hbp, hb8p, rout, with_meta) PH_BEGIN(ph) \
        pg8::Gemm g{ACT, D8(f) ? (const bf16*)(ws + WS_WD8 + (f) * SZ_WD8) : WD + (size_t)(f) * NWD, MREAL, DM, DFF}; pg8::StaticOrder S; S.init(MREAL, DM, F.G, F.bid); \
        pg8::EpiResid E{(basep), H, (hbp), (hb8p), RSSK(rout), D8(f) ? 0.5f / (pg8::FP8_ACT_SCALE * pg8::FP8_W_SCALE) : 0.5f}; \
        pg8::gemm_phase<pg8::EpiResid, pg8::StaticOrder, true, true, D8(f)>(F.lds, g, S, E, F.wave); \
        if (with_meta) { SkResid SE{H, H, HB, RSSK(rout), D8(f) ? 0.5f / (pg8::FP8_ACT_SCALE * pg8::FP8_W_SCALE) : 0.5f}; \
            if (D8(f)) skinny_phase8<SkResid>(F, (const unsigned char*)ACT + (size_t)MREAL * DFF, ws + WS_WD8 + (f) * SZ_WD8, DFF, DM / 32, SE); \
            else skinny_phase<1, SkResid>(F, ACT + (size_t)MREAL * DFF, WD + (size_t)(f) * NWD, DFF, DM / 32, SE); } \
        PH_END(ph)

    FFN_UP(1, 0, MPAD, 0)
    FFN_DOWN(2, 0, x, HB, (unsigned char*)nullptr, 1, true)
    PH_BEGIN(3)
        pg8::Gemm g{HB, WCI, MREAL, 3 * DM, DM}; pg8::StaticOrder S; S.init(MREAL, 3 * DM, F.G, F.bid);
        pg8::EpiConvIn E{BB, UB, RSSK(1)};
        pg8::gemm_phase<pg8::EpiConvIn, pg8::StaticOrder, true, true>(F.lds, g, S, E, F.wave);
        SkConvIn SE{BB, UB, RSSK(1)}; skinny_phase<3, SkConvIn>(F, HB + (size_t)MREAL * DM, WCI, DM, DM / 32, SE);
    PH_END(3)
    PH_BEGIN(4) conv_pass(F, BB, UB, conv_w, conv_b, AUX); PH_END(4)
    PH_BEGIN(5)
        pg8::Gemm g{AUX, WCO, MREAL, DM, DM}; pg8::StaticOrder S; S.init(MREAL, DM, F.G, F.bid);
        pg8::EpiResid E{H, H, HB, (unsigned char*)nullptr, RSSK(2), 1.0f};
        pg8::gemm_phase<pg8::EpiResid, pg8::StaticOrder, true, true>(F.lds, g, S, E, F.wave);
        SkResid SE{H, H, HB, RSSK(2), 1.0f}; skinny_phase<1, SkResid>(F, AUX + (size_t)MREAL * DM, WCO, DM, DM / 32, SE);
    PH_END(5)
    FFN_UP(6, 1, MPAD, 2)
    FFN_DOWN(7, 1, H, HB, (unsigned char*)nullptr, 3, true)
    FFN_UP(8, 2, MPAD, 3)
    FFN_DOWN(9, 2, H, FP8_QKV ? (bf16*)nullptr : HB, FP8_QKV ? HB8 : (unsigned char*)nullptr, 4, true)
    PH_BEGIN(10)
        pg8::Gemm g{FP8_QKV ? (const bf16*)HB8 : HB, FP8_QKV ? (const bf16*)(ws + WS_WQKV8) : WQKV, MREAL, NQKV, DM}; pg8::StaticOrder S; S.init(MREAL, NQKV, F.G, F.bid);
        pg8::EpiQKV E{QB, KB, VB, RSSK(4), FP8_QKV ? 1.0f / (pg8::FP8_H_SCALE * pg8::FP8_W_SCALE) : 1.0f};
        pg8::gemm_phase<pg8::EpiQKV, pg8::StaticOrder, true, true, FP8_QKV != 0>(F.lds, g, S, E, F.wave);
        SkKV SE{KB, VB, RSSK(4)}; skinny_phase<1, SkKV>(F, HB + (size_t)MREAL * DM, WQKV + (size_t)NHEAD * HD * DM, DM, 2 * NKV * HD / 32, SE);
        for (int i = F.bid * (NWAVES * 64) + F.tid; i < NB * 48 * (NKV * HD / 8); i += F.G * NWAVES * 64) {
            const int b = i / (48 * 128), r = (i / 128) % 48, c = (i & 127) * 8; const size_t o = (size_t)(b * KVROWS + NMETA + r) * (NKV * HD) + c;
            *(GAS v4u*)(KB + o) = (v4u){0u, 0u, 0u, 0u}; *(GAS v4u*)(VB + o) = (v4u){0u, 0u, 0u, 0u};
        }
    PH_END(10)
    PH_BEGIN(11) if (FP8_ATTN) kv_prep8_pass<false>(F, KB, VB, k_gain, K8, VT8); else k_prep_pass(F, KB, k_gain); PH_END(11)
    PH_BEGIN(12)
        constexpr int NUNITS = NB * NHEAD * (SEQ / 256);
        const bool xcd_deal = (F.G == 256);
        for (int i = 0;; ++i) {
            int un;
            if (xcd_deal) { if (i >= 8) break; un = (F.bid & 7) * 256 + i * 32 + (F.bid >> 3); } else { un = i * F.G + F.bid; if (un >= NUNITS) break; }
            const int grp = un >> 7, rem = un & 127, b = grp >> 3, kvh = grp & 7, hq = kvh * 4 + (rem >> 5), qb = rem & 31;
            const size_t qoff = (size_t)(b * SEQ + qb * 256) * DM + hq * HD, koff = (size_t)(b * KVROWS) * (NKV * HD) + kvh * HD;
            if (FP8_ATTN) att8::attn_unit8(QB + qoff, K8 + koff, VT8 + (size_t)grp * (KVROWS / 64) * 8192, (unsigned char*)AUX + qoff, (char*)lds_raw, F.lds, F.wave, q_gain, qb * 256);
            else att::attn_unit<FP8_WO != 0>(QB + qoff, KB + koff, VB + koff, FP8_WO ? (void*)((unsigned char*)AUX + qoff) : (void*)(AUX + qoff), (char*)lds_raw, F.wave, q_gain, qb * 256);
        }
    PH_END(12)
    PH_BEGIN(13)
        pg8::Gemm g{AUX, FP8_WO ? (const bf16*)(ws + WS_WO8) : WO, MREAL, DM, DM}; pg8::StaticOrder S; S.init(MREAL, DM, F.G, F.bid);
        pg8::EpiResid E{H, H, HB, (unsigned char*)nullptr, RSSK(5), FP8_WO ? 1.0f / (pg8::FP8_O_SCALE * pg8::FP8_W_SCALE) : 1.0f};
        pg8::gemm_phase<pg8::EpiResid, pg8::StaticOrder, true, true, FP8_WO != 0>(F.lds, g, S, E, F.wave);
    PH_END(13)
    FFN_UP(14, 3, MREAL, 5)
    FFN_DOWN(15, 3, H, (bf16*)nullptr, (unsigned char*)nullptr, 6, false)
    PH_BEGIN(16) final_norm_pass(F, H, RSSK(6), final_g, args.out); PH_END(16)
#undef IN
#undef SEAM
}

extern "C" void kernel_launch(void* const* d_in, const int* in_sizes, int n_in, void* d_out, int out_size, void* d_ws, size_t ws_size, hipStream_t stream) {
    static int grid = 0;
    if (grid == 0) {
        if (n_in != 21 || in_sizes[0] != MREAL * DM || out_size != MREAL * DM || ws_size < WS_END) {
            fprintf(stderr, "kernel_launch: built for 21 inputs, x/out of %d floats, >= %zu bytes of workspace; got n_in %d, in0 %d, out %d, ws %zu; nothing launched\n", MREAL * DM, (size_t)WS_END, n_in, n_in > 0 ? in_sizes[0] : -1, out_size, ws_size);
            grid = -1; return; }
        int dev = 0, cus = 0, per_cu = 0;
        if (hipGetDevice(&dev) != hipSuccess || hipDeviceGetAttribute(&cus, hipDeviceAttributeMultiprocessorCount, dev) != hipSuccess) { fprintf(stderr, "kernel_launch: device query failed\n"); grid = -1; return; }
        if (hipFuncSetAttribute((const void*)fwd_kernel, hipFuncAttributeMaxDynamicSharedMemorySize, LDS_BYTES) != hipSuccess) { fprintf(stderr, "kernel_launch: hipFuncSetAttribute failed\n"); grid = -1; return; }
        if (hipOccupancyMaxActiveBlocksPerMultiprocessor(&per_cu, (const void*)fwd_kernel, NWAVES * 64, LDS_BYTES) != hipSuccess || per_cu < 1)
            fprintf(stderr, "kernel_launch: note: occupancy query reports %d workgroups per CU\n", per_cu);
        (void)hipGetLastError();
        grid = cus;
    }
    if (grid < 0) return;
    if (hipMemsetAsync(d_ws, 0, CTL_ZERO_BYTES, stream) != hipSuccess) { fprintf(stderr, "kernel_launch: hipMemsetAsync failed\n"); return; }
    Args a{};
    for (int i = 0; i < 21; ++i) a.in[i] = (const float*)d_in[i];
    a.out = (float*)d_out; a.ws = (unsigned char*)d_ws;
#if MK_ONE_LAUNCH
    a.ph_lo = 0; a.ph_hi = N_PHASES;
    hipLaunchKernelGGL(fwd_kernel, dim3(grid), dim3(NWAVES * 64), LDS_BYTES, stream, a);
#else
    for (int p = 0; p < N_PHASES; ++p) { a.ph_lo = p; a.ph_hi = p + 1; hipLaunchKernelGGL(fwd_kernel, dim3(grid), dim3(NWAVES * 64), LDS_BYTES, stream, a); }
#endif
    const hipError_t le = hipPeekAtLastError();
    if (le != hipSuccess) fprintf(stderr, "kernel_launch: launch failed: %s\n", hipGetErrorName(le));
}
```
